# Optimizing an MI355X kernel written in HIP

```python
import math
import jax, jax.numpy as jnp
from jax import lax
import numpy as np

D_MODEL = 1024
BATCH = 4
SEQ = 4096
DEPTH = 1

ATTN_HEADS = 8
HEAD_DIM = 64
ATTN_WIDTH = ATTN_HEADS * HEAD_DIM
MOBA_BLOCK = 256
MOBA_TOPK = 3
Q_CHUNK = 64
NUM_BUCKETS = 32
MAX_DISTANCE = 128
SSM_WIDTH = 512
SSM_GROUP = 16
SSM_GROUPS = SSM_WIDTH // SSM_GROUP
SSM_STATE = 64
DT_MIN = 0.001
DT_MAX = 0.1
IN_SPLITS = [ATTN_WIDTH, 2 * ATTN_WIDTH, 3 * ATTN_WIDTH, 3 * ATTN_WIDTH + SSM_WIDTH,
             3 * ATTN_WIDTH + SSM_WIDTH + D_MODEL]
IN_WIDTH = 3 * ATTN_WIDTH + SSM_WIDTH + 2 * D_MODEL
N_EXPERTS = 256
TOP_K = 8
N_EXPERT_GROUPS = 8
TOPK_GROUPS = 4
EXPERT_DIM = 256
SHARED_DIM = 256
ROUTED_SCALE = 2.5
EXPERT_BLOCK = 128
EPS = 1e-6
MASK_VALUE = -1e30

kernel_name = "griffin_moba_s5_moe_hybrid"


def rms_norm(x, g):
    xf = x.astype(jnp.float32)
    y = xf * lax.rsqrt(jnp.mean(xf * xf, axis=-1, keepdims=True) + EPS)
    return (y * g.astype(jnp.float32)).astype(x.dtype)


def t5_bucket(rel):
    n = jnp.maximum(rel, 0)
    max_exact = NUM_BUCKETS // 2
    nf = jnp.maximum(n, 1).astype(jnp.float32)
    large = max_exact + (jnp.log(nf / max_exact) / math.log(MAX_DISTANCE / max_exact)
                         * (NUM_BUCKETS - max_exact)).astype(jnp.int32)
    large = jnp.minimum(large, NUM_BUCKETS - 1)
    return jnp.where(n < max_exact, n, large)


def moba_attention(q, k, v, rel_bias):
    B, H, S, Dh = q.shape
    nb = -(-S // MOBA_BLOCK)
    pad = nb * MOBA_BLOCK - S
    kp = jnp.pad(k, ((0, 0), (0, 0), (0, pad), (0, 0)))
    vp = jnp.pad(v, ((0, 0), (0, 0), (0, pad), (0, 0)))
    kb = kp.reshape(B, H, nb, MOBA_BLOCK, Dh)
    vb = vp.reshape(B, H, nb, MOBA_BLOCK, Dh)
    kmean = jnp.mean(kb.astype(jnp.float32), axis=3)
    n_sel = min(MOBA_TOPK, nb)
    scale = Dh ** -0.5
    bidx = jnp.arange(B)[:, None, None, None]
    hidx = jnp.arange(H)[None, :, None, None]
    blk_off = jnp.arange(MOBA_BLOCK)

    def chunk(ci):
        start = ci * Q_CHUNK
        qc = lax.dynamic_slice_in_dim(q, start, Q_CHUNK, axis=2)
        qpos = start + jnp.arange(Q_CHUNK)
        own = start // MOBA_BLOCK
        gate = jnp.einsum('bhqd,bhnd->bhqn', qc.astype(jnp.float32), kmean)
        gate = jnp.where(jnp.arange(nb) < own, gate, MASK_VALUE)
        _, sel = lax.top_k(gate, n_sel)
        valid = sel < own
        ksel = kb[bidx, hidx, sel]
        vsel = vb[bidx, hidx, sel]
        s_sel = jnp.einsum('bhqd,bhqjkd->bhqjk', qc, ksel).astype(jnp.float32) * scale
        kpos_sel = sel[..., None] * MOBA_BLOCK + blk_off
        bucket_sel = t5_bucket(qpos[None, None, :, None, None] - kpos_sel)
        bias_sel = rel_bias[bucket_sel, hidx[..., None]].astype(jnp.float32)
        s_sel = jnp.where(valid[..., None], s_sel + bias_sel, MASK_VALUE)
        kown = lax.dynamic_index_in_dim(kb, own, axis=2, keepdims=False)
        vown = lax.dynamic_index_in_dim(vb, own, axis=2, keepdims=False)
        s_own = jnp.einsum('bhqd,bhkd->bhqk', qc, kown).astype(jnp.float32) * scale
        rel_own = qpos[:, None] - (own * MOBA_BLOCK + blk_off)[None, :]
        bias_own = rel_bias[t5_bucket(rel_own)].astype(jnp.float32).transpose(2, 0, 1)
        s_own = jnp.where(rel_own >= 0, s_own + bias_own, MASK_VALUE)
        logits = jnp.concatenate(
            [s_sel.reshape(B, H, Q_CHUNK, n_sel * MOBA_BLOCK), s_own], axis=-1)
        p = jax.nn.softmax(logits, axis=-1).astype(v.dtype)
        p_sel = p[..., :n_sel * MOBA_BLOCK].reshape(B, H, Q_CHUNK, n_sel, MOBA_BLOCK)
        p_own = p[..., n_sel * MOBA_BLOCK:]
        return (jnp.einsum('bhqjk,bhqjkd->bhqd', p_sel, vsel)
                + jnp.einsum('bhqk,bhkd->bhqd', p_own, vown))

    out = lax.map(chunk, jnp.arange(S // Q_CHUNK))
    return out.transpose(1, 0, 3, 2, 4).reshape(B, S, H * Dh)


def _complex_affine_combine(e1, e2):
    a1r, a1i, b1r, b1i = e1
    a2r, a2i, b2r, b2i = e2
    return (a2r * a1r - a2i * a1i,
            a2r * a1i + a2i * a1r,
            a2r * b1r - a2i * b1i + b2r,
            a2r * b1i + a2i * b1r + b2i)


def s5_branch(u, lambda_re, lambda_im, log_dt, b_re, b_im, c_re, c_im, d_skip, w_glu, b_glu):
    B, S, _ = u.shape
    f32 = jnp.float32
    uf = u.astype(f32)
    ug = uf.reshape(B, S, SSM_GROUPS, SSM_GROUP)
    lam_re = jnp.minimum(lambda_re.astype(f32), -1e-4)
    lam_im = lambda_im.astype(f32)
    dt = jnp.exp(log_dt.astype(f32))[:, None]
    mag = jnp.exp(lam_re * dt)
    a_re = mag * jnp.cos(lam_im * dt)
    a_im = mag * jnp.sin(lam_im * dt)
    den = lam_re * lam_re + lam_im * lam_im
    nr = a_re - 1.0
    coef_re = (nr * lam_re + a_im * lam_im) / den
    coef_im = (a_im * lam_re - nr * lam_im) / den
    br = b_re.astype(f32)
    bi = b_im.astype(f32)
    bbar_re = coef_re[..., None] * br - coef_im[..., None] * bi
    bbar_im = coef_re[..., None] * bi + coef_im[..., None] * br
    bu_re = jnp.einsum('bsgc,gpc->bsgp', ug, bbar_re)
    bu_im = jnp.einsum('bsgc,gpc->bsgp', ug, bbar_im)
    a_re_b = jnp.broadcast_to(a_re, bu_re.shape)
    a_im_b = jnp.broadcast_to(a_im, bu_re.shape)
    _, _, h_re, h_im = lax.associative_scan(
        _complex_affine_combine, (a_re_b, a_im_b, bu_re, bu_im), axis=1)
    y = (jnp.einsum('gcp,bsgp->bsgc', c_re.astype(f32), h_re)
         - jnp.einsum('gcp,bsgp->bsgc', c_im.astype(f32), h_im))
    y = y.reshape(B, S, SSM_WIDTH) + d_skip.astype(f32) * uf
    g = jax.nn.gelu(y)
    out = g * jax.nn.sigmoid(g @ w_glu.astype(f32) + b_glu.astype(f32))
    return out.astype(u.dtype)


def routed_experts(xf, top_idx, top_w, w_gate, w_up, w_down):
    n_tok = xf.shape[0]
    n_assign = n_tok * TOP_K
    flat_e = top_idx.reshape(n_assign).astype(jnp.int32)
    flat_tok = jnp.arange(n_assign, dtype=jnp.int32) // TOP_K
    flat_w = top_w.reshape(n_assign)
    order = jnp.argsort(flat_e, stable=True)
    se = flat_e[order]
    stok = flat_tok[order]
    sw = flat_w[order]
    counts = jnp.bincount(flat_e, length=N_EXPERTS)
    offs = jnp.cumsum(counts) - counts
    padded = (counts + EXPERT_BLOCK - 1) // EXPERT_BLOCK * EXPERT_BLOCK
    pend = jnp.cumsum(padded)
    poffs = pend - padded
    dest = poffs[se] + jnp.arange(n_assign, dtype=jnp.int32) - offs[se]
    n_blocks = -(-n_assign // EXPERT_BLOCK) + N_EXPERTS
    rows = n_blocks * EXPERT_BLOCK
    blk_tok = jnp.zeros((rows,), jnp.int32).at[dest].set(stok).reshape(n_blocks, EXPERT_BLOCK)
    blk_w = jnp.zeros((rows,), xf.dtype).at[dest].set(sw).reshape(n_blocks, EXPERT_BLOCK)
    blk_e = jnp.minimum(
        jnp.searchsorted(pend, jnp.arange(n_blocks) * EXPERT_BLOCK, side='right'),
        N_EXPERTS - 1).astype(jnp.int32)

    def body(acc, blk):
        tok, wgt, e = blk
        xb = xf[tok]
        hb = jax.nn.silu(xb @ w_gate[e]) * (xb @ w_up[e])
        return acc.at[tok].add((hb @ w_down[e]) * wgt[:, None]), None

    out, _ = lax.scan(body, jnp.zeros_like(xf), (blk_tok, blk_w, blk_e))
    return out


def moe_ffn(h, w_router, router_bias, w_exp_gate, w_exp_up, w_exp_down,
            w_sh_gate, w_sh_up, w_sh_down):
    B, S, D = h.shape
    n_tok = B * S
    xf = h.reshape(n_tok, D)
    scores = jax.nn.sigmoid((xf @ w_router).astype(jnp.float32))
    biased = scores + router_bias.astype(jnp.float32)
    grouped = biased.reshape(n_tok, N_EXPERT_GROUPS, N_EXPERTS // N_EXPERT_GROUPS)
    group_score = jnp.sum(lax.top_k(grouped, 2)[0], axis=-1)
    _, top_groups = lax.top_k(group_score, TOPK_GROUPS)
    group_mask = jnp.sum(jax.nn.one_hot(top_groups, N_EXPERT_GROUPS, dtype=jnp.float32), axis=1) > 0
    expert_mask = jnp.repeat(group_mask, N_EXPERTS // N_EXPERT_GROUPS, axis=1)
    _, top_idx = lax.top_k(jnp.where(expert_mask, biased, MASK_VALUE), TOP_K)
    top_w = jnp.take_along_axis(scores, top_idx, axis=-1)
    top_w = top_w / jnp.sum(top_w, axis=-1, keepdims=True) * ROUTED_SCALE
    routed = routed_experts(xf, top_idx, top_w.astype(xf.dtype), w_exp_gate, w_exp_up, w_exp_down)
    shared = (jax.nn.silu(xf @ w_sh_gate) * (xf @ w_sh_up)) @ w_sh_down
    return (routed + shared).reshape(B, S, D)


def hybrid_layer(x, cond, rel_bias, w_ada, b_ada, ln1_g, w_in, q_norm_g, k_norm_g,
                 ssm_lambda_re, ssm_lambda_im, ssm_log_dt, ssm_b_re, ssm_b_im, ssm_c_re, ssm_c_im,
                 ssm_d, ssm_w_glu, ssm_b_glu, w_up_attn, w_up_ssm, w_out, ln2_g,
                 w_router, router_bias, w_exp_gate, w_exp_up, w_exp_down,
                 w_sh_gate, w_sh_up, w_sh_down):
    B, S, D = x.shape
    mod = jax.nn.silu(cond) @ w_ada + b_ada
    sh1, sc1, g1, sh2, sc2, g2 = jnp.split(mod[:, None, :], 6, axis=-1)
    h = rms_norm(x, ln1_g) * (1.0 + sc1) + sh1
    proj = h @ w_in
    q, k, v, u, ga, gs = jnp.split(proj, IN_SPLITS, axis=-1)
    q = rms_norm(q.reshape(B, S, ATTN_HEADS, HEAD_DIM), q_norm_g).transpose(0, 2, 1, 3)
    k = rms_norm(k.reshape(B, S, ATTN_HEADS, HEAD_DIM), k_norm_g).transpose(0, 2, 1, 3)
    v = v.reshape(B, S, ATTN_HEADS, HEAD_DIM).transpose(0, 2, 1, 3)
    y_attn = moba_attention(q, k, v, rel_bias) @ w_up_attn
    y_ssm = s5_branch(u, ssm_lambda_re, ssm_lambda_im, ssm_log_dt, ssm_b_re, ssm_b_im,
                      ssm_c_re, ssm_c_im, ssm_d, ssm_w_glu, ssm_b_glu) @ w_up_ssm
    mixed = jax.nn.sigmoid(ga) * y_attn + jax.nn.sigmoid(gs) * y_ssm
    x = x + g1 * (mixed @ w_out)
    h2 = rms_norm(x, ln2_g) * (1.0 + sc2) + sh2
    y = moe_ffn(h2, w_router, router_bias, w_exp_gate, w_exp_up, w_exp_down,
                w_sh_gate, w_sh_up, w_sh_down)
    return x + g2 * y


def setup_inputs(seed: int = 0) -> dict:
    key = jax.random.key(seed)
    ks = jax.random.split(key, 40)
    L = DEPTH
    f32 = jnp.float32

    def nrm(k, shape, scale):
        return jax.random.normal(k, shape, f32) * scale

    n_idx = jnp.arange(SSM_STATE, dtype=f32)
    return {
        "x": nrm(ks[0], (BATCH, SEQ, D_MODEL), 1.0),
        "c": nrm(ks[1], (BATCH, D_MODEL), 1.0),
        "rel_bias": nrm(ks[2], (NUM_BUCKETS, ATTN_HEADS), 0.1),
        "w_ada": nrm(ks[3], (L, D_MODEL, 6 * D_MODEL), 0.5 * D_MODEL ** -0.5),
        "b_ada": nrm(ks[4], (L, 6 * D_MODEL), 0.02),
        "ln1_g": 1.0 + nrm(ks[5], (L, D_MODEL), 0.02),
        "w_in": nrm(ks[6], (L, D_MODEL, IN_WIDTH), D_MODEL ** -0.5),
        "q_norm_g": 1.0 + nrm(ks[7], (L, HEAD_DIM), 0.02),
        "k_norm_g": 1.0 + nrm(ks[8], (L, HEAD_DIM), 0.02),
        "ssm_lambda_re": -0.5 + nrm(ks[9], (L, SSM_GROUPS, SSM_STATE), 0.01),
        "ssm_lambda_im": jnp.pi * n_idx + nrm(ks[10], (L, SSM_GROUPS, SSM_STATE), 0.01),
        "ssm_log_dt": jax.random.uniform(ks[11], (L, SSM_GROUPS), f32,
                                         minval=math.log(DT_MIN), maxval=math.log(DT_MAX)),
        "ssm_b_re": nrm(ks[12], (L, SSM_GROUPS, SSM_STATE, SSM_GROUP), (2 * SSM_GROUP) ** -0.5),
        "ssm_b_im": nrm(ks[13], (L, SSM_GROUPS, SSM_STATE, SSM_GROUP), (2 * SSM_GROUP) ** -0.5),
        "ssm_c_re": nrm(ks[14], (L, SSM_GROUPS, SSM_GROUP, SSM_STATE), SSM_STATE ** -0.5),
        "ssm_c_im": nrm(ks[15], (L, SSM_GROUPS, SSM_GROUP, SSM_STATE), SSM_STATE ** -0.5),
        "ssm_d": nrm(ks[16], (L, SSM_WIDTH), 1.0),
        "ssm_w_glu": nrm(ks[17], (L, SSM_WIDTH, SSM_WIDTH), SSM_WIDTH ** -0.5),
        "ssm_b_glu": nrm(ks[18], (L, SSM_WIDTH), 0.02),
        "w_up_attn": nrm(ks[19], (L, ATTN_WIDTH, D_MODEL), ATTN_WIDTH ** -0.5),
        "w_up_ssm": nrm(ks[20], (L, SSM_WIDTH, D_MODEL), SSM_WIDTH ** -0.5),
        "w_out": nrm(ks[21], (L, D_MODEL, D_MODEL), D_MODEL ** -0.5),
        "ln2_g": 1.0 + nrm(ks[22], (L, D_MODEL), 0.02),
        "w_router": nrm(ks[23], (L, D_MODEL, N_EXPERTS), D_MODEL ** -0.5),
        "router_bias": nrm(ks[24], (L, N_EXPERTS), 0.01),
        "w_exp_gate": nrm(ks[25], (L, N_EXPERTS, D_MODEL, EXPERT_DIM), D_MODEL ** -0.5),
        "w_exp_up": nrm(ks[26], (L, N_EXPERTS, D_MODEL, EXPERT_DIM), D_MODEL ** -0.5),
        "w_exp_down": nrm(ks[27], (L, N_EXPERTS, EXPERT_DIM, D_MODEL), EXPERT_DIM ** -0.5),
        "w_sh_gate": nrm(ks[28], (L, D_MODEL, SHARED_DIM), D_MODEL ** -0.5),
        "w_sh_up": nrm(ks[29], (L, D_MODEL, SHARED_DIM), D_MODEL ** -0.5),
        "w_sh_down": nrm(ks[30], (L, SHARED_DIM, D_MODEL), SHARED_DIM ** -0.5),
    }


def reference(x, c, rel_bias, w_ada, b_ada, ln1_g, w_in, q_norm_g, k_norm_g,
              ssm_lambda_re, ssm_lambda_im, ssm_log_dt, ssm_b_re, ssm_b_im, ssm_c_re, ssm_c_im,
              ssm_d, ssm_w_glu, ssm_b_glu, w_up_attn, w_up_ssm, w_out, ln2_g,
              w_router, router_bias, w_exp_gate, w_exp_up, w_exp_down,
              w_sh_gate, w_sh_up, w_sh_down):
    for l in range(DEPTH):
        x = hybrid_layer(x, c, rel_bias, w_ada[l], b_ada[l], ln1_g[l], w_in[l],
                         q_norm_g[l], k_norm_g[l],
                         ssm_lambda_re[l], ssm_lambda_im[l], ssm_log_dt[l], ssm_b_re[l],
                         ssm_b_im[l], ssm_c_re[l], ssm_c_im[l], ssm_d[l], ssm_w_glu[l],
                         ssm_b_glu[l], w_up_attn[l], w_up_ssm[l], w_out[l], ln2_g[l],
                         w_router[l], router_bias[l], w_exp_gate[l], w_exp_up[l],
                         w_exp_down[l], w_sh_gate[l], w_sh_up[l], w_sh_down[l])
    return x
```

```cpp
#include <hip/hip_runtime.h>
#include <cstdio>
#include <cstdint>

#ifndef MK_PER_PHASE
#define MK_PER_PHASE 0
#endif

#define LAS __attribute__((address_space(3)))
#define GAS __attribute__((address_space(1)))
typedef unsigned short bf16_t;
typedef short bf16x8 __attribute__((ext_vector_type(8)));
typedef short s16x4 __attribute__((ext_vector_type(4)));
typedef float f32x2 __attribute__((ext_vector_type(2)));
typedef float f32x4 __attribute__((ext_vector_type(4)));
typedef float f32x16 __attribute__((ext_vector_type(16)));
typedef unsigned u32x2 __attribute__((ext_vector_type(2)));
typedef unsigned u32x4 __attribute__((ext_vector_type(4)));
typedef __bf16 bf16x2_t __attribute__((ext_vector_type(2)));

#define DI __device__ __forceinline__
DI unsigned pk2(float lo, float hi) { f32x2 v = {lo, hi}; bf16x2_t b = __builtin_convertvector(v, bf16x2_t); return __builtin_bit_cast(unsigned, b); }
DI float bflo(unsigned w) { return __uint_as_float(w << 16); }
DI float bfhi(unsigned w) { return __uint_as_float(w & 0xffff0000u); }
DI float sigmoidf_(float x) { return 1.0f / (1.0f + __expf(-x)); }
DI float siluf_(float x) { return x / (1.0f + __expf(-x)); }
DI float gelu_tanh(float y) { const float z = 0.7978845608028654f * (y + 0.044715f * y * y * y); const float t = 1.0f - 2.0f / (__expf(2.0f * z) + 1.0f); return 0.5f * y * (1.0f + t); }

constexpr int NB = 4, SEQ = 4096, DM = 1024, M = NB * SEQ;
constexpr int NH = 8, HD = 64, AW = 512, SW = 512, INW = 4096;
constexpr int NE = 256, ED = 256, TOPK = 8;
constexpr int NG = 32, GC = 16, NS = 64, CH = 16, NCH = SEQ / CH;
constexpr int MAXTILES = 768, MAXROWS = MAXTILES * 256;
constexpr float EPSF = 1e-6f;
constexpr float LOG2E = 1.4426950408889634f;
constexpr float QC2 = 0.125f * LOG2E;

constexpr size_t MiB = 1u << 20;
constexpr size_t WS_CTL = 0, CTL_ZERO_BYTES = 1 * MiB;
constexpr size_t WS_SMALL = 1 * MiB;
constexpr size_t WS_WIN = 4 * MiB, WS_WGLU = 12 * MiB, WS_WUPA = 13 * MiB, WS_WUPS = 14 * MiB, WS_WOUT = 15 * MiB, WS_WRSH = 17 * MiB, WS_WSHD = 19 * MiB;
constexpr size_t WS_TF = 20 * MiB, WS_ET = 26 * MiB;
constexpr size_t WS_WEGU = 32 * MiB, WS_WED = 288 * MiB;
constexpr size_t WS_H = 416 * MiB;
constexpr size_t WS_Q = 448 * MiB, WS_K = 464 * MiB, WS_V = 480 * MiB;
constexpr size_t WS_ASSM = 496 * MiB, WS_HLOC = 520 * MiB;
constexpr size_t WS_GBUF = 536 * MiB, WS_SOUT = 552 * MiB;
constexpr size_t WS_SGA = 568 * MiB, WS_SGS = 600 * MiB;
constexpr size_t WS_P1 = 632 * MiB, WS_MIX = 664 * MiB;
constexpr size_t WS_SCORES = 696 * MiB, WS_HS = 712 * MiB, WS_YSH = 720 * MiB;
constexpr size_t WS_ROUTE = 752 * MiB;
constexpr size_t WS_HSORT = 760 * MiB;
constexpr size_t WS_Y = 416 * MiB;
constexpr size_t WS_END = 856 * MiB;
constexpr int CW_BAR = 4096;
constexpr int CW_CNT = 16384;
constexpr int CW_KMEAN = 32768;

constexpr int RING_BYTES = 131072;
constexpr int GTAB_OFF = RING_BYTES;
constexpr int TILEE_OFF = GTAB_OFF + 2048;
constexpr int SCAN_OFF = TILEE_OFF + 1536;
constexpr int MISC_OFF = SCAN_OFF + 2048;
constexpr int LDS_BYTES = 147456;
static_assert(MISC_OFF + 256 <= LDS_BYTES, "LDS map");

namespace pg8 {
constexpr int BM = 256, BK = 64, HALF = 128, HTB = HALF * BK * 2, STAGE_BYTES = 8 * HTB, NXCD = 8, WGM = 8;
__host__ __device__ __forceinline__ int lds_byte(int r, int c) { const int st = (r >> 4) * 2 + (c >> 5), rr = r & 15, cc = c & 31, ob = rr * 64 + cc * 2; return st * 1024 + (ob ^ (((ob >> 9) & 1) << 5)); }
__host__ __device__ __forceinline__ void stage_rc(int b, int& R, int& C) { const int st = b / 1024, sb = b % 1024, swz = sb ^ (((sb >> 9) & 1) << 5); R = (st >> 1) * 16 + swz / 64; C = (st & 1) * 32 + (swz % 64) / 2; }
__host__ __device__ __forceinline__ int perm32(int rho) { const int n = rho >> 4, i = rho & 15; return 8 * (i >> 2) + 4 * n + (i & 3); }

struct Unit { const char* A; const char* B; const int* rowtab; int pm, pn, aux; };
struct Gemm { int lda, ldb, K; };

struct StaticOrder {
    int nM, nN, nwg, G, c;
    __device__ void init(int M_, int N_, int G_, int c_) { nM = M_ / BM; nN = N_ / BM; nwg = nM * nN; G = G_; c = c_; }
    __device__ bool next(int i, int& pm, int& pn) const {
        const long L = (long)i * G + c; if (L >= nwg) return false;
        int wgid = (int)L; { const int q = nwg / NXCD, r = nwg % NXCD, xcd = wgid % NXCD, off = wgid / NXCD; wgid = (xcd < r ? xcd * (q + 1) : r * (q + 1) + (xcd - r) * q) + off; }
        const int nig = WGM * nN, gid = wgid / nig, fm = gid * WGM, gsz = (nM - fm) < WGM ? (nM - fm) : WGM;
        pm = fm + ((wgid % nig) % gsz); pn = (wgid % nig) / gsz; return true;
    }
};

template <class Epi, class Sched, bool ALIGN_EPI, bool GATHER>
__device__ __forceinline__ void gemm_phase(LAS unsigned char* lds, LAS unsigned* gtab, const int wid, const Gemm g, const Sched& S, const Epi& E) {
    const int lane = (int)__builtin_amdgcn_mbcnt_hi(~0u, __builtin_amdgcn_mbcnt_lo(~0u, 0u)), tid = wid * 64 + lane, wr = wid >> 2, wc = wid & 3, fr = lane & 15, fq = lane >> 4;
    const int K = g.K, nt = K / BK;
    unsigned voffA[2], voffB[2]; int gR[2];
#pragma unroll
    for (int i = 0; i < 2; ++i) { int R, C; stage_rc(tid * 16 + i * 8192, R, C); const int Rb = Epi::PERM ? ((R & ~31) + perm32(R & 31)) : R;
        voffA[i] = GATHER ? (unsigned)(C * 2) : (unsigned)(R * g.lda + C) * 2u; voffB[i] = (unsigned)(Rb * g.ldb + C) * 2u; gR[i] = R; }
    const size_t kstep = (size_t)(BK * 2);
    const size_t hstepA = (size_t)HALF * g.lda * 2, hstepB = (size_t)HALF * g.ldb * 2;
    const unsigned ldsw = (unsigned)wid * 1024u;
    const int aoff = lds_byte(wr * 64 + fr, fq * 8), boff = lds_byte(wc * 32 + fr, fq * 8);
#define PG8_SA(b, h) (((b) * 2 + (h)) * HTB)
#define PG8_SB(b, h) ((4 + (b) * 2 + (h)) * HTB)
#define PG8_STAGEB(bufoff, gbase) do { _Pragma("unroll") for (int _i = 0; _i < 2; ++_i) \
        __builtin_amdgcn_global_load_lds((const unsigned*)((const char*)(gbase) + voffB[_i]), (LAS unsigned*)(lds + (bufoff) + ldsw + _i * 8192), 16, 0, 0); } while (0)
#define PG8_STAGEA(bufoff, gbase, par, half) do { _Pragma("unroll") for (int _i = 0; _i < 2; ++_i) { \
        const char* _src = GATHER ? ((const char*)(gbase) + gtab[(par) * 256 + (half) * 128 + gR[_i]] + voffA[_i]) : ((const char*)(gbase) + (size_t)(half) * hstepA + voffA[_i]); \
        __builtin_amdgcn_global_load_lds((const unsigned*)_src, (LAS unsigned*)(lds + (bufoff) + ldsw + _i * 8192), 16, 0, 0); } } while (0)
#define PG8_TABLOAD(par, un) do { __builtin_amdgcn_global_load_lds((const unsigned*)((un).rowtab + 64 * (wid & 3) + lane), (LAS unsigned*)(gtab + (par) * 256 + 64 * (wid & 3)), 4, 0, 0); } while (0)
#define PG8_LDA(dst, b, h) do { _Pragma("unroll") for (int m = 0; m < 4; ++m) _Pragma("unroll") for (int k = 0; k < 2; ++k) dst[m][k] = *(const LAS bf16x8*)(lds + PG8_SA(b, h) + aoff + m * 2048 + k * 1024); } while (0)
#define PG8_LDB(dst, b, h) do { _Pragma("unroll") for (int n = 0; n < 2; ++n) _Pragma("unroll") for (int k = 0; k < 2; ++k) dst[n][k] = *(const LAS bf16x8*)(lds + PG8_SB(b, h) + boff + n * 2048 + k * 1024); } while (0)
#define PG8_MMA(ai, bj, At, Bt) do { __builtin_amdgcn_s_setprio(1); _Pragma("unroll") for (int m = 0; m < 4; ++m) _Pragma("unroll") for (int n = 0; n < 2; ++n) _Pragma("unroll") for (int k = 0; k < 2; ++k) \
        acc[ai][bj][m][n] = __builtin_amdgcn_mfma_f32_16x16x32_bf16(Bt[n][k], At[m][k], acc[ai][bj][m][n], 0, 0, 0); __builtin_amdgcn_s_setprio(0); } while (0)
#define PG8_WAIT_V(n) asm volatile("s_waitcnt vmcnt(" #n ")" ::: "memory")
#define PG8_WAIT_L(n) asm volatile("s_waitcnt lgkmcnt(" #n ")" ::: "memory")
#define PG8_BAR __builtin_amdgcn_s_barrier()
#define PG8_SCHED __builtin_amdgcn_sched_barrier(0)
    Unit cur, nxt; int ui = 0;
    if (!S.next(0, cur)) return;
    f32x4 acc[2][2][4][2];
#pragma unroll
    for (int a = 0; a < 2; ++a)
#pragma unroll
        for (int b = 0; b < 2; ++b)
#pragma unroll
            for (int m = 0; m < 4; ++m)
#pragma unroll
                for (int n = 0; n < 2; ++n) acc[a][b][m][n] = (f32x4){0.f, 0.f, 0.f, 0.f};
    bf16x8 At[4][2], B0[2][2], B1[2][2];
    const char* cA = cur.A; const char* cB = cur.B;
    if constexpr (GATHER) { PG8_TABLOAD(0, cur); PG8_WAIT_V(0); PG8_BAR; }
    PG8_STAGEB(PG8_SB(0, 0), cB); PG8_STAGEB(PG8_SB(0, 1), cB + hstepB); PG8_STAGEA(PG8_SA(0, 0), cA, 0, 0); PG8_STAGEA(PG8_SA(0, 1), cA, 0, 1);
    if (wr == 1) PG8_BAR;
    PG8_WAIT_V(2); PG8_BAR;
    PG8_STAGEB(PG8_SB(1, 0), cB + kstep); PG8_STAGEA(PG8_SA(1, 0), cA + kstep, 0, 0); PG8_STAGEB(PG8_SB(1, 1), cB + hstepB + kstep);
    PG8_WAIT_V(6); PG8_BAR;
    for (;;) {
        const bool has_next = S.next(ui + 1, nxt);
        const char* nA = has_next ? nxt.A : cA; const char* nB = has_next ? nxt.B : cB;
        const int pc = ui & 1, pnx = has_next ? (pc ^ 1) : pc;
        if constexpr (GATHER) { if (has_next) PG8_TABLOAD(pc ^ 1, nxt); }
#pragma unroll 1
        for (int t = 0; t < nt; t += 2) {
            const bool last = (t == nt - 2);
            const char* a1 = cA + (size_t)(t + 1) * kstep;
            const char* a2 = last ? nA : cA + (size_t)(t + 2) * kstep; const char* b2 = last ? nB : cB + (size_t)(t + 2) * kstep;
            const char* a3 = a2 + kstep; const char* b3 = b2 + kstep;
            const int p2 = last ? pnx : pc;
            PG8_LDB(B0, 0, 0); PG8_LDB(B1, 0, 1); PG8_SCHED; PG8_LDA(At, 0, 0); PG8_STAGEA(PG8_SA(1, 1), a1, pc, 1);
            PG8_WAIT_V(8); PG8_WAIT_L(0); PG8_BAR; PG8_MMA(0, 0, At, B0); PG8_MMA(0, 1, At, B1); PG8_BAR; PG8_SCHED;
            PG8_LDA(At, 0, 1); PG8_STAGEB(PG8_SB(0, 0), b2); PG8_STAGEB(PG8_SB(0, 1), b2 + hstepB); PG8_STAGEA(PG8_SA(0, 0), a2, p2, 0);
            PG8_WAIT_V(8); PG8_WAIT_L(0); PG8_BAR; PG8_MMA(1, 0, At, B0); PG8_MMA(1, 1, At, B1); PG8_BAR; PG8_SCHED;
            PG8_LDB(B0, 1, 0); PG8_LDB(B1, 1, 1); PG8_SCHED; PG8_LDA(At, 1, 0); PG8_STAGEA(PG8_SA(0, 1), a2, p2, 1);
            PG8_WAIT_V(8); PG8_WAIT_L(0); PG8_BAR; PG8_MMA(0, 0, At, B0); PG8_MMA(0, 1, At, B1); PG8_BAR; PG8_SCHED;
            PG8_LDA(At, 1, 1); PG8_STAGEB(PG8_SB(1, 0), b3); PG8_STAGEB(PG8_SB(1, 1), b3 + hstepB); PG8_STAGEA(PG8_SA(1, 0), a3, p2, 0);
            PG8_WAIT_V(8); PG8_WAIT_L(0); PG8_BAR; PG8_MMA(1, 0, At, B0); PG8_MMA(1, 1, At, B1); PG8_BAR; PG8_SCHED;
        }
        if constexpr (ALIGN_EPI) { if (wr == 0) PG8_BAR; }
        { int fr_ = fr, fq_ = fq; asm volatile("" : "+v"(fr_), "+v"(fq_)); E(acc, cur, wr, wc, fr_, fq_); }
        if (!has_next) break;
#pragma unroll
        for (int a = 0; a < 2; ++a)
#pragma unroll
            for (int b = 0; b < 2; ++b)
#pragma unroll
                for (int m = 0; m < 4; ++m)
#pragma unroll
                    for (int n = 0; n < 2; ++n) acc[a][b][m][n] = (f32x4){0.f, 0.f, 0.f, 0.f};
        cur = nxt; cA = nA; cB = nB; ++ui;
        if constexpr (ALIGN_EPI) { if (wr == 1) PG8_BAR; }
    }
    PG8_WAIT_V(0);
    if constexpr (!ALIGN_EPI) { if (wr == 0) PG8_BAR; }
    PG8_BAR;
#undef PG8_SA
#undef PG8_SB
#undef PG8_STAGEA
#undef PG8_STAGEB
#undef PG8_TABLOAD
#undef PG8_LDA
#undef PG8_LDB
#undef PG8_MMA
#undef PG8_WAIT_V
#undef PG8_WAIT_L
#undef PG8_BAR
#undef PG8_SCHED
}
}

typedef f32x4 AccT[2][2][4][2];
using pg8::Unit;

typedef GAS unsigned gu32;
#define XB_TMO      128
#define XB_XCNT(j)  (256  + 64 * (j))
#define XB_XSUB(j)  (1280 + 64 * (j))
#define XB_XGEN(j)  (2304 + 64 * (j))
#define XB_TOP      3328
#define XB_TOPGEN   3392
#define XCD_BAR_WORDS 3456
#define XB_SPIN_CAP (1u << 20)
DI unsigned xb_ld(unsigned* p)              { return __hip_atomic_load(p, __ATOMIC_RELAXED, __HIP_MEMORY_SCOPE_AGENT); }
DI unsigned xb_add(unsigned* p, unsigned v) { return __hip_atomic_fetch_add(p, v, __ATOMIC_RELAXED, __HIP_MEMORY_SCOPE_AGENT); }
DI unsigned xb_xcc_id() { return (unsigned)__builtin_amdgcn_s_getreg((3 << 11) | 20) & 0xFu; }
#define XB_SPIN(cond, bar) do { unsigned _sp = 0; while (cond) { __builtin_amdgcn_s_sleep(1); \
    if ((++_sp & 255u) == 0u) { if (xb_ld(&(bar)[XB_TMO])) break; if (_sp > XB_SPIN_CAP) { atomicAdd(&(bar)[XB_TMO], 1u); break; } } } } while (0)
DI int lane_id() { return (int)__builtin_amdgcn_mbcnt_hi(~0u, __builtin_amdgcn_mbcnt_lo(~0u, 0u)); }
struct XcdBarrier { unsigned* bar; unsigned x; volatile LAS unsigned* st; int wave; };
DI XcdBarrier xcd_barrier_post(unsigned* bar, volatile LAS unsigned* st, int wave) {
    XcdBarrier b; b.bar = bar; b.x = xb_xcc_id(); b.st = st; b.wave = wave;
    if (wave == 0 && lane_id() == 0) (void)xb_add(&bar[XB_XCNT(b.x)], 1u);
    return b;
}
DI void xcd_barrier_complete(unsigned* bar, unsigned x, unsigned& nloc, unsigned& nx) {
    const unsigned G = gridDim.x * gridDim.y * gridDim.z;
    unsigned sum, cnt, mine, sp = 0u;
    for (;;) {
        sum = 0u; cnt = 0u; mine = 0u;
#pragma unroll
        for (unsigned j = 0; j < 16; ++j) { const unsigned c = xb_ld(&bar[XB_XCNT(j)]); sum += c; cnt += (c > 0u) ? 1u : 0u; mine = (j == x) ? c : mine; }
        if (sum == G) break;
        __builtin_amdgcn_s_sleep(1);
        if ((++sp & 255u) == 0u) { if (xb_ld(&bar[XB_TMO])) break; if (sp > XB_SPIN_CAP) { atomicAdd(&bar[XB_TMO], 1u); break; } }
    }
    nloc = mine > 0u ? mine : 1u; nx = cnt > 0u ? cnt : 1u;
}
DI void xcd_barrier(const XcdBarrier& b) {
    asm volatile("s_waitcnt vmcnt(0)" ::: "memory");
    __syncthreads();
    if (b.wave == 0 && lane_id() == 0) {
        unsigned* bar = b.bar;
        __builtin_amdgcn_s_waitcnt(0);
        unsigned nloc = b.st[0], nx = b.st[1];
        if (nloc == 0u) { xcd_barrier_complete(bar, b.x, nloc, nx); b.st[0] = nloc; b.st[1] = nx; }
        const unsigned old = xb_add(&bar[XB_XSUB(b.x)], 1u);
        const unsigned gen = old / nloc;
        if (old + 1u == (gen + 1u) * nloc) {
            __builtin_amdgcn_fence(__ATOMIC_RELEASE, "agent");
            asm volatile("s_waitcnt vmcnt(0)" ::: "memory");
            const unsigned og = xb_add(&bar[XB_TOP], 1u);
            const unsigned tg = og / nx;
            if (og + 1u == (tg + 1u) * nx) xb_add(&bar[XB_TOPGEN], 1u);
            else XB_SPIN(xb_ld(&bar[XB_TOPGEN]) == tg, bar);
            __builtin_amdgcn_fence(__ATOMIC_ACQUIRE, "agent");
            xb_add(&bar[XB_XGEN(b.x)], 1u);
            asm volatile("s_waitcnt vmcnt(0)" ::: "memory");
        } else {
            XB_SPIN(xb_ld(&bar[XB_XGEN(b.x)]) == gen, bar);
            __builtin_amdgcn_fence(__ATOMIC_ACQUIRE, "agent");
            asm volatile("s_waitcnt vmcnt(0)" ::: "memory");
        }
    }
    __syncthreads();
}

struct Args { const float* in[31]; float* out; unsigned char* ws; int ph_lo, ph_hi; };
struct InTab { const float* const* p; DI const float* operator[](int i) const { return p[i]; } };
struct Frame {
    LAS unsigned char* lds; int wave, vcu, G;
    InTab in; float* out; unsigned char* ws;
    DI int lane_() const { return lane_id(); }
    DI int tid_() const { return wave * 64 + lane_id(); }
};
#define FTID (F.tid_())
#define FLANE (F.lane_())
#define IN_X 0
#define IN_C 1
#define IN_RELB 2
#define IN_WADA 3
#define IN_BADA 4
#define IN_LN1G 5
#define IN_WIN 6
#define IN_QG 7
#define IN_KG 8
#define IN_LRE 9
#define IN_LIM 10
#define IN_LDT 11
#define IN_BRE 12
#define IN_BIM 13
#define IN_CRE 14
#define IN_CIM 15
#define IN_SSMD 16
#define IN_WGLU 17
#define IN_BGLU 18
#define IN_WUPA 19
#define IN_WUPS 20
#define IN_WOUT 21
#define IN_LN2G 22
#define IN_WROUTER 23
#define IN_RBIAS 24
#define IN_WEG 25
#define IN_WEU 26
#define IN_WED 27
#define IN_WSG 28
#define IN_WSU 29
#define IN_WSD 30

DI float wave_sum(float v) {
#pragma unroll
    for (int o = 1; o < 64; o <<= 1) v += __shfl_xor(v, o);
    return v;
}

template <class RowMap>
DI void tr_item(const float* W, int N, bf16_t* WT, int ldt, int k0, int n0, int lane, RowMap rm) {
    float v[64];
    const float* src = W + (size_t)k0 * N + n0 + lane;
#pragma unroll
    for (int i = 0; i < 64; ++i) v[i] = src[(size_t)i * N];
    bf16_t* dst = WT + (size_t)rm(n0 + lane) * ldt + k0;
#pragma unroll
    for (int j = 0; j < 8; ++j) { u32x4 o; o.x = pk2(v[8 * j], v[8 * j + 1]); o.y = pk2(v[8 * j + 2], v[8 * j + 3]); o.z = pk2(v[8 * j + 4], v[8 * j + 5]); o.w = pk2(v[8 * j + 6], v[8 * j + 7]);
        *(u32x4*)(dst + 8 * j) = o; }
}
struct RmId { DI int operator()(int n) const { return n; } };
struct RmAdd { int off; DI int operator()(int n) const { return n + off; } };
struct RmWin { DI int operator()(int n) const { if (n >= 1024) return n; const int tile = n >> 8, w = n & 255, hh = w >> 6, bj = (w >> 5) & 1, i = w & 31; return tile * 256 + 128 * bj + 32 * hh + i; } };
struct RmGU { int base; DI int operator()(int c) const { return base + 256 * (c >> 7) + (c & 127); } };

DI void p0_convert(Frame& F) {
    const int gw = F.vcu * 8 + F.wave, NGW = F.G * 8, lane = FLANE;
    unsigned char* ws = F.ws;
    constexpr int I_WIN = 16 * 64, I_GLU = 8 * 8, I_UPA = 8 * 16, I_UPS = 8 * 16, I_OUT = 16 * 16, I_RT = 16 * 4, I_SG = 16 * 4, I_SU = 16 * 4, I_SD = 4 * 16;
    constexpr int I_SMALL = I_WIN + I_GLU + I_UPA + I_UPS + I_OUT + I_RT + I_SG + I_SU + I_SD;
    constexpr int I_EG = 256 * 64, I_EU = 256 * 64, I_EDN = 256 * 64;
    constexpr int NITEMS = I_SMALL + I_EG + I_EU + I_EDN;
    for (int it = gw; it < NITEMS; it += NGW) {
        int r = it;
        if (r < I_WIN) { tr_item(F.in[IN_WIN], INW, (bf16_t*)(ws + WS_WIN), DM, 64 * (r / 64), 64 * (r % 64), lane, RmWin{}); continue; } r -= I_WIN;
        if (r < I_GLU) { tr_item(F.in[IN_WGLU], SW, (bf16_t*)(ws + WS_WGLU), SW, 64 * (r / 8), 64 * (r % 8), lane, RmId{}); continue; } r -= I_GLU;
        if (r < I_UPA) { tr_item(F.in[IN_WUPA], DM, (bf16_t*)(ws + WS_WUPA), AW, 64 * (r / 16), 64 * (r % 16), lane, RmId{}); continue; } r -= I_UPA;
        if (r < I_UPS) { tr_item(F.in[IN_WUPS], DM, (bf16_t*)(ws + WS_WUPS), SW, 64 * (r / 16), 64 * (r % 16), lane, RmId{}); continue; } r -= I_UPS;
        if (r < I_OUT) { tr_item(F.in[IN_WOUT], DM, (bf16_t*)(ws + WS_WOUT), DM, 64 * (r / 16), 64 * (r % 16), lane, RmId{}); continue; } r -= I_OUT;
        if (r < I_RT) { tr_item(F.in[IN_WROUTER], NE, (bf16_t*)(ws + WS_WRSH), DM, 64 * (r / 4), 64 * (r % 4), lane, RmId{}); continue; } r -= I_RT;
        if (r < I_SG) { tr_item(F.in[IN_WSG], ED, (bf16_t*)(ws + WS_WRSH), DM, 64 * (r / 4), 64 * (r % 4), lane, RmGU{256}); continue; } r -= I_SG;
        if (r < I_SU) { tr_item(F.in[IN_WSU], ED, (bf16_t*)(ws + WS_WRSH), DM, 64 * (r / 4), 64 * (r % 4), lane, RmGU{256 + 128}); continue; } r -= I_SU;
        if (r < I_SD) { tr_item(F.in[IN_WSD], DM, (bf16_t*)(ws + WS_WSHD), ED, 64 * (r / 16), 64 * (r % 16), lane, RmId{}); continue; } r -= I_SD;
        if (r < I_EG) { const int e = r / 64, q = r % 64; tr_item(F.in[IN_WEG] + (size_t)e * DM * ED, ED, (bf16_t*)(ws + WS_WEGU) + (size_t)e * 512 * DM, DM, 64 * (q / 4), 64 * (q % 4), lane, RmGU{0}); continue; } r -= I_EG;
        if (r < I_EU) { const int e = r / 64, q = r % 64; tr_item(F.in[IN_WEU] + (size_t)e * DM * ED, ED, (bf16_t*)(ws + WS_WEGU) + (size_t)e * 512 * DM, DM, 64 * (q / 4), 64 * (q % 4), lane, RmGU{128}); continue; } r -= I_EU;
        { const int e = r / 64, q = r % 64; tr_item(F.in[IN_WED] + (size_t)e * ED * DM, DM, (bf16_t*)(ws + WS_WED) + (size_t)e * DM * ED, ED, 64 * (q / 16), 64 * (q % 16), lane, RmId{}); }
    }
}
DI void p0_adaln(Frame& F, int cb) {
    LAS float* sc = (LAS float*)F.lds;
    LAS float* red = (LAS float*)(F.lds + 16384);
    for (int i = FTID; i < 4096; i += 512) sc[i] = siluf_(F.in[IN_C][i]);
    __syncthreads();
    const int j = cb * 64 + FLANE; const float* w = F.in[IN_WADA] + j;
    float a0 = 0.f, a1 = 0.f, a2 = 0.f, a3 = 0.f;
    const int kb = F.wave * 128;
#pragma unroll 8
    for (int k = 0; k < 128; ++k) { const float wv = w[(size_t)(kb + k) * 6144]; a0 += sc[kb + k] * wv; a1 += sc[1024 + kb + k] * wv; a2 += sc[2048 + kb + k] * wv; a3 += sc[3072 + kb + k] * wv; }
    red[(F.wave * 4 + 0) * 64 + FLANE] = a0; red[(F.wave * 4 + 1) * 64 + FLANE] = a1; red[(F.wave * 4 + 2) * 64 + FLANE] = a2; red[(F.wave * 4 + 3) * 64 + FLANE] = a3;
    __syncthreads();
    if (FTID < 256) { const int b = FTID >> 6, l = FTID & 63; float s = F.in[IN_BADA][cb * 64 + l];
#pragma unroll
        for (int w8 = 0; w8 < 8; ++w8) s += red[(w8 * 4 + b) * 64 + l];
        ((float*)(F.ws + WS_SMALL))[b * 6144 + cb * 64 + l] = s; }
    __syncthreads();
}
DI void p0_ssm(Frame& F, int g) {
    LAS float* apow = (LAS float*)F.lds;
    LAS float* bb = apow + 17 * 64 * 2;
    LAS float* cc = bb + 64 * 16 * 2;
    LAS float* km = cc + 16 * 64 * 2;
    const int tid = FTID;
    if (tid < 64) {
        const int p = tid;
        const float lre = fminf(F.in[IN_LRE][g * 64 + p], -1e-4f), lim = F.in[IN_LIM][g * 64 + p], dt = expf(F.in[IN_LDT][g]);
        const float mag = expf(lre * dt); float sn, cs; sincosf(lim * dt, &sn, &cs);
        const float are = mag * cs, aim = mag * sn, den = lre * lre + lim * lim, nr = are - 1.0f;
        const float cre = (nr * lre + aim * lim) / den, cim = (aim * lre - nr * lim) / den;
        for (int tau = 0; tau <= 16; ++tau) { const float mg = expf(lre * dt * (float)tau); float s2, c2; sincosf(lim * dt * (float)tau, &s2, &c2); apow[(tau * 64 + p) * 2] = mg * c2; apow[(tau * 64 + p) * 2 + 1] = mg * s2; }
        for (int c = 0; c < 16; ++c) { const float br = F.in[IN_BRE][(g * 64 + p) * 16 + c], bi = F.in[IN_BIM][(g * 64 + p) * 16 + c];
            bb[(p * 16 + c) * 2] = cre * br - cim * bi; bb[(p * 16 + c) * 2 + 1] = cre * bi + cim * br; }
        float* a16 = (float*)(F.ws + WS_SMALL + 128 * 1024);
        const float mg = expf(lre * dt * 16.0f); float s2, c2; sincosf(lim * dt * 16.0f, &s2, &c2);
        a16[(g * 64 + p) * 2] = mg * c2; a16[(g * 64 + p) * 2 + 1] = mg * s2;
    }
    for (int i = tid; i < 1024; i += 512) { cc[i * 2] = F.in[IN_CRE][g * 1024 + i]; cc[i * 2 + 1] = F.in[IN_CIM][g * 1024 + i]; }
    __syncthreads();
    for (int e = tid; e < 4096; e += 512) { const int tau = e >> 8, c = (e >> 4) & 15, c2 = e & 15; float s = 0.f;
        for (int p = 0; p < 64; ++p) { const float cr = cc[(c * 64 + p) * 2], ci = cc[(c * 64 + p) * 2 + 1], ar = apow[(tau * 64 + p) * 2], ai = apow[(tau * 64 + p) * 2 + 1], br = bb[(p * 16 + c2) * 2], bi = bb[(p * 16 + c2) * 2 + 1];
            const float tr = cr * ar - ci * ai, ti = cr * ai + ci * ar; s += tr * br - ti * bi; }
        km[e] = s; }
    __syncthreads();
    bf16_t* TF = (bf16_t*)(F.ws + WS_TF) + (size_t)g * 256 * 384;
    for (int e = tid; e < 256 * 384; e += 512) { const int n = e / 384, k = e % 384, s = n >> 4, c = n & 15; float v;
        if (k < 256) { const int s2 = k >> 4, c2 = k & 15; v = (s >= s2) ? km[((s - s2) * 16 + c) * 16 + c2] : 0.f; }
        else { const int p = (k - 256) & 63; const float cr = cc[(c * 64 + p) * 2], ci = cc[(c * 64 + p) * 2 + 1], ar = apow[((s + 1) * 64 + p) * 2], ai = apow[((s + 1) * 64 + p) * 2 + 1];
            v = (k < 320) ? (cr * ar - ci * ai) : -(cr * ai + ci * ar); }
        TF[e] = (bf16_t)(pk2(v, 0.f) & 0xffffu); }
    bf16_t* ET = (bf16_t*)(F.ws + WS_ET) + (size_t)g * 256 * 256;
    for (int e = tid; e < 256 * 256; e += 512) { const int n = e >> 8, k = e & 255, s2 = k >> 4, c2 = k & 15; float v = 0.f;
        if (n < 128) { const int p = n & 63; const float ar = apow[((15 - s2) * 64 + p) * 2], ai = apow[((15 - s2) * 64 + p) * 2 + 1], br = bb[(p * 16 + c2) * 2], bi = bb[(p * 16 + c2) * 2 + 1];
            v = (n < 64) ? (ar * br - ai * bi) : (ar * bi + ai * br); }
        ET[e] = (bf16_t)(pk2(v, 0.f) & 0xffffu); }
    __syncthreads();
}

DI void norm_mod_rows(Frame& F, const float* x, const float* gvec, int sh_off, int sc_off, bf16_t* outp) {
    const float* mod = (const float*)(F.ws + WS_SMALL);
    const int gw = F.vcu * 8 + F.wave, NGW = F.G * 8;
    for (int m = gw; m < M; m += NGW) {
        const int b = m / SEQ;
        const f32x4* xr = (const f32x4*)(x + (size_t)m * DM) + FLANE;
        f32x4 v[4]; float s = 0.f;
#pragma unroll
        for (int j = 0; j < 4; ++j) { v[j] = xr[64 * j]; s += (v[j].x * v[j].x + v[j].y * v[j].y) + (v[j].z * v[j].z + v[j].w * v[j].w); }
        const float rstd = 1.0f / sqrtf(wave_sum(s) * (1.0f / DM) + EPSF);
        u32x2* o8 = (u32x2*)(outp + (size_t)m * DM) + FLANE;
#pragma unroll
        for (int j = 0; j < 4; ++j) { const int col = 4 * FLANE + 256 * j;
            const f32x4 gv = *(const f32x4*)(gvec + col), scv = *(const f32x4*)(mod + b * 6144 + sc_off + col), shv = *(const f32x4*)(mod + b * 6144 + sh_off + col);
            const f32x4 y = v[j] * rstd * gv * (scv + 1.0f) + shv;
            u32x2 w; w.x = pk2(y.x, y.y); w.y = pk2(y.z, y.w); o8[64 * j] = w; }
    }
}

struct DenseSched {
    pg8::StaticOrder so; const char* A; const char* B; size_t astep, bstep;
    DI void init(int Mr, int N, int G, int c, const void* A_, int lda, const void* B_, int ldb) { so.init(Mr, N, G, c); A = (const char*)A_; B = (const char*)B_; astep = (size_t)256 * lda * 2; bstep = (size_t)256 * ldb * 2; }
    DI bool next(int i, Unit& u) const { int pm, pn; if (!so.next(i, pm, pn)) return false; u.pm = pm; u.pn = pn; u.aux = 0; u.rowtab = nullptr; u.A = A + (size_t)pm * astep; u.B = B + (size_t)pn * bstep; return true; }
};

struct EpiInProj {
    static constexpr bool PERM = true;
    bf16_t *Q, *Kb, *V, *Assm, *sga, *sgs; float* kmean; const float *qg, *kg;
    DI void operator()(const AccT& acc, const Unit& u, int wr, int wc, int fr, int fq) const {
        const int pn = u.pn, pm = u.pm;
        const int row0 = pm * 256 + wr * 64 + fr;
        if (pn < 4) {
            const bool isk = pn >= 2; const int hg = (pn & 1) * 4 + wc;
            const float* gp = (isk ? kg : qg) + 8 * fq; const float scl = isk ? 1.0f : QC2;
            f32x4 gv[2][2];
#pragma unroll
            for (int bj = 0; bj < 2; ++bj)
#pragma unroll
                for (int n = 0; n < 2; ++n) gv[bj][n] = *(const f32x4*)(gp + 32 * bj + 4 * n) * scl;
            f32x4 ks[2][2];
#pragma unroll
            for (int bj = 0; bj < 2; ++bj)
#pragma unroll
                for (int n = 0; n < 2; ++n) ks[bj][n] = (f32x4){0.f, 0.f, 0.f, 0.f};
            bf16_t* dst = (isk ? Kb : Q) + hg * 64 + 8 * fq;
#pragma unroll
            for (int ai = 0; ai < 2; ++ai)
#pragma unroll
                for (int m = 0; m < 4; ++m) {
                    float ss = 0.f;
#pragma unroll
                    for (int bj = 0; bj < 2; ++bj)
#pragma unroll
                        for (int n = 0; n < 2; ++n) { const f32x4 a = acc[ai][bj][m][n]; ss += (a.x * a.x + a.y * a.y) + (a.z * a.z + a.w * a.w); }
                    ss += __shfl_xor(ss, 16); ss += __shfl_xor(ss, 32);
                    const float rstd = 1.0f / sqrtf(ss * (1.0f / 64.0f) + EPSF);
                    const size_t row = (size_t)(row0 + ai * 128 + m * 16);
#pragma unroll
                    for (int bj = 0; bj < 2; ++bj) {
                        const f32x4 v0 = acc[ai][bj][m][0] * rstd * gv[bj][0], v1 = acc[ai][bj][m][1] * rstd * gv[bj][1];
                        if (isk) { ks[bj][0] += v0; ks[bj][1] += v1; }
                        u32x4 w; w.x = pk2(v0.x, v0.y); w.y = pk2(v0.z, v0.w); w.z = pk2(v1.x, v1.y); w.w = pk2(v1.z, v1.w);
                        *(u32x4*)(dst + row * 512 + 32 * bj) = w; }
                }
            if (isk) {
                const int b = pm >> 4, blk = pm & 15;
                float* kmp = kmean + ((size_t)((b * 8 + hg) * 16 + blk)) * 64 + 8 * fq;
#pragma unroll
                for (int bj = 0; bj < 2; ++bj)
#pragma unroll
                    for (int n = 0; n < 2; ++n)
#pragma unroll
                        for (int j = 0; j < 4; ++j) { float s = ks[bj][n][j]; s += __shfl_xor(s, 1); s += __shfl_xor(s, 2); s += __shfl_xor(s, 4); s += __shfl_xor(s, 8);
                            if (fr == 0) atomicAdd(kmp + 32 * bj + 4 * n + j, s * (1.0f / 256.0f)); }
            }
        } else if (pn < 6) {
            bf16_t* dst = V + (pn - 4) * 256 + wc * 32 + 8 * fq;
#pragma unroll
            for (int ai = 0; ai < 2; ++ai)
#pragma unroll
                for (int m = 0; m < 4; ++m) { const size_t row = (size_t)(row0 + ai * 128 + m * 16);
#pragma unroll
                    for (int bj = 0; bj < 2; ++bj) { const f32x4 v0 = acc[ai][bj][m][0], v1 = acc[ai][bj][m][1];
                        u32x4 w; w.x = pk2(v0.x, v0.y); w.y = pk2(v0.z, v0.w); w.z = pk2(v1.x, v1.y); w.w = pk2(v1.z, v1.w);
                        *(u32x4*)(dst + row * 512 + 128 * bj) = w; } }
        } else if (pn < 8) {
            const int b = pm >> 4;
#pragma unroll
            for (int ai = 0; ai < 2; ++ai)
#pragma unroll
                for (int m = 0; m < 4; ++m) { const int t = (pm & 15) * 256 + ai * 128 + wr * 64 + m * 16 + fr;
#pragma unroll
                    for (int bj = 0; bj < 2; ++bj) { const int c = (pn - 6) * 256 + 128 * bj + 32 * wc + 8 * fq, g = c >> 4, c2 = c & 15;
                        const f32x4 v0 = acc[ai][bj][m][0], v1 = acc[ai][bj][m][1];
                        u32x4 w; w.x = pk2(v0.x, v0.y); w.y = pk2(v0.z, v0.w); w.z = pk2(v1.x, v1.y); w.w = pk2(v1.z, v1.w);
                        *(u32x4*)(Assm + ((size_t)g * 1024 + b * 256 + (t >> 4)) * 384 + (t & 15) * 16 + c2) = w; } }
        } else {
            bf16_t* dst = (pn < 12 ? sga + (pn - 8) * 256 : sgs + (pn - 12) * 256) + wc * 32 + 8 * fq;
#pragma unroll
            for (int ai = 0; ai < 2; ++ai)
#pragma unroll
                for (int m = 0; m < 4; ++m) { const size_t row = (size_t)(row0 + ai * 128 + m * 16);
#pragma unroll
                    for (int bj = 0; bj < 2; ++bj) { const f32x4 v0 = acc[ai][bj][m][0], v1 = acc[ai][bj][m][1];
                        u32x4 w; w.x = pk2(sigmoidf_(v0.x), sigmoidf_(v0.y)); w.y = pk2(sigmoidf_(v0.z), sigmoidf_(v0.w)); w.z = pk2(sigmoidf_(v1.x), sigmoidf_(v1.y)); w.w = pk2(sigmoidf_(v1.z), sigmoidf_(v1.w));
                        *(u32x4*)(dst + row * 1024 + 128 * bj) = w; } }
        }
    }
};

struct EpiS1 {
    static constexpr bool PERM = false;
    float* Hloc;
    DI void operator()(const AccT& acc, const Unit& u, int wr, int wc, int fr, int fq) const {
        float* base = Hloc + (size_t)u.pm * 256 * 128 + wc * 32 + 4 * fq;
#pragma unroll
        for (int ai = 0; ai < 2; ++ai)
#pragma unroll
            for (int m = 0; m < 4; ++m) { const int r = ai * 128 + wr * 64 + m * 16 + fr;
#pragma unroll
                for (int n = 0; n < 2; ++n) *(f32x4*)(base + (size_t)r * 128 + 16 * n) = acc[ai][0][m][n]; }
    }
};
struct SsmSched {
    int G, c; const char* A; const char* B; size_t bstep;
    DI bool next(int i, Unit& u) const { const int L = i * G + c; if (L >= 128) return false; u.pm = L; u.pn = 0; u.aux = 0; u.rowtab = nullptr;
        u.A = A + (size_t)L * 256 * 384 * 2; u.B = B + (size_t)(L >> 2) * bstep; return true; }
};
struct EpiS2 {
    static constexpr bool PERM = true;
    const bf16_t* Assm; const float* dskip; bf16_t* gbuf;
    DI void operator()(const AccT& acc, const Unit& u, int wr, int wc, int fr, int fq) const {
        const int g = u.pm >> 2, b = u.pm & 3;
#pragma unroll
        for (int ai = 0; ai < 2; ++ai)
#pragma unroll
            for (int m = 0; m < 4; ++m) { const int r = ai * 128 + wr * 64 + m * 16 + fr;
#pragma unroll
                for (int bj = 0; bj < 2; ++bj) { const int c = 128 * bj + 32 * wc + 8 * fq, s = c >> 4, c2 = c & 15;
                    const int t = 16 * r + s;
                    size_t uo = ((size_t)u.pm * 256 + r) * 384 + c, oo = ((size_t)b * SEQ + t) * 512 + g * 16 + c2;
                    asm volatile("" : "+v"(uo), "+v"(oo));
                    const u32x2* up = (const u32x2*)(Assm + uo);
                    u32x2* op = (u32x2*)(gbuf + oo);
#pragma unroll
                    for (int n = 0; n < 2; ++n) {
                        const u32x2 uu = up[n]; const f32x4 d0 = *(const f32x4*)(dskip + g * 16 + c2 + 4 * n); const f32x4 a0 = acc[ai][bj][m][n];
                        const float y0 = a0.x + d0.x * bflo(uu.x), y1 = a0.y + d0.y * bfhi(uu.x), y2 = a0.z + d0.z * bflo(uu.y), y3 = a0.w + d0.w * bfhi(uu.y);
                        u32x2 w; w.x = pk2(gelu_tanh(y0), gelu_tanh(y1)); w.y = pk2(gelu_tanh(y2), gelu_tanh(y3));
                        op[n] = w; asm volatile("" ::: "memory"); } } }
    }
};
struct EpiGluUp {
    static constexpr bool PERM = true;
    const bf16_t* gbuf; const float* bglu; bf16_t* sout; const bf16_t* sga; bf16_t* P1;
    DI void operator()(const AccT& acc, const Unit& u, int wr, int wc, int fr, int fq) const {
        const int row0 = u.pm * 256 + wr * 64 + fr, col0 = u.pn * 256 + wc * 32 + 8 * fq;
#pragma unroll
        for (int ai = 0; ai < 2; ++ai)
#pragma unroll
            for (int m = 0; m < 4; ++m) { const size_t row = (size_t)(row0 + ai * 128 + m * 16);
#pragma unroll
                for (int bj = 0; bj < 2; ++bj) { const int col = col0 + 128 * bj; const f32x4 a0 = acc[ai][bj][m][0], a1 = acc[ai][bj][m][1]; u32x4 w;
                    if (u.aux == 0) { const u32x4 gg = *(const u32x4*)(gbuf + row * 512 + col); const f32x4 b0 = *(const f32x4*)(bglu + col), b1 = *(const f32x4*)(bglu + col + 4);
                        w.x = pk2(bflo(gg.x) * sigmoidf_(a0.x + b0.x), bfhi(gg.x) * sigmoidf_(a0.y + b0.y)); w.y = pk2(bflo(gg.y) * sigmoidf_(a0.z + b0.z), bfhi(gg.y) * sigmoidf_(a0.w + b0.w));
                        w.z = pk2(bflo(gg.z) * sigmoidf_(a1.x + b1.x), bfhi(gg.z) * sigmoidf_(a1.y + b1.y)); w.w = pk2(bflo(gg.w) * sigmoidf_(a1.z + b1.z), bfhi(gg.w) * sigmoidf_(a1.w + b1.w));
                        *(u32x4*)(sout + row * 512 + col) = w;
                    } else { const u32x4 gg = *(const u32x4*)(sga + row * 1024 + col);
                        w.x = pk2(bflo(gg.x) * a0.x, bfhi(gg.x) * a0.y); w.y = pk2(bflo(gg.y) * a0.z, bfhi(gg.y) * a0.w); w.z = pk2(bflo(gg.z) * a1.x, bfhi(gg.z) * a1.y); w.w = pk2(bflo(gg.w) * a1.z, bfhi(gg.w) * a1.w);
                        *(u32x4*)(P1 + row * 1024 + col) = w; } } }
    }
};
struct GluUpSched {
    int G, c; const char *Ag, *Bg, *Au, *Bu;
    DI bool next(int i, Unit& u) const { const int L = i * G + c; if (L >= 384) return false; u.rowtab = nullptr;
        if (L < 128) { u.aux = 0; u.pm = L >> 1; u.pn = L & 1; u.A = Ag + (size_t)u.pm * 256 * 512 * 2; u.B = Bg + (size_t)u.pn * 256 * 512 * 2; }
        else { const int l2 = L - 128; u.aux = 1; u.pm = l2 >> 2; u.pn = l2 & 3; u.A = Au + (size_t)u.pm * 256 * 512 * 2; u.B = Bu + (size_t)u.pn * 256 * 512 * 2; }
        return true; }
};
struct EpiUp2 {
    static constexpr bool PERM = true;
    const bf16_t* P1; const bf16_t* sgs; bf16_t* mix;
    DI void operator()(const AccT& acc, const Unit& u, int wr, int wc, int fr, int fq) const {
        const int row0 = u.pm * 256 + wr * 64 + fr, col0 = u.pn * 256 + wc * 32 + 8 * fq;
#pragma unroll
        for (int ai = 0; ai < 2; ++ai)
#pragma unroll
            for (int m = 0; m < 4; ++m) { const size_t row = (size_t)(row0 + ai * 128 + m * 16);
#pragma unroll
                for (int bj = 0; bj < 2; ++bj) { const size_t o = row * 1024 + col0 + 128 * bj; const f32x4 a0 = acc[ai][bj][m][0], a1 = acc[ai][bj][m][1];
                    const u32x4 gg = *(const u32x4*)(sgs + o), pp = *(const u32x4*)(P1 + o); u32x4 w;
                    w.x = pk2(bflo(pp.x) + bflo(gg.x) * a0.x, bfhi(pp.x) + bfhi(gg.x) * a0.y); w.y = pk2(bflo(pp.y) + bflo(gg.y) * a0.z, bfhi(pp.y) + bfhi(gg.y) * a0.w);
                    w.z = pk2(bflo(pp.z) + bflo(gg.z) * a1.x, bfhi(pp.z) + bfhi(gg.z) * a1.y); w.w = pk2(bflo(pp.w) + bflo(gg.w) * a1.z, bfhi(pp.w) + bfhi(gg.w) * a1.w);
                    *(u32x4*)(mix + o) = w; } }
    }
};
struct EpiOut {
    static constexpr bool PERM = true;
    const float* x; const float* mod; float* out;
    DI void operator()(const AccT& acc, const Unit& u, int wr, int wc, int fr, int fq) const {
        const int row0 = u.pm * 256 + wr * 64 + fr, col0 = u.pn * 256 + wc * 32 + 8 * fq, b = u.pm >> 4;
#pragma unroll
        for (int bj = 0; bj < 2; ++bj) { const int col = col0 + 128 * bj;
            const f32x4 g0 = *(const f32x4*)(mod + b * 6144 + 2048 + col), g1 = *(const f32x4*)(mod + b * 6144 + 2048 + col + 4);
#pragma unroll
            for (int ai = 0; ai < 2; ++ai)
#pragma unroll
                for (int m = 0; m < 4; ++m) { const size_t o = (size_t)(row0 + ai * 128 + m * 16) * 1024 + col;
                    const f32x4 x0 = *(const f32x4*)(x + o), x1 = *(const f32x4*)(x + o + 4);
                    *(f32x4*)(out + o) = x0 + g0 * acc[ai][bj][m][0]; *(f32x4*)(out + o + 4) = x1 + g1 * acc[ai][bj][m][1]; } }
    }
};
struct EpiRsh {
    static constexpr bool PERM = true;
    float* scores; bf16_t* hs;
    DI void operator()(const AccT& acc, const Unit& u, int wr, int wc, int fr, int fq) const {
        const int row0 = u.pm * 256 + wr * 64 + fr;
        if (u.pn == 0) {
#pragma unroll
            for (int ai = 0; ai < 2; ++ai)
#pragma unroll
                for (int m = 0; m < 4; ++m) { const size_t row = (size_t)(row0 + ai * 128 + m * 16);
#pragma unroll
                    for (int bj = 0; bj < 2; ++bj) { float* d = scores + row * 256 + 128 * bj + 32 * wc + 8 * fq; const f32x4 a0 = acc[ai][bj][m][0], a1 = acc[ai][bj][m][1];
                        *(f32x4*)d = (f32x4){sigmoidf_(a0.x), sigmoidf_(a0.y), sigmoidf_(a0.z), sigmoidf_(a0.w)}; *(f32x4*)(d + 4) = (f32x4){sigmoidf_(a1.x), sigmoidf_(a1.y), sigmoidf_(a1.z), sigmoidf_(a1.w)}; } }
        } else {
#pragma unroll
            for (int ai = 0; ai < 2; ++ai)
#pragma unroll
                for (int m = 0; m < 4; ++m) { const size_t row = (size_t)(row0 + ai * 128 + m * 16);
                    const f32x4 g0 = acc[ai][0][m][0], g1 = acc[ai][0][m][1], u0 = acc[ai][1][m][0], u1 = acc[ai][1][m][1]; u32x4 w;
                    w.x = pk2(siluf_(g0.x) * u0.x, siluf_(g0.y) * u0.y); w.y = pk2(siluf_(g0.z) * u0.z, siluf_(g0.w) * u0.w); w.z = pk2(siluf_(g1.x) * u1.x, siluf_(g1.y) * u1.y); w.w = pk2(siluf_(g1.z) * u1.z, siluf_(g1.w) * u1.w);
                    *(u32x4*)(hs + row * 256 + 128 * (u.pn - 1) + 32 * wc + 8 * fq) = w; }
        }
    }
};
struct EpiBf16 {
    static constexpr bool PERM = true;
    bf16_t* O; int ldc;
    DI void operator()(const AccT& acc, const Unit& u, int wr, int wc, int fr, int fq) const {
        const int row0 = u.pm * 256 + wr * 64 + fr, col0 = u.pn * 256 + wc * 32 + 8 * fq;
#pragma unroll
        for (int ai = 0; ai < 2; ++ai)
#pragma unroll
            for (int m = 0; m < 4; ++m) { const size_t row = (size_t)(row0 + ai * 128 + m * 16);
#pragma unroll
                for (int bj = 0; bj < 2; ++bj) { const f32x4 v0 = acc[ai][bj][m][0], v1 = acc[ai][bj][m][1];
                    u32x4 w; w.x = pk2(v0.x, v0.y); w.y = pk2(v0.z, v0.w); w.z = pk2(v1.x, v1.y); w.w = pk2(v1.z, v1.w);
                    *(u32x4*)(O + row * ldc + col0 + 128 * bj) = w; } asm volatile("" ::: "memory"); }
    }
};
struct EpiMoe1 {
    static constexpr bool PERM = true;
    bf16_t* Hs;
    DI void operator()(const AccT& acc, const Unit& u, int wr, int wc, int fr, int fq) const {
        const int row0 = u.pm * 256 + wr * 64 + fr;
#pragma unroll
        for (int ai = 0; ai < 2; ++ai)
#pragma unroll
            for (int m = 0; m < 4; ++m) { const size_t row = (size_t)(row0 + ai * 128 + m * 16);
                const f32x4 g0 = acc[ai][0][m][0], g1 = acc[ai][0][m][1], u0 = acc[ai][1][m][0], u1 = acc[ai][1][m][1]; u32x4 w;
                w.x = pk2(siluf_(g0.x) * u0.x, siluf_(g0.y) * u0.y); w.y = pk2(siluf_(g0.z) * u0.z, siluf_(g0.w) * u0.w); w.z = pk2(siluf_(g1.x) * u1.x, siluf_(g1.y) * u1.y); w.w = pk2(siluf_(g1.z) * u1.z, siluf_(g1.w) * u1.w);
                *(u32x4*)(Hs + row * 256 + 128 * u.pn + 32 * wc + 8 * fq) = w; }
    }
};
struct EpiMoe2 {
    static constexpr bool PERM = true;
    const int* dest; const float* roww; bf16_t* Y;
    DI void operator()(const AccT& acc, const Unit& u, int wr, int wc, int fr, int fq) const {
        const int row0 = u.pm * 256 + wr * 64 + fr, col0 = u.pn * 256 + wc * 32 + 8 * fq;
#pragma unroll
        for (int ai = 0; ai < 2; ++ai)
#pragma unroll
            for (int m = 0; m < 4; ++m) { const int row = row0 + ai * 128 + m * 16; const int d = dest[row]; const float wt = roww[row];
                if (d >= 0) {
#pragma unroll
                    for (int bj = 0; bj < 2; ++bj) { const f32x4 v0 = acc[ai][bj][m][0] * wt, v1 = acc[ai][bj][m][1] * wt;
                        u32x4 w; w.x = pk2(v0.x, v0.y); w.y = pk2(v0.z, v0.w); w.z = pk2(v1.x, v1.y); w.w = pk2(v1.z, v1.w);
                        *(u32x4*)(Y + (size_t)d * 1024 + col0 + 128 * bj) = w; } } asm volatile("" ::: "memory"); }
    }
};
struct MoeSched {
    int G, c, npn, ntiles; const LAS unsigned short* tile_e; const char* A; const char* B; size_t astep, bestep, bnstep; const int* rowtab;
    DI bool next(int i, Unit& u) const { const int L = i * G + c; if (L >= ntiles * npn) return false; const int tile = L / npn, pn = L % npn; const int e = tile_e[tile];
        u.pm = tile; u.pn = pn; u.aux = e; u.rowtab = rowtab + tile * 256; u.A = A + (size_t)tile * astep; u.B = B + (size_t)e * bestep + (size_t)pn * bnstep; return true; }
};

namespace att {
constexpr int KS_STRIDE = 144, VT_STRIDE = 136;
constexpr int L_KS = 0, L_VT = 64 * KS_STRIDE, L_KM = L_VT + 64 * VT_STRIDE, L_BT = L_KM + 4096, L_WS = L_BT + 576 * 4, L_END = L_WS + 8 * 64 * 4;
DI int crow(int r, int hi) { return (r & 3) + 8 * (r >> 2) + 4 * hi; }
DI int t5_bucket(int n) { if (n < 16) return n; int v = 16 + (int)(logf((float)n * (1.0f / 16.0f)) * (16.0f / 2.0794415416798357f)); return v > 31 ? 31 : v; }

DI void attn_unit(Frame& F, int b, int h, int qb, const bf16_t* Q, const bf16_t* Kg, const bf16_t* Vg, bf16_t* O, const float* kmean, const float* relb) {
    LAS unsigned char* lds = F.lds;
    int lane = FLANE; asm volatile("" : "+v"(lane));
    const int wid = F.wave, tid = wid * 64 + lane, r32 = lane & 31, hi = lane >> 5;
    LAS float* kms = (LAS float*)(lds + L_KM); LAS float* bt = (LAS float*)(lds + L_BT); LAS float* wsf = (LAS float*)(lds + L_WS) + wid * 64;
    __syncthreads();
    if (tid < 256) *(LAS f32x4*)(kms + 4 * tid) = *(const f32x4*)(kmean + (size_t)(b * 8 + h) * 1024 + 4 * tid);
    for (int i = tid; i < 576; i += 512) { const int n = i - 256; float v = 0.f; if (n >= 0 && n < 128) v = (relb[t5_bucket(n) * 8 + h] - relb[31 * 8 + h]) * LOG2E; bt[i] = v; }
    const size_t rowq = (size_t)b * SEQ + qb * 256 + wid * 32 + r32;
    const bf16_t* qrow = Q + rowq * 512 + h * 64;
    bf16x8 qf[4];
#pragma unroll
    for (int ks = 0; ks < 4; ++ks) qf[ks] = *(const bf16x8*)(qrow + ks * 16 + hi * 8);
    __syncthreads();
    unsigned selmask = 0;
    {
        float gsc[8];
#pragma unroll
        for (int j = 0; j < 8; ++j) gsc[j] = 0.f;
#pragma unroll
        for (int c8 = 0; c8 < 8; ++c8) { const u32x4 qq = *(const u32x4*)(qrow + c8 * 8);
            float qv[8] = {bflo(qq.x), bfhi(qq.x), bflo(qq.y), bfhi(qq.y), bflo(qq.z), bfhi(qq.z), bflo(qq.w), bfhi(qq.w)};
#pragma unroll
            for (int j = 0; j < 8; ++j) { const LAS float* kp = kms + (8 * hi + j) * 64 + c8 * 8; const f32x4 k0 = *(const LAS f32x4*)kp, k1 = *(const LAS f32x4*)(kp + 4);
                gsc[j] += qv[0] * k0.x + qv[1] * k0.y + qv[2] * k0.z + qv[3] * k0.w + qv[4] * k1.x + qv[5] * k1.y + qv[6] * k1.z + qv[7] * k1.w; } }
        float ga[16];
#pragma unroll
        for (int j = 0; j < 8; ++j) { const float o = __shfl_xor(gsc[j], 32); ga[j] = hi ? o : gsc[j]; ga[8 + j] = hi ? gsc[j] : o; }
#pragma unroll
        for (int j = 0; j < 16; ++j) if (j >= qb) ga[j] = -INFINITY;
#pragma unroll
        for (int k = 0; k < 3; ++k) { float bv = -INFINITY; int bi = -1;
#pragma unroll
            for (int j = 0; j < 16; ++j) if (ga[j] > bv) { bv = ga[j]; bi = j; }
            if (bi >= 0) { selmask |= 1u << bi;
#pragma unroll
                for (int j = 0; j < 16; ++j) if (j == bi) ga[j] = -INFINITY; } }
    }
    float m_run = -INFINITY, l_run = 0.f; f32x16 o0 = {}, o1 = {};
    const int NT = 4 * (qb + 1);
    const int skey = tid >> 3, sch = tid & 7;
    const bf16_t* kbase = Kg + ((size_t)b * SEQ + skey) * 512 + h * 64 + sch * 8;
    const bf16_t* vbase = Vg + ((size_t)b * SEQ + skey) * 512 + h * 64 + sch * 8;
    u32x4 kreg = *(const u32x4*)kbase, vreg = *(const u32x4*)vbase;
    const int qrel = wid * 32 + r32;
    for (int t = 0; t < NT; ++t) {
        __syncthreads();
        *(LAS u32x4*)(lds + L_KS + skey * KS_STRIDE + sch * 16) = kreg;
        { LAS unsigned short* vt = (LAS unsigned short*)(lds + L_VT); const int d0 = sch * 8;
            vt[(d0 + 0) * (VT_STRIDE / 2) + skey] = (unsigned short)(vreg.x & 0xffff); vt[(d0 + 1) * (VT_STRIDE / 2) + skey] = (unsigned short)(vreg.x >> 16);
            vt[(d0 + 2) * (VT_STRIDE / 2) + skey] = (unsigned short)(vreg.y & 0xffff); vt[(d0 + 3) * (VT_STRIDE / 2) + skey] = (unsigned short)(vreg.y >> 16);
            vt[(d0 + 4) * (VT_STRIDE / 2) + skey] = (unsigned short)(vreg.z & 0xffff); vt[(d0 + 5) * (VT_STRIDE / 2) + skey] = (unsigned short)(vreg.z >> 16);
            vt[(d0 + 6) * (VT_STRIDE / 2) + skey] = (unsigned short)(vreg.w & 0xffff); vt[(d0 + 7) * (VT_STRIDE / 2) + skey] = (unsigned short)(vreg.w >> 16); }
        if (t + 1 < NT) { kreg = *(const u32x4*)(kbase + (size_t)(t + 1) * 64 * 512); vreg = *(const u32x4*)(vbase + (size_t)(t + 1) * 64 * 512); }
        __syncthreads();
        const int jblk = t >> 2;
        f32x16 p0 = {}, p1 = {};
#pragma unroll
        for (int ks = 0; ks < 4; ++ks) {
            const bf16x8 a0 = *(const LAS bf16x8*)(lds + L_KS + r32 * KS_STRIDE + ks * 32 + hi * 16);
            const bf16x8 a1 = *(const LAS bf16x8*)(lds + L_KS + (32 + r32) * KS_STRIDE + ks * 32 + hi * 16);
            p0 = __builtin_amdgcn_mfma_f32_32x32x16_bf16(a0, qf[ks], p0, 0, 0, 0);
            p1 = __builtin_amdgcn_mfma_f32_32x32x16_bf16(a1, qf[ks], p1, 0, 0, 0);
        }
        if (jblk < qb) {
            if (!((selmask >> jblk) & 1u)) {
#pragma unroll
                for (int r = 0; r < 16; ++r) { p0[r] = -INFINITY; p1[r] = -INFINITY; } }
        } else {
            const int kb = 64 * (t & 3);
#pragma unroll
            for (int r = 0; r < 16; ++r) { const int kv = kb + crow(r, hi); if (kv > qrel) p0[r] = -INFINITY; if (kv + 32 > qrel) p1[r] = -INFINITY; }
        }
        if ((qb * 256 + wid * 32) - (64 * t + 63) < 128) {
            const int nb = (qb * 256 + qrel) - 64 * t + 256;
#pragma unroll
            for (int r = 0; r < 16; ++r) { p0[r] += bt[nb - crow(r, hi)]; p1[r] += bt[nb - crow(r, hi) - 32]; }
        }
        float rm = p0[0];
#pragma unroll
        for (int r = 1; r < 16; ++r) rm = fmaxf(rm, p0[r]);
#pragma unroll
        for (int r = 0; r < 16; ++r) rm = fmaxf(rm, p1[r]);
        rm = fmaxf(rm, __shfl_xor(rm, 32));
        const float mnew = fmaxf(m_run, rm);
        const float msafe = (mnew == -INFINITY) ? 0.f : mnew;
        const float alpha = (m_run == -INFINITY) ? ((mnew == -INFINITY) ? 1.f : 0.f) : exp2f(m_run - mnew);
        float rs = 0.f;
#pragma unroll
        for (int r = 0; r < 16; ++r) { p0[r] = exp2f(p0[r] - msafe); p1[r] = exp2f(p1[r] - msafe); rs += p0[r] + p1[r]; }
        rs += __shfl_xor(rs, 32);
        l_run = l_run * alpha + rs; m_run = mnew;
        if (__any(alpha != 1.0f)) {
            if (hi == 0) wsf[r32] = alpha;
            asm volatile("s_waitcnt lgkmcnt(0)" ::: "memory");
#pragma unroll
            for (int r = 0; r < 16; ++r) { const float f = wsf[crow(r, hi)]; o0[r] *= f; o1[r] *= f; }
            asm volatile("s_waitcnt lgkmcnt(0)" ::: "memory");
        }
#pragma unroll
        for (int mt = 0; mt < 2; ++mt)
#pragma unroll
            for (int s = 0; s < 2; ++s) {
                u32x4 pw;
                if (mt == 0) { pw.x = pk2(p0[8 * s], p0[8 * s + 1]); pw.y = pk2(p0[8 * s + 2], p0[8 * s + 3]); pw.z = pk2(p0[8 * s + 4], p0[8 * s + 5]); pw.w = pk2(p0[8 * s + 6], p0[8 * s + 7]); }
                else { pw.x = pk2(p1[8 * s], p1[8 * s + 1]); pw.y = pk2(p1[8 * s + 2], p1[8 * s + 3]); pw.z = pk2(p1[8 * s + 4], p1[8 * s + 5]); pw.w = pk2(p1[8 * s + 6], p1[8 * s + 7]); }
                const bf16x8 pa = __builtin_bit_cast(bf16x8, pw);
                const int koff = (32 * mt + 16 * s + 4 * hi) * 2;
                { const LAS unsigned char* vp = lds + L_VT + r32 * VT_STRIDE + koff; const u32x2 lo = *(const LAS u32x2*)vp, hi2 = *(const LAS u32x2*)(vp + 16);
                    u32x4 vv; vv.x = lo.x; vv.y = lo.y; vv.z = hi2.x; vv.w = hi2.y; o0 = __builtin_amdgcn_mfma_f32_32x32x16_bf16(pa, __builtin_bit_cast(bf16x8, vv), o0, 0, 0, 0); }
                { const LAS unsigned char* vp = lds + L_VT + (32 + r32) * VT_STRIDE + koff; const u32x2 lo = *(const LAS u32x2*)vp, hi2 = *(const LAS u32x2*)(vp + 16);
                    u32x4 vv; vv.x = lo.x; vv.y = lo.y; vv.z = hi2.x; vv.w = hi2.y; o1 = __builtin_amdgcn_mfma_f32_32x32x16_bf16(pa, __builtin_bit_cast(bf16x8, vv), o1, 0, 0, 0); }
            }
    }
    if (hi == 0) wsf[r32] = 1.0f / l_run;
    asm volatile("s_waitcnt lgkmcnt(0)" ::: "memory");
    bf16_t* orow = O + ((size_t)b * SEQ + qb * 256 + wid * 32) * 512 + h * 64;
#pragma unroll
    for (int r = 0; r < 16; ++r) { const int q = crow(r, hi); const float f = wsf[q];
        orow[(size_t)q * 512 + r32] = (bf16_t)(pk2(o0[r] * f, 0.f) & 0xffffu); orow[(size_t)q * 512 + 32 + r32] = (bf16_t)(pk2(o1[r] * f, 0.f) & 0xffffu); }
}
}

DI void ssm_scan(Frame& F) {
    const float* Hloc = (const float*)(F.ws + WS_HLOC); bf16_t* Assm = (bf16_t*)(F.ws + WS_ASSM); const float* a16 = (const float*)(F.ws + WS_SMALL + 128 * 1024);
    const int gw = F.vcu * 8 + F.wave, NGW = F.G * 8, p = FLANE;
    for (int task = gw; task < 128; task += NGW) {
        const int g = task >> 2, b = task & 3;
        const float ar = a16[(g * 64 + p) * 2], ai = a16[(g * 64 + p) * 2 + 1];
        float sr = 0.f, si = 0.f;
        const float* hl = Hloc + ((size_t)g * 1024 + b * 256) * 128; bf16_t* ao = Assm + ((size_t)g * 1024 + b * 256) * 384 + 256;
        for (int c0 = 0; c0 < 256; c0 += 8) {
            float lr[8], li[8];
#pragma unroll
            for (int j = 0; j < 8; ++j) { lr[j] = hl[(size_t)(c0 + j) * 128 + p]; li[j] = hl[(size_t)(c0 + j) * 128 + 64 + p]; }
#pragma unroll
            for (int j = 0; j < 8; ++j) {
                ao[(size_t)(c0 + j) * 384 + p] = (bf16_t)(pk2(sr, 0.f) & 0xffffu); ao[(size_t)(c0 + j) * 384 + 64 + p] = (bf16_t)(pk2(si, 0.f) & 0xffffu);
                const float nr = ar * sr - ai * si + lr[j], ni = ar * si + ai * sr + li[j]; sr = nr; si = ni; }
        }
    }
}

DI void topk_tokens(Frame& F) {
    const float* scores = (const float*)(F.ws + WS_SCORES); const float* rbias = F.in[IN_RBIAS];
    int* top_idx = (int*)(F.ws + WS_ROUTE); float* top_w = (float*)(F.ws + WS_ROUTE + 512 * 1024); int* rank = (int*)(F.ws + WS_ROUTE + 1024 * 1024);
    unsigned* cnt = (unsigned*)(F.ws + WS_CTL) + CW_CNT;
    const int gw = F.vcu * 8 + F.wave, NGW = F.G * 8, l = FLANE;
    const f32x4 rb = *(const f32x4*)(rbias + 4 * l);
    for (int t = gw; t < M; t += NGW) {
        const f32x4 sc = *(const f32x4*)(scores + (size_t)t * 256 + 4 * l);
        float v[4] = {sc.x + rb.x, sc.y + rb.y, sc.z + rb.z, sc.w + rb.w};
        float m1 = fmaxf(v[0], v[1]), m2 = fminf(v[0], v[1]);
        { const float a = fmaxf(v[2], v[3]), c = fminf(v[2], v[3]); const float n1 = fmaxf(m1, a), n2 = fmaxf(fminf(m1, a), fmaxf(m2, c)); m1 = n1; m2 = n2; }
#pragma unroll
        for (int o = 1; o < 8; o <<= 1) { const float o1 = __shfl_xor(m1, o), o2 = __shfl_xor(m2, o); const float n1 = fmaxf(m1, o1), n2 = fmaxf(fminf(m1, o1), fmaxf(m2, o2)); m1 = n1; m2 = n2; }
        const float gs = m1 + m2; const int myg = l >> 3; int higher = 0;
#pragma unroll
        for (int j = 0; j < 8; ++j) { const float og = __shfl(gs, 8 * j); higher += (og > gs || (og == gs && j < myg)) ? 1 : 0; }
        if (higher >= 4) { v[0] = -1e30f; v[1] = -1e30f; v[2] = -1e30f; v[3] = -1e30f; }
        int my_e = 0; float my_s = 0.f, tot = 0.f;
#pragma unroll
        for (int k = 0; k < 8; ++k) {
            float bv = v[0]; int bi = 4 * l;
            if (v[1] > bv) { bv = v[1]; bi = 4 * l + 1; } if (v[2] > bv) { bv = v[2]; bi = 4 * l + 2; } if (v[3] > bv) { bv = v[3]; bi = 4 * l + 3; }
#pragma unroll
            for (int o = 1; o < 64; o <<= 1) { const float ov = __shfl_xor(bv, o); const int oi = __shfl_xor(bi, o); if (ov > bv || (ov == bv && oi < bi)) { bv = ov; bi = oi; } }
            const float mys = (bi == 4 * l) ? sc.x : (bi == 4 * l + 1) ? sc.y : (bi == 4 * l + 2) ? sc.z : sc.w;
            const float ssel = __shfl(mys, bi >> 2);
            if (bi == 4 * l) v[0] = -3e38f; if (bi == 4 * l + 1) v[1] = -3e38f; if (bi == 4 * l + 2) v[2] = -3e38f; if (bi == 4 * l + 3) v[3] = -3e38f;
            tot += ssel; if (l == k) { my_e = bi; my_s = ssel; }
        }
        if (l < 8) { top_idx[t * 8 + l] = my_e; top_w[t * 8 + l] = my_s / tot * 2.5f; rank[t * 8 + l] = (int)atomicAdd(cnt + my_e, 1u); }
    }
}
DI int build_tiles(Frame& F) {
    const unsigned* cnt = (const unsigned*)(F.ws + WS_CTL) + CW_CNT;
    LAS unsigned* sa = (LAS unsigned*)(F.lds + SCAN_OFF); LAS unsigned* sb = sa + 256; LAS unsigned short* tile_e = (LAS unsigned short*)(F.lds + TILEE_OFF);
    LAS unsigned* misc = (LAS unsigned*)(F.lds + MISC_OFF);
    const int tid = FTID; unsigned nt = 0;
    __syncthreads();
    if (tid < 256) { nt = (__hip_atomic_load(cnt + tid, __ATOMIC_RELAXED, __HIP_MEMORY_SCOPE_AGENT) + 255u) >> 8; sa[tid] = nt; }
    __syncthreads();
    LAS unsigned* src = sa; LAS unsigned* dst = sb;
    for (int o = 1; o < 256; o <<= 1) { if (tid < 256) { unsigned v = src[tid]; if (tid >= o) v += src[tid - o]; dst[tid] = v; } __syncthreads(); LAS unsigned* tmp = src; src = dst; dst = tmp; }
    if (tid < 256) { const unsigned incl = src[tid], first = incl - nt; for (unsigned k = 0; k < nt; ++k) if (first + k < MAXTILES) tile_e[first + k] = (unsigned short)tid; dst[tid] = first; if (tid == 255) misc[16] = incl; }
    __syncthreads();
    if (tid < 256) sa[tid] = dst[tid];
    __syncthreads();
    int ntl = (int)misc[16]; if (ntl > MAXTILES) ntl = MAXTILES; return ntl;
}
DI void route_scatter(Frame& F) {
    const int* top_idx = (const int*)(F.ws + WS_ROUTE); const float* top_w = (const float*)(F.ws + WS_ROUTE + 512 * 1024); const int* rank = (const int*)(F.ws + WS_ROUTE + 1024 * 1024);
    int* rowoff = (int*)(F.ws + WS_ROUTE + 2 * MiB); float* roww = (float*)(F.ws + WS_ROUTE + 3 * MiB); int* dest = (int*)(F.ws + WS_ROUTE + 4 * MiB);
    (void)build_tiles(F);
    LAS unsigned* first = (LAS unsigned*)(F.lds + SCAN_OFF);
    const int gt = F.vcu * 512 + FTID, NT = F.G * 512;
    for (int i = gt; i < M * 8; i += NT) { const int e = top_idx[i]; const int pos = (int)first[e] * 256 + rank[i];
        if (pos < MAXROWS) { rowoff[pos] = (i >> 3) * (DM * 2); roww[pos] = top_w[i]; dest[pos] = i; } }
}
DI void route_clear(Frame& F) {
    int* rowoff = (int*)(F.ws + WS_ROUTE + 2 * MiB); float* roww = (float*)(F.ws + WS_ROUTE + 3 * MiB); int* dest = (int*)(F.ws + WS_ROUTE + 4 * MiB);
    const int gt = F.vcu * 512 + FTID, NT = F.G * 512;
    for (int i = gt; i < MAXROWS; i += NT) { rowoff[i] = 0; roww[i] = 0.f; dest[i] = -1; }
}
DI void combine(Frame& F) {
    const float* mod = (const float*)(F.ws + WS_SMALL); const bf16_t* ysh = (const bf16_t*)(F.ws + WS_YSH); const bf16_t* Y = (const bf16_t*)(F.ws + WS_Y);
    const int gw = F.vcu * 8 + F.wave, NGW = F.G * 8;
    for (int t = gw; t < M; t += NGW) { const int b = t / SEQ;
#pragma unroll
        for (int hf = 0; hf < 2; ++hf) { const int col = hf * 512 + FLANE * 8;
            const u32x4 s = *(const u32x4*)(ysh + (size_t)t * 1024 + col);
            float a[8] = {bflo(s.x), bfhi(s.x), bflo(s.y), bfhi(s.y), bflo(s.z), bfhi(s.z), bflo(s.w), bfhi(s.w)};
            u32x4 yv[8];
#pragma unroll
            for (int k = 0; k < 8; ++k) yv[k] = *(const u32x4*)(Y + ((size_t)t * 8 + k) * 1024 + col);
#pragma unroll
            for (int k = 0; k < 8; ++k) { a[0] += bflo(yv[k].x); a[1] += bfhi(yv[k].x); a[2] += bflo(yv[k].y); a[3] += bfhi(yv[k].y); a[4] += bflo(yv[k].z); a[5] += bfhi(yv[k].z); a[6] += bflo(yv[k].w); a[7] += bfhi(yv[k].w); }
            float* o = F.out + (size_t)t * 1024 + col; const float* g2 = mod + b * 6144 + 5120 + col;
            const f32x4 x0 = *(const f32x4*)o, x1 = *(const f32x4*)(o + 4), g0 = *(const f32x4*)g2, g1 = *(const f32x4*)(g2 + 4);
            *(f32x4*)o = x0 + g0 * (f32x4){a[0], a[1], a[2], a[3]}; *(f32x4*)(o + 4) = x1 + g1 * (f32x4){a[4], a[5], a[6], a[7]}; }
    }
}

constexpr int NPHASE = 17;
__global__ void __launch_bounds__(512, 2) mk_fwd(Args args) {
    extern __shared__ __attribute__((aligned(16))) unsigned char lds_raw[];
    Frame F;
    F.lds = (LAS unsigned char*)lds_raw; F.wave = __builtin_amdgcn_readfirstlane((int)threadIdx.x >> 6);
    F.G = gridDim.x; { const int bx = blockIdx.x; F.vcu = (F.G % 8 == 0) ? (bx % 8) * (F.G / 8) + bx / 8 : bx; }
    F.in.p = args.in; F.out = args.out; F.ws = args.ws;
    unsigned char* ws = args.ws;
    volatile LAS unsigned* MISC = (volatile LAS unsigned*)(F.lds + MISC_OFF);
    LAS unsigned* gtab = (LAS unsigned*)(F.lds + GTAB_OFF);
    for (int u = FTID; u < 64; u += 512) MISC[u] = 0u;
    __syncthreads();
    unsigned* ctl = (unsigned*)(ws + WS_CTL);
    XcdBarrier bar; bar.bar = ctl + CW_BAR; bar.x = 0; bar.st = nullptr; bar.wave = F.wave;
    if (!MK_PER_PHASE) bar = xcd_barrier_post(ctl + CW_BAR, MISC + 8, F.wave);
    const int lo = args.ph_lo, hi = args.ph_hi;
#ifndef ONLY_PHASE
#define ONLY_PHASE -1
#endif
#define IN(k) ((ONLY_PHASE < 0 || ONLY_PHASE == (k)) && lo <= (k) && (k) < hi)
#define SEAM(k) do { if (IN(k) && IN((k) + 1)) xcd_barrier(bar); } while (0)
    const int G = F.G, bx = (int)blockIdx.x;
    float* mod = (float*)(ws + WS_SMALL);

    if (IN(0)) {
        if (bx < 96) p0_adaln(F, bx); else if (bx < 128) p0_ssm(F, bx - 96);
        p0_convert(F);
    }
    SEAM(0);
    if (IN(1)) norm_mod_rows(F, F.in[IN_X], F.in[IN_LN1G], 0, 1024, (bf16_t*)(ws + WS_H));
    SEAM(1);
    if (IN(2)) {
        pg8::Gemm g{DM, DM, DM}; DenseSched S; S.init(M, INW, G, bx, ws + WS_H, DM, ws + WS_WIN, DM);
        EpiInProj E{(bf16_t*)(ws + WS_Q), (bf16_t*)(ws + WS_K), (bf16_t*)(ws + WS_V), (bf16_t*)(ws + WS_ASSM), (bf16_t*)(ws + WS_SGA), (bf16_t*)(ws + WS_SGS), (float*)(ctl + CW_KMEAN), F.in[IN_QG], F.in[IN_KG]};
        pg8::gemm_phase<EpiInProj, DenseSched, true, false>(F.lds, gtab, F.wave, g, S, E);
    }
    SEAM(2);
    if (IN(3)) {
#pragma unroll 1
        for (int ui = F.vcu * 2; ui < 512; ui += 2 * G) {
#pragma unroll 1
            for (int k2 = 0; k2 < 2; ++k2) { const int pi = ui >> 1, bh = pi >> 3, s = pi & 7, qb = k2 ? s : 15 - s;
                att::attn_unit(F, bh >> 3, bh & 7, qb, (const bf16_t*)(ws + WS_Q), (const bf16_t*)(ws + WS_K), (const bf16_t*)(ws + WS_V), (bf16_t*)(ws + WS_Q), (const float*)(ctl + CW_KMEAN), F.in[IN_RELB]); } }
        __syncthreads();
        pg8::Gemm g{384, 256, 256}; SsmSched S{G, F.vcu, (const char*)(ws + WS_ASSM), (const char*)(ws + WS_ET), (size_t)256 * 256 * 2};
        EpiS1 E{(float*)(ws + WS_HLOC)};
        pg8::gemm_phase<EpiS1, SsmSched, true, false>(F.lds, gtab, F.wave, g, S, E);
    }
    SEAM(3);
    if (IN(4)) ssm_scan(F);
    SEAM(4);
    if (IN(5)) {
        pg8::Gemm g{384, 384, 384}; SsmSched S{G, F.vcu, (const char*)(ws + WS_ASSM), (const char*)(ws + WS_TF), (size_t)256 * 384 * 2};
        EpiS2 E{(const bf16_t*)(ws + WS_ASSM), F.in[IN_SSMD], (bf16_t*)(ws + WS_GBUF)};
        pg8::gemm_phase<EpiS2, SsmSched, true, false>(F.lds, gtab, F.wave, g, S, E);
    }
    SEAM(5);
    if (IN(6)) {
        pg8::Gemm g{512, 512, 512}; GluUpSched S{G, F.vcu, (const char*)(ws + WS_GBUF), (const char*)(ws + WS_WGLU), (const char*)(ws + WS_Q), (const char*)(ws + WS_WUPA)};
        EpiGluUp E{(const bf16_t*)(ws + WS_GBUF), F.in[IN_BGLU], (bf16_t*)(ws + WS_SOUT), (const bf16_t*)(ws + WS_SGA), (bf16_t*)(ws + WS_P1)};
        pg8::gemm_phase<EpiGluUp, GluUpSched, true, false>(F.lds, gtab, F.wave, g, S, E);
    }
    SEAM(6);
    if (IN(7)) {
        pg8::Gemm g{512, 512, 512}; DenseSched S; S.init(M, DM, G, bx, ws + WS_SOUT, 512, ws + WS_WUPS, 512);
        EpiUp2 E{(const bf16_t*)(ws + WS_P1), (const bf16_t*)(ws + WS_SGS), (bf16_t*)(ws + WS_MIX)};
        pg8::gemm_phase<EpiUp2, DenseSched, true, false>(F.lds, gtab, F.wave, g, S, E);
    }
    SEAM(7);
    if (IN(8)) {
        pg8::Gemm g{DM, DM, DM}; DenseSched S; S.init(M, DM, G, bx, ws + WS_MIX, DM, ws + WS_WOUT, DM);
        EpiOut E{F.in[IN_X], mod, F.out};
        pg8::gemm_phase<EpiOut, DenseSched, true, false>(F.lds, gtab, F.wave, g, S, E);
    }
    SEAM(8);
    if (IN(9)) norm_mod_rows(F, F.out, F.in[IN_LN2G], 3072, 4096, (bf16_t*)(ws + WS_H));
    SEAM(9);
    if (IN(10)) {
        pg8::Gemm g{DM, DM, DM}; DenseSched S; S.init(M, 768, G, bx, ws + WS_H, DM, ws + WS_WRSH, DM);
        EpiRsh E{(float*)(ws + WS_SCORES), (bf16_t*)(ws + WS_HS)};
        pg8::gemm_phase<EpiRsh, DenseSched, true, false>(F.lds, gtab, F.wave, g, S, E);
    }
    SEAM(10);
    if (IN(11)) {
        route_clear(F);
        topk_tokens(F);
        __syncthreads();
        pg8::Gemm g{ED, ED, ED}; DenseSched S; S.init(M, DM, G, bx, ws + WS_HS, ED, ws + WS_WSHD, ED);
        EpiBf16 E{(bf16_t*)(ws + WS_YSH), 1024};
        pg8::gemm_phase<EpiBf16, DenseSched, true, false>(F.lds, gtab, F.wave, g, S, E);
    }
    SEAM(11);
    if (IN(12)) route_scatter(F);
    SEAM(12);
    if (IN(13)) {
        const int ntl = build_tiles(F);
        pg8::Gemm g{DM, DM, DM};
        MoeSched S{G, F.vcu, 2, ntl, (const LAS unsigned short*)(F.lds + TILEE_OFF), (const char*)(ws + WS_H), (const char*)(ws + WS_WEGU), 0, (size_t)512 * DM * 2, (size_t)256 * DM * 2, (const int*)(ws + WS_ROUTE + 2 * MiB)};
        EpiMoe1 E{(bf16_t*)(ws + WS_HSORT)};
        pg8::gemm_phase<EpiMoe1, MoeSched, true, true>(F.lds, gtab, F.wave, g, S, E);
    }
    SEAM(13);
    if (IN(14)) {
        const int ntl = build_tiles(F);
        pg8::Gemm g{ED, ED, ED};
        MoeSched S{G, F.vcu, 4, ntl, (const LAS unsigned short*)(F.lds + TILEE_OFF), (const char*)(ws + WS_HSORT), (const char*)(ws + WS_WED), (size_t)256 * ED * 2, (size_t)DM * ED * 2, (size_t)256 * ED * 2, nullptr};
        EpiMoe2 E{(const int*)(ws + WS_ROUTE + 4 * MiB), (const float*)(ws + WS_ROUTE + 3 * MiB), (bf16_t*)(ws + WS_Y)};
        pg8::gemm_phase<EpiMoe2, MoeSched, true, false>(F.lds, gtab, F.wave, g, S, E);
    }
    SEAM(14);
    if (IN(15)) combine(F);
#undef IN
#undef SEAM
}

extern "C" void kernel_launch(void* const* d_in, const int* in_sizes, int n_in, void* d_out, int out_size, void* d_ws, size_t ws_size, hipStream_t stream) {
    static int grid = 0;
    if (grid == 0) {
        if (n_in != 31 || out_size != M * DM || ws_size < WS_END) { fprintf(stderr, "kernel_launch: unexpected shapes (n_in %d out %d ws %zu)\n", n_in, out_size, ws_size); grid = -1; return; }
        int dev = 0, cus = 0;
        if (hipGetDevice(&dev) != hipSuccess || hipDeviceGetAttribute(&cus, hipDeviceAttributeMultiprocessorCount, dev) != hipSuccess) { grid = -1; return; }
        if (hipFuncSetAttribute((const void*)mk_fwd, hipFuncAttributeMaxDynamicSharedMemorySize, LDS_BYTES) != hipSuccess) { fprintf(stderr, "kernel_launch: hipFuncSetAttribute failed\n"); grid = -1; return; }
        int per_cu = 0;
        if (hipOccupancyMaxActiveBlocksPerMultiprocessor(&per_cu, (const void*)mk_fwd, 512, LDS_BYTES) != hipSuccess || per_cu < 1) fprintf(stderr, "kernel_launch: occupancy query says %d\n", per_cu);
        (void)hipGetLastError();
        grid = cus;
    }
    if (grid < 0) return;
    (void)hipMemsetAsync((char*)d_ws + WS_CTL, 0, CTL_ZERO_BYTES, stream);
    Args a{};
    for (int i = 0; i < 31; ++i) a.in[i] = (const float*)d_in[i];
    a.out = (float*)d_out; a.ws = (unsigned char*)d_ws;
#if MK_PER_PHASE
    for (int p = 0; p < NPHASE; ++p) { a.ph_lo = p; a.ph_hi = p + 1; hipLaunchKernelGGL(mk_fwd, dim3(grid), dim3(512), LDS_BYTES, stream, a); }
#else
    a.ph_lo = 0; a.ph_hi = NPHASE;
    hipLaunchKernelGGL(mk_fwd, dim3(grid), dim3(512), LDS_BYTES, stream, a);
#endif
}
```

```cpp
#include <hip/hip_runtime.h>
#include <cstdio>
#include <cstdint>

#ifndef MK_PER_PHASE
#define MK_PER_PHASE 0
#endif

#define LAS __attribute__((address_space(3)))
#define GAS __attribute__((address_space(1)))
typedef unsigned short bf16_t;
typedef short bf16x8 __attribute__((ext_vector_type(8)));
typedef short s16x4 __attribute__((ext_vector_type(4)));
typedef float f32x2 __attribute__((ext_vector_type(2)));
typedef float f32x4 __attribute__((ext_vector_type(4)));
typedef float f32x16 __attribute__((ext_vector_type(16)));
typedef unsigned u32x2 __attribute__((ext_vector_type(2)));
typedef unsigned u32x4 __attribute__((ext_vector_type(4)));
typedef __bf16 bf16x2_t __attribute__((ext_vector_type(2)));

#define DI __device__ __forceinline__
DI unsigned pk2(float lo, float hi) { f32x2 v = {lo, hi}; bf16x2_t b = __builtin_convertvector(v, bf16x2_t); return __builtin_bit_cast(unsigned, b); }
DI float bflo(unsigned w) { return __uint_as_float(w << 16); }
DI float bfhi(unsigned w) { return __uint_as_float(w & 0xffff0000u); }
DI float sigmoidf_(float x) { return 1.0f / (1.0f + __expf(-x)); }
DI float siluf_(float x) { return x / (1.0f + __expf(-x)); }
DI float gelu_tanh(float y) { const float z = 0.7978845608028654f * (y + 0.044715f * y * y * y); const float t = 1.0f - 2.0f / (__expf(2.0f * z) + 1.0f); return 0.5f * y * (1.0f + t); }

constexpr int NB = 4, SEQ = 4096, DM = 1024, M = NB * SEQ;
constexpr int NH = 8, HD = 64, AW = 512, SW = 512, INW = 4096;
constexpr int NE = 256, ED = 256, TOPK = 8;
constexpr int NG = 32, GC = 16, NS = 64, CH = 16, NCH = SEQ / CH;
constexpr int MAXTILES = 768, MAXROWS = MAXTILES * 256;
constexpr float EPSF = 1e-6f;
constexpr float LOG2E = 1.4426950408889634f;
constexpr float QC2 = 0.125f * LOG2E;

constexpr size_t MiB = 1u << 20;
constexpr size_t WS_CTL = 0, CTL_ZERO_BYTES = 1 * MiB;
constexpr size_t WS_SMALL = 1 * MiB;
constexpr size_t WS_WIN = 4 * MiB, WS_WGLU = 12 * MiB, WS_WUPA = 13 * MiB, WS_WUPS = 14 * MiB, WS_WOUT = 15 * MiB, WS_WRSH = 17 * MiB, WS_WSHD = 19 * MiB;
constexpr size_t WS_TF = 20 * MiB, WS_ET = 26 * MiB;
constexpr size_t WS_WEGU = 32 * MiB, WS_WED = 288 * MiB;
constexpr size_t WS_H = 416 * MiB;
constexpr size_t WS_Q = 448 * MiB, WS_K = 464 * MiB, WS_V = 480 * MiB;
constexpr size_t WS_ASSM = 496 * MiB, WS_HLOC = 520 * MiB;
constexpr size_t WS_GBUF = 536 * MiB, WS_SOUT = 552 * MiB;
constexpr size_t WS_SGA = 568 * MiB, WS_SGS = 600 * MiB;
constexpr size_t WS_P1 = 632 * MiB, WS_MIX = 664 * MiB;
constexpr size_t WS_SCORES = 696 * MiB, WS_HS = 712 * MiB, WS_YSH = 720 * MiB;
constexpr size_t WS_ROUTE = 752 * MiB;
constexpr size_t WS_HSORT = 760 * MiB;
constexpr size_t WS_Y = 416 * MiB;
constexpr size_t WS_END = 856 * MiB;
constexpr int CW_BAR = 4096;
constexpr int CW_CNT = 16384;
constexpr int CW_KMEAN = 32768;

constexpr int RING_BYTES = 131072;
constexpr int GTAB_OFF = RING_BYTES;
constexpr int TILEE_OFF = GTAB_OFF + 2048;
constexpr int SCAN_OFF = TILEE_OFF + 3072;
constexpr int MISC_OFF = SCAN_OFF + 2048;
constexpr int LDS_BYTES = 147456;
static_assert(MISC_OFF + 256 <= LDS_BYTES, "LDS map");

namespace pg8 {
constexpr int BM = 256, BK = 64, HALF = 128, HTB = HALF * BK * 2, STAGE_BYTES = 8 * HTB, NXCD = 8, WGM = 8;
__host__ __device__ __forceinline__ int lds_byte(int r, int c) { const int st = (r >> 4) * 2 + (c >> 5), rr = r & 15, cc = c & 31, ob = rr * 64 + cc * 2; return st * 1024 + (ob ^ (((ob >> 9) & 1) << 5)); }
__host__ __device__ __forceinline__ void stage_rc(int b, int& R, int& C) { const int st = b / 1024, sb = b % 1024, swz = sb ^ (((sb >> 9) & 1) << 5); R = (st >> 1) * 16 + swz / 64; C = (st & 1) * 32 + (swz % 64) / 2; }
__host__ __device__ __forceinline__ int perm32(int rho) { const int n = rho >> 4, i = rho & 15; return 8 * (i >> 2) + 4 * n + (i & 3); }

struct Unit { const char* A; const char* B; const int* rowtab; int pm, pn, aux, half; };
struct Gemm { int lda, ldb, K; };

struct StaticOrder {
    int nM, nN, nwg, G, c;
    __device__ void init(int M_, int N_, int G_, int c_) { nM = M_ / BM; nN = N_ / BM; nwg = nM * nN; G = G_; c = c_; }
    __device__ bool next(int i, int& pm, int& pn) const {
        const long L = (long)i * G + c; if (L >= nwg) return false;
        int wgid = (int)L; { const int q = nwg / NXCD, r = nwg % NXCD, xcd = wgid % NXCD, off = wgid / NXCD; wgid = (xcd < r ? xcd * (q + 1) : r * (q + 1) + (xcd - r) * q) + off; }
        const int nig = WGM * nN, gid = wgid / nig, fm = gid * WGM, gsz = (nM - fm) < WGM ? (nM - fm) : WGM;
        pm = fm + ((wgid % nig) % gsz); pn = (wgid % nig) / gsz; return true;
    }
};

template <class Epi, class Sched, bool ALIGN_EPI, bool GATHER>
__device__ __forceinline__ void gemm_phase(LAS unsigned char* lds, LAS unsigned* gtab, const int wid, const Gemm g, const Sched& S, const Epi& E) {
    const int lane = (int)__builtin_amdgcn_mbcnt_hi(~0u, __builtin_amdgcn_mbcnt_lo(~0u, 0u)), tid = wid * 64 + lane, wr = wid >> 2, wc = wid & 3, fr = lane & 15, fq = lane >> 4;
    const int K = g.K, nt = K / BK;
    unsigned voffA[2], voffB[2]; int gR[2];
#pragma unroll
    for (int i = 0; i < 2; ++i) { int R, C; stage_rc(tid * 16 + i * 8192, R, C); const int Rb = Epi::PERM ? ((R & ~31) + perm32(R & 31)) : R;
        voffA[i] = GATHER ? (unsigned)(C * 2) : (unsigned)(R * g.lda + C) * 2u; voffB[i] = (unsigned)(Rb * g.ldb + C) * 2u; gR[i] = R; }
    const size_t kstep = (size_t)(BK * 2);
    const size_t hstepA = (size_t)HALF * g.lda * 2, hstepB = (size_t)HALF * g.ldb * 2;
    const unsigned ldsw = (unsigned)wid * 1024u;
    const int aoff = lds_byte(wr * 64 + fr, fq * 8), boff = lds_byte(wc * 32 + fr, fq * 8);
#define PG8_SA(b, h) (((b) * 2 + (h)) * HTB)
#define PG8_SB(b, h) ((4 + (b) * 2 + (h)) * HTB)
#define PG8_STAGEB(bufoff, gbase) do { _Pragma("unroll") for (int _i = 0; _i < 2; ++_i) \
        __builtin_amdgcn_global_load_lds((const unsigned*)((const char*)(gbase) + voffB[_i]), (LAS unsigned*)(lds + (bufoff) + ldsw + _i * 8192), 16, 0, 0); } while (0)
#define PG8_STAGEA(bufoff, gbase, par, half) do { _Pragma("unroll") for (int _i = 0; _i < 2; ++_i) { \
        const char* _src = GATHER ? ((const char*)(gbase) + gtab[(par) * 256 + (half) * 128 + gR[_i]] + voffA[_i]) : ((const char*)(gbase) + (size_t)(half) * hstepA + voffA[_i]); \
        __builtin_amdgcn_global_load_lds((const unsigned*)_src, (LAS unsigned*)(lds + (bufoff) + ldsw + _i * 8192), 16, 0, 0); } } while (0)
#define PG8_TABLOAD(par, un) do { __builtin_amdgcn_global_load_lds((const unsigned*)((un).rowtab + 64 * (wid & 3) + lane), (LAS unsigned*)(gtab + (par) * 256 + 64 * (wid & 3)), 4, 0, 0); } while (0)
#define PG8_LDA(dst, b, h) do { _Pragma("unroll") for (int m = 0; m < 4; ++m) _Pragma("unroll") for (int k = 0; k < 2; ++k) dst[m][k] = *(const LAS bf16x8*)(lds + PG8_SA(b, h) + aoff + m * 2048 + k * 1024); } while (0)
#define PG8_LDB(dst, b, h) do { _Pragma("unroll") for (int n = 0; n < 2; ++n) _Pragma("unroll") for (int k = 0; k < 2; ++k) dst[n][k] = *(const LAS bf16x8*)(lds + PG8_SB(b, h) + boff + n * 2048 + k * 1024); } while (0)
#define PG8_MMA(ai, bj, At, Bt) do { __builtin_amdgcn_s_setprio(1); _Pragma("unroll") for (int m = 0; m < 4; ++m) _Pragma("unroll") for (int n = 0; n < 2; ++n) _Pragma("unroll") for (int k = 0; k < 2; ++k) \
        acc[ai][bj][m][n] = __builtin_amdgcn_mfma_f32_16x16x32_bf16(Bt[n][k], At[m][k], acc[ai][bj][m][n], 0, 0, 0); __builtin_amdgcn_s_setprio(0); } while (0)
#define PG8_WAIT_V(n) asm volatile("s_waitcnt vmcnt(" #n ")" ::: "memory")
#define PG8_WAIT_L(n) asm volatile("s_waitcnt lgkmcnt(" #n ")" ::: "memory")
#define PG8_BAR __builtin_amdgcn_s_barrier()
#define PG8_SCHED __builtin_amdgcn_sched_barrier(0)
    Unit cur, nxt; int ui = 0;
    if (!S.next(0, cur)) return;
    f32x4 acc[2][2][4][2];
#pragma unroll
    for (int a = 0; a < 2; ++a)
#pragma unroll
        for (int b = 0; b < 2; ++b)
#pragma unroll
            for (int m = 0; m < 4; ++m)
#pragma unroll
                for (int n = 0; n < 2; ++n) acc[a][b][m][n] = (f32x4){0.f, 0.f, 0.f, 0.f};
    bf16x8 At[4][2], B0[2][2], B1[2][2];
    const char* cA = cur.A; const char* cB = cur.B;
    if constexpr (GATHER) { PG8_TABLOAD(0, cur); PG8_WAIT_V(0); PG8_BAR; }
    PG8_STAGEB(PG8_SB(0, 0), cB); PG8_STAGEB(PG8_SB(0, 1), cB + hstepB); PG8_STAGEA(PG8_SA(0, 0), cA, 0, 0); PG8_STAGEA(PG8_SA(0, 1), cA, 0, 1);
    if (wr == 1) PG8_BAR;
    PG8_WAIT_V(2); PG8_BAR;
    PG8_STAGEB(PG8_SB(1, 0), cB + kstep); PG8_STAGEA(PG8_SA(1, 0), cA + kstep, 0, 0); PG8_STAGEB(PG8_SB(1, 1), cB + hstepB + kstep);
    PG8_WAIT_V(6); PG8_BAR;
    for (;;) {
        const bool has_next = S.next(ui + 1, nxt);
        const char* nA = has_next ? nxt.A : cA; const char* nB = has_next ? nxt.B : cB;
        const int pc = ui & 1, pnx = has_next ? (pc ^ 1) : pc;
        if constexpr (GATHER) { if (has_next) PG8_TABLOAD(pc ^ 1, nxt); }
#pragma unroll 1
        for (int t = 0; t < nt; t += 2) {
            const bool last = (t == nt - 2);
            const char* a1 = cA + (size_t)(t + 1) * kstep;
            const char* a2 = last ? nA : cA + (size_t)(t + 2) * kstep; const char* b2 = last ? nB : cB + (size_t)(t + 2) * kstep;
            const char* a3 = a2 + kstep; const char* b3 = b2 + kstep;
            const int p2 = last ? pnx : pc;
            PG8_LDB(B0, 0, 0); PG8_LDB(B1, 0, 1); PG8_SCHED; PG8_LDA(At, 0, 0); PG8_STAGEA(PG8_SA(1, 1), a1, pc, 1);
            PG8_WAIT_V(8); PG8_WAIT_L(0); PG8_BAR; PG8_MMA(0, 0, At, B0); PG8_MMA(0, 1, At, B1); PG8_BAR; PG8_SCHED;
            PG8_LDA(At, 0, 1); PG8_STAGEB(PG8_SB(0, 0), b2); PG8_STAGEB(PG8_SB(0, 1), b2 + hstepB); PG8_STAGEA(PG8_SA(0, 0), a2, p2, 0);
            PG8_WAIT_V(8); PG8_WAIT_L(0); PG8_BAR; if (!cur.half) { PG8_MMA(1, 0, At, B0); PG8_MMA(1, 1, At, B1); } PG8_BAR; PG8_SCHED;
            PG8_LDB(B0, 1, 0); PG8_LDB(B1, 1, 1); PG8_SCHED; PG8_LDA(At, 1, 0); PG8_STAGEA(PG8_SA(0, 1), a2, p2, 1);
            PG8_WAIT_V(8); PG8_WAIT_L(0); PG8_BAR; PG8_MMA(0, 0, At, B0); PG8_MMA(0, 1, At, B1); PG8_BAR; PG8_SCHED;
            PG8_LDA(At, 1, 1); PG8_STAGEB(PG8_SB(1, 0), b3); PG8_STAGEB(PG8_SB(1, 1), b3 + hstepB); PG8_STAGEA(PG8_SA(1, 0), a3, p2, 0);
            PG8_WAIT_V(8); PG8_WAIT_L(0); PG8_BAR; if (!cur.half) { PG8_MMA(1, 0, At, B0); PG8_MMA(1, 1, At, B1); } PG8_BAR; PG8_SCHED;
        }
        if constexpr (ALIGN_EPI) { if (wr == 0) PG8_BAR; }
        { int fr_ = fr, fq_ = fq; asm volatile("" : "+v"(fr_), "+v"(fq_)); E(acc, cur, wr, wc, fr_, fq_); }
        if (!has_next) break;
#pragma unroll
        for (int a = 0; a < 2; ++a)
#pragma unroll
            for (int b = 0; b < 2; ++b)
#pragma unroll
                for (int m = 0; m < 4; ++m)
#pragma unroll
                    for (int n = 0; n < 2; ++n) acc[a][b][m][n] = (f32x4){0.f, 0.f, 0.f, 0.f};
        cur = nxt; cA = nA; cB = nB; ++ui;
        if constexpr (ALIGN_EPI) { if (wr == 1) PG8_BAR; }
    }
    PG8_WAIT_V(0);
    if constexpr (!ALIGN_EPI) { if (wr == 0) PG8_BAR; }
    PG8_BAR;
#undef PG8_SA
#undef PG8_SB
#undef PG8_STAGEA
#undef PG8_STAGEB
#undef PG8_TABLOAD
#undef PG8_LDA
#undef PG8_LDB
#undef PG8_MMA
#undef PG8_WAIT_V
#undef PG8_WAIT_L
#undef PG8_BAR
#undef PG8_SCHED
}
}

typedef f32x4 AccT[2][2][4][2];
using pg8::Unit;

typedef GAS unsigned gu32;
#define XB_TMO      128
#define XB_XCNT(j)  (256  + 64 * (j))
#define XB_XSUB(j)  (1280 + 64 * (j))
#define XB_XGEN(j)  (2304 + 64 * (j))
#define XB_TOP      3328
#define XB_TOPGEN   3392
#define XCD_BAR_WORDS 3456
#define XB_SPIN_CAP (1u << 20)
DI unsigned xb_ld(unsigned* p)              { return __hip_atomic_load(p, __ATOMIC_RELAXED, __HIP_MEMORY_SCOPE_AGENT); }
DI unsigned xb_add(unsigned* p, unsigned v) { return __hip_atomic_fetch_add(p, v, __ATOMIC_RELAXED, __HIP_MEMORY_SCOPE_AGENT); }
DI unsigned xb_xcc_id() { return (unsigned)__builtin_amdgcn_s_getreg((3 << 11) | 20) & 0xFu; }
#define XB_SPIN(cond, bar) do { unsigned _sp = 0; while (cond) { __builtin_amdgcn_s_sleep(1); \
    if ((++_sp & 255u) == 0u) { if (xb_ld(&(bar)[XB_TMO])) break; if (_sp > XB_SPIN_CAP) { atomicAdd(&(bar)[XB_TMO], 1u); break; } } } } while (0)
DI int lane_id() { int l = (int)__builtin_amdgcn_mbcnt_hi(~0u, __builtin_amdgcn_mbcnt_lo(~0u, 0u)); asm volatile("" : "+v"(l)); return l; }
struct XcdBarrier { unsigned* bar; unsigned x; volatile LAS unsigned* st; int wave; };
DI XcdBarrier xcd_barrier_post(unsigned* bar, volatile LAS unsigned* st, int wave) {
    XcdBarrier b; b.bar = bar; b.x = xb_xcc_id(); b.st = st; b.wave = wave;
    if (wave == 0 && lane_id() == 0) (void)xb_add(&bar[XB_XCNT(b.x)], 1u);
    return b;
}
DI void xcd_barrier_complete(unsigned* bar, unsigned x, unsigned& nloc, unsigned& nx) {
    const unsigned G = gridDim.x * gridDim.y * gridDim.z;
    unsigned sum, cnt, mine, sp = 0u;
    for (;;) {
        sum = 0u; cnt = 0u; mine = 0u;
#pragma unroll
        for (unsigned j = 0; j < 16; ++j) { const unsigned c = xb_ld(&bar[XB_XCNT(j)]); sum += c; cnt += (c > 0u) ? 1u : 0u; mine = (j == x) ? c : mine; }
        if (sum == G) break;
        __builtin_amdgcn_s_sleep(1);
        if ((++sp & 255u) == 0u) { if (xb_ld(&bar[XB_TMO])) break; if (sp > XB_SPIN_CAP) { atomicAdd(&bar[XB_TMO], 1u); break; } }
    }
    nloc = mine > 0u ? mine : 1u; nx = cnt > 0u ? cnt : 1u;
}
DI void xcd_barrier(const XcdBarrier& b) {
    asm volatile("s_waitcnt vmcnt(0)" ::: "memory");
    __syncthreads();
    if (b.wave == 0 && lane_id() == 0) {
        unsigned* bar = b.bar;
        __builtin_amdgcn_s_waitcnt(0);
        unsigned nloc = b.st[0], nx = b.st[1];
        if (nloc == 0u) { xcd_barrier_complete(bar, b.x, nloc, nx); b.st[0] = nloc; b.st[1] = nx; }
        const unsigned old = xb_add(&bar[XB_XSUB(b.x)], 1u);
        const unsigned gen = old / nloc;
        if (old + 1u == (gen + 1u) * nloc) {
            __builtin_amdgcn_fence(__ATOMIC_RELEASE, "agent");
            asm volatile("s_waitcnt vmcnt(0)" ::: "memory");
            const unsigned og = xb_add(&bar[XB_TOP], 1u);
            const unsigned tg = og / nx;
            if (og + 1u == (tg + 1u) * nx) xb_add(&bar[XB_TOPGEN], 1u);
            else XB_SPIN(xb_ld(&bar[XB_TOPGEN]) == tg, bar);
            __builtin_amdgcn_fence(__ATOMIC_ACQUIRE, "agent");
            xb_add(&bar[XB_XGEN(b.x)], 1u);
            asm volatile("s_waitcnt vmcnt(0)" ::: "memory");
        } else {
            XB_SPIN(xb_ld(&bar[XB_XGEN(b.x)]) == gen, bar);
            __builtin_amdgcn_fence(__ATOMIC_ACQUIRE, "agent");
            asm volatile("s_waitcnt vmcnt(0)" ::: "memory");
        }
    }
    __syncthreads();
}

struct Args { const float* in[31]; float* out; unsigned char* ws; int ph_lo, ph_hi; };
template <int I> DI const float* in_ptr() { const void* kp = (const void*)__builtin_amdgcn_kernarg_segment_ptr(); unsigned long long r;
    asm volatile("s_load_dwordx2 %0, %1, %2\n\ts_waitcnt lgkmcnt(0)" : "=s"(r) : "s"(kp), "i"(I * 8)); return (const float*)(const GAS float*)r; }
struct InTab { int dummy; };
struct Frame {
    LAS unsigned char* lds; int wave, vcu, G;
    InTab in; float* out; unsigned char* ws;
    DI int lane_() const { return lane_id(); }
    DI int tid_() const { return wave * 64 + lane_id(); }
};
#define FTID (F.tid_())
#define FLANE (F.lane_())
#define IN_X 0
#define IN_C 1
#define IN_RELB 2
#define IN_WADA 3
#define IN_BADA 4
#define IN_LN1G 5
#define IN_WIN 6
#define IN_QG 7
#define IN_KG 8
#define IN_LRE 9
#define IN_LIM 10
#define IN_LDT 11
#define IN_BRE 12
#define IN_BIM 13
#define IN_CRE 14
#define IN_CIM 15
#define IN_SSMD 16
#define IN_WGLU 17
#define IN_BGLU 18
#define IN_WUPA 19
#define IN_WUPS 20
#define IN_WOUT 21
#define IN_LN2G 22
#define IN_WROUTER 23
#define IN_RBIAS 24
#define IN_WEG 25
#define IN_WEU 26
#define IN_WED 27
#define IN_WSG 28
#define IN_WSU 29
#define IN_WSD 30

DI float wave_sum(float v) {
#pragma unroll
    for (int o = 1; o < 64; o <<= 1) v += __shfl_xor(v, o);
    return v;
}

template <class RowMap>
DI void tr_item(const float* W, int N, bf16_t* WT, int ldt, int k0, int n0, int lane, RowMap rm) {
    float v[64];
    const float* src = W + (size_t)k0 * N + n0 + lane;
#pragma unroll
    for (int i = 0; i < 64; ++i) v[i] = src[(size_t)i * N];
    bf16_t* dst = WT + (size_t)rm(n0 + lane) * ldt + k0;
#pragma unroll
    for (int j = 0; j < 8; ++j) { u32x4 o; o.x = pk2(v[8 * j], v[8 * j + 1]); o.y = pk2(v[8 * j + 2], v[8 * j + 3]); o.z = pk2(v[8 * j + 4], v[8 * j + 5]); o.w = pk2(v[8 * j + 6], v[8 * j + 7]);
        *(u32x4*)(dst + 8 * j) = o; }
}
struct RmGen { int kind, base; DI int operator()(int n) const { if (kind == 0) return base + n;
    if (kind == 1) { if (n >= 1024) return n; const int tile = n >> 8, w = n & 255, hh = w >> 6, bj = (w >> 5) & 1, i = w & 31; return tile * 256 + 128 * bj + 32 * hh + i; }
    return base + 256 * (n >> 7) + (n & 127); } };
constexpr int I_WIN = 16 * 64, I_GLU = 8 * 8, I_UPA = 8 * 16, I_UPS = 8 * 16, I_OUT = 16 * 16, I_RT = 16 * 4, I_SG = 16 * 4, I_SU = 16 * 4, I_SD = 4 * 16;
constexpr int I_SMALL = I_WIN + I_GLU + I_UPA + I_UPS + I_OUT + I_RT + I_SG + I_SU + I_SD;
constexpr int I_EG = 256 * 64, I_EU = 256 * 64, I_EDN = 256 * 64;
constexpr int NITEMS = I_SMALL + I_EG + I_EU + I_EDN;
DI void conv_items(Frame& F, int lo, int hi) {
    const int gw = F.vcu * 8 + F.wave, NGW = F.G * 8, lane = FLANE;
    unsigned char* ws = F.ws;
#pragma unroll 1
    for (int it = lo + gw; it < hi; it += NGW) {
        int r = it; const float* W; int N, ldt, k0, n0; bf16_t* WT; RmGen rm{0, 0};
        if (r < I_WIN) { W = in_ptr<IN_WIN>(); N = INW; WT = (bf16_t*)(ws + WS_WIN); ldt = DM; k0 = 64 * (r / 64); n0 = 64 * (r % 64); rm.kind = 1; }
        else if ((r -= I_WIN) < I_GLU) { W = in_ptr<IN_WGLU>(); N = SW; WT = (bf16_t*)(ws + WS_WGLU); ldt = SW; k0 = 64 * (r / 8); n0 = 64 * (r % 8); }
        else if ((r -= I_GLU) < I_UPA) { W = in_ptr<IN_WUPA>(); N = DM; WT = (bf16_t*)(ws + WS_WUPA); ldt = AW; k0 = 64 * (r / 16); n0 = 64 * (r % 16); }
        else if ((r -= I_UPA) < I_UPS) { W = in_ptr<IN_WUPS>(); N = DM; WT = (bf16_t*)(ws + WS_WUPS); ldt = SW; k0 = 64 * (r / 16); n0 = 64 * (r % 16); }
        else if ((r -= I_UPS) < I_OUT) { W = in_ptr<IN_WOUT>(); N = DM; WT = (bf16_t*)(ws + WS_WOUT); ldt = DM; k0 = 64 * (r / 16); n0 = 64 * (r % 16); }
        else if ((r -= I_OUT) < I_RT) { W = in_ptr<IN_WROUTER>(); N = NE; WT = (bf16_t*)(ws + WS_WRSH); ldt = DM; k0 = 64 * (r / 4); n0 = 64 * (r % 4); }
        else if ((r -= I_RT) < I_SG) { W = in_ptr<IN_WSG>(); N = ED; WT = (bf16_t*)(ws + WS_WRSH); ldt = DM; k0 = 64 * (r / 4); n0 = 64 * (r % 4); rm.kind = 2; rm.base = 256; }
        else if ((r -= I_SG) < I_SU) { W = in_ptr<IN_WSU>(); N = ED; WT = (bf16_t*)(ws + WS_WRSH); ldt = DM; k0 = 64 * (r / 4); n0 = 64 * (r % 4); rm.kind = 2; rm.base = 256 + 128; }
        else if ((r -= I_SU) < I_SD) { W = in_ptr<IN_WSD>(); N = DM; WT = (bf16_t*)(ws + WS_WSHD); ldt = ED; k0 = 64 * (r / 16); n0 = 64 * (r % 16); }
        else if ((r -= I_SD) < I_EG) { const int e = r / 64, q = r % 64; W = in_ptr<IN_WEG>() + (size_t)e * DM * ED; N = ED; WT = (bf16_t*)(ws + WS_WEGU) + (size_t)e * 512 * DM; ldt = DM; k0 = 64 * (q / 4); n0 = 64 * (q % 4); rm.kind = 2; }
        else if ((r -= I_EG) < I_EU) { const int e = r / 64, q = r % 64; W = in_ptr<IN_WEU>() + (size_t)e * DM * ED; N = ED; WT = (bf16_t*)(ws + WS_WEGU) + (size_t)e * 512 * DM; ldt = DM; k0 = 64 * (q / 4); n0 = 64 * (q % 4); rm.kind = 2; rm.base = 128; }
        else { r -= I_EU; const int e = r / 64, q = r % 64; W = in_ptr<IN_WED>() + (size_t)e * ED * DM; N = DM; WT = (bf16_t*)(ws + WS_WED) + (size_t)e * DM * ED; ldt = ED; k0 = 64 * (q / 16); n0 = 64 * (q % 16); }
        tr_item(W, N, WT, ldt, k0, n0, lane, rm);
    }
}
DI void p0_adaln(Frame& F, int cb) {
    LAS float* sc = (LAS float*)F.lds;
    LAS float* red = (LAS float*)(F.lds + 16384);
    for (int i = FTID; i < 4096; i += 512) sc[i] = siluf_(in_ptr<IN_C>()[i]);
    __syncthreads();
    const int j = cb * 64 + FLANE; const float* w = in_ptr<IN_WADA>() + j;
    float a0 = 0.f, a1 = 0.f, a2 = 0.f, a3 = 0.f;
    const int kb = F.wave * 128;
#pragma unroll 8
    for (int k = 0; k < 128; ++k) { const float wv = w[(size_t)(kb + k) * 6144]; a0 += sc[kb + k] * wv; a1 += sc[1024 + kb + k] * wv; a2 += sc[2048 + kb + k] * wv; a3 += sc[3072 + kb + k] * wv; }
    red[(F.wave * 4 + 0) * 64 + FLANE] = a0; red[(F.wave * 4 + 1) * 64 + FLANE] = a1; red[(F.wave * 4 + 2) * 64 + FLANE] = a2; red[(F.wave * 4 + 3) * 64 + FLANE] = a3;
    __syncthreads();
    if (FTID < 256) { const int b = FTID >> 6, l = FTID & 63; float s = in_ptr<IN_BADA>()[cb * 64 + l];
#pragma unroll
        for (int w8 = 0; w8 < 8; ++w8) s += red[(w8 * 4 + b) * 64 + l];
        ((float*)(F.ws + WS_SMALL))[b * 6144 + cb * 64 + l] = s; }
    __syncthreads();
}
DI void p0_ssm(Frame& F, int g) {
    LAS float* apow = (LAS float*)F.lds;
    LAS float* bb = apow + 17 * 64 * 2;
    LAS float* cc = bb + 64 * 16 * 2;
    LAS float* km = cc + 16 * 64 * 2;
    const int tid = FTID;
    if (tid < 64) {
        const int p = tid;
        const float lre = fminf(in_ptr<IN_LRE>()[g * 64 + p], -1e-4f), lim = in_ptr<IN_LIM>()[g * 64 + p], dt = expf(in_ptr<IN_LDT>()[g]);
        const float mag = expf(lre * dt); float sn, cs; sincosf(lim * dt, &sn, &cs);
        const float are = mag * cs, aim = mag * sn, den = lre * lre + lim * lim, nr = are - 1.0f;
        const float cre = (nr * lre + aim * lim) / den, cim = (aim * lre - nr * lim) / den;
        for (int tau = 0; tau <= 16; ++tau) { const float mg = expf(lre * dt * (float)tau); float s2, c2; sincosf(lim * dt * (float)tau, &s2, &c2); apow[(tau * 64 + p) * 2] = mg * c2; apow[(tau * 64 + p) * 2 + 1] = mg * s2; }
        for (int c = 0; c < 16; ++c) { const float br = in_ptr<IN_BRE>()[(g * 64 + p) * 16 + c], bi = in_ptr<IN_BIM>()[(g * 64 + p) * 16 + c];
            bb[(p * 16 + c) * 2] = cre * br - cim * bi; bb[(p * 16 + c) * 2 + 1] = cre * bi + cim * br; }
        float* a16 = (float*)(F.ws + WS_SMALL + 128 * 1024);
        const float mg = expf(lre * dt * 16.0f); float s2, c2; sincosf(lim * dt * 16.0f, &s2, &c2);
        a16[(g * 64 + p) * 2] = mg * c2; a16[(g * 64 + p) * 2 + 1] = mg * s2;
    }
    for (int i = tid; i < 1024; i += 512) { cc[i * 2] = in_ptr<IN_CRE>()[g * 1024 + i]; cc[i * 2 + 1] = in_ptr<IN_CIM>()[g * 1024 + i]; }
    __syncthreads();
    for (int e = tid; e < 4096; e += 512) { const int tau = e >> 8, c = (e >> 4) & 15, c2 = e & 15; float s = 0.f;
        for (int p = 0; p < 64; ++p) { const float cr = cc[(c * 64 + p) * 2], ci = cc[(c * 64 + p) * 2 + 1], ar = apow[(tau * 64 + p) * 2], ai = apow[(tau * 64 + p) * 2 + 1], br = bb[(p * 16 + c2) * 2], bi = bb[(p * 16 + c2) * 2 + 1];
            const float tr = cr * ar - ci * ai, ti = cr * ai + ci * ar; s += tr * br - ti * bi; }
        km[e] = s; }
    __syncthreads();
    bf16_t* TF = (bf16_t*)(F.ws + WS_TF) + (size_t)g * 256 * 384;
    for (int e = tid; e < 256 * 384; e += 512) { const int n = e / 384, k = e % 384, s = n >> 4, c = n & 15; float v;
        if (k < 256) { const int s2 = k >> 4, c2 = k & 15; v = (s >= s2) ? km[((s - s2) * 16 + c) * 16 + c2] : 0.f; }
        else { const int p = (k - 256) & 63; const float cr = cc[(c * 64 + p) * 2], ci = cc[(c * 64 + p) * 2 + 1], ar = apow[((s + 1) * 64 + p) * 2], ai = apow[((s + 1) * 64 + p) * 2 + 1];
            v = (k < 320) ? (cr * ar - ci * ai) : -(cr * ai + ci * ar); }
        TF[e] = (bf16_t)(pk2(v, 0.f) & 0xffffu); }
    bf16_t* ET = (bf16_t*)(F.ws + WS_ET) + (size_t)g * 256 * 256;
    for (int e = tid; e < 256 * 256; e += 512) { const int n = e >> 8, k = e & 255, s2 = k >> 4, c2 = k & 15; float v = 0.f;
        if (n < 128) { const int p = n & 63; const float ar = apow[((15 - s2) * 64 + p) * 2], ai = apow[((15 - s2) * 64 + p) * 2 + 1], br = bb[(p * 16 + c2) * 2], bi = bb[(p * 16 + c2) * 2 + 1];
            v = (n < 64) ? (ar * br - ai * bi) : (ar * bi + ai * br); }
        ET[e] = (bf16_t)(pk2(v, 0.f) & 0xffffu); }
    __syncthreads();
}

DI void norm_mod_rows(Frame& F, const float* x, const float* gvec, int sh_off, int sc_off, bf16_t* outp) {
    const float* mod = (const float*)(F.ws + WS_SMALL);
    const int gw = F.vcu * 8 + F.wave, NGW = F.G * 8;
    for (int m = gw; m < M; m += NGW) {
        const int b = m / SEQ;
        const f32x4* xr = (const f32x4*)(x + (size_t)m * DM) + FLANE;
        f32x4 v[4]; float s = 0.f;
#pragma unroll
        for (int j = 0; j < 4; ++j) { v[j] = xr[64 * j]; s += (v[j].x * v[j].x + v[j].y * v[j].y) + (v[j].z * v[j].z + v[j].w * v[j].w); }
        const float rstd = 1.0f / sqrtf(wave_sum(s) * (1.0f / DM) + EPSF);
        u32x2* o8 = (u32x2*)(outp + (size_t)m * DM) + FLANE;
#pragma unroll
        for (int j = 0; j < 4; ++j) { const int col = 4 * FLANE + 256 * j;
            const f32x4 gv = *(const f32x4*)(gvec + col), scv = *(const f32x4*)(mod + b * 6144 + sc_off + col), shv = *(const f32x4*)(mod + b * 6144 + sh_off + col);
            const f32x4 y = v[j] * rstd * gv * (scv + 1.0f) + shv;
            u32x2 w; w.x = pk2(y.x, y.y); w.y = pk2(y.z, y.w); o8[64 * j] = w; }
    }
}

struct DenseSched {
    pg8::StaticOrder so; const char* A; const char* B; size_t astep, bstep;
    DI void init(int Mr, int N, int G, int c, const void* A_, int lda, const void* B_, int ldb) { so.init(Mr, N, G, c); A = (const char*)A_; B = (const char*)B_; astep = (size_t)256 * lda * 2; bstep = (size_t)256 * ldb * 2; }
    DI bool next(int i, Unit& u) const { int pm, pn; if (!so.next(i, pm, pn)) return false; u.pm = pm; u.pn = pn; u.aux = 0; u.half = 0; u.rowtab = nullptr; u.A = A + (size_t)pm * astep; u.B = B + (size_t)pn * bstep; return true; }
};

struct EpiInProj {
    static constexpr bool PERM = true;
    bf16_t *Q, *Kb, *V, *Assm, *sga, *sgs; float* kmean; const float *qg, *kg;
    DI void operator()(const AccT& acc, const Unit& u, int wr, int wc, int fr, int fq) const {
        const int pn = u.pn, pm = u.pm;
        const int row0 = pm * 256 + wr * 64 + fr;
        if (pn < 4) {
            const bool isk = pn >= 2; const int hg = (pn & 1) * 4 + wc;
            const float* gp = (isk ? kg : qg) + 8 * fq; const float scl = isk ? 1.0f : QC2;
            f32x4 gv[2][2];
#pragma unroll
            for (int bj = 0; bj < 2; ++bj)
#pragma unroll
                for (int n = 0; n < 2; ++n) gv[bj][n] = *(const f32x4*)(gp + 32 * bj + 4 * n) * scl;
            f32x4 ks[2][2];
#pragma unroll
            for (int bj = 0; bj < 2; ++bj)
#pragma unroll
                for (int n = 0; n < 2; ++n) ks[bj][n] = (f32x4){0.f, 0.f, 0.f, 0.f};
            bf16_t* dst = (isk ? Kb : Q) + hg * 64 + 8 * fq;
#pragma unroll
            for (int ai = 0; ai < 2; ++ai)
#pragma unroll
                for (int m = 0; m < 4; ++m) {
                    float ss = 0.f;
#pragma unroll
                    for (int bj = 0; bj < 2; ++bj)
#pragma unroll
                        for (int n = 0; n < 2; ++n) { const f32x4 a = acc[ai][bj][m][n]; ss += (a.x * a.x + a.y * a.y) + (a.z * a.z + a.w * a.w); }
                    ss += __shfl_xor(ss, 16); ss += __shfl_xor(ss, 32);
                    const float rstd = 1.0f / sqrtf(ss * (1.0f / 64.0f) + EPSF);
                    const size_t row = (size_t)(row0 + ai * 128 + m * 16);
#pragma unroll
                    for (int bj = 0; bj < 2; ++bj) {
                        const f32x4 v0 = acc[ai][bj][m][0] * rstd * gv[bj][0], v1 = acc[ai][bj][m][1] * rstd * gv[bj][1];
                        if (isk) { ks[bj][0] += v0; ks[bj][1] += v1; }
                        u32x4 w; w.x = pk2(v0.x, v0.y); w.y = pk2(v0.z, v0.w); w.z = pk2(v1.x, v1.y); w.w = pk2(v1.z, v1.w);
                        *(u32x4*)(dst + row * 512 + 32 * bj) = w; }
                }
            if (isk) {
                const int b = pm >> 4, blk = pm & 15;
                float* kmp = kmean + ((size_t)((b * 8 + hg) * 16 + blk)) * 64 + 8 * fq;
#pragma unroll
                for (int bj = 0; bj < 2; ++bj)
#pragma unroll
                    for (int n = 0; n < 2; ++n)
#pragma unroll
                        for (int j = 0; j < 4; ++j) { float s = ks[bj][n][j]; s += __shfl_xor(s, 1); s += __shfl_xor(s, 2); s += __shfl_xor(s, 4); s += __shfl_xor(s, 8);
                            if (fr == 0) kmp[wr * 32768 + 32 * bj + 4 * n + j] = s * (1.0f / 256.0f); }
            }
        } else if (pn < 6) {
            bf16_t* dst = V + (pn - 4) * 256 + wc * 32 + 8 * fq;
#pragma unroll
            for (int ai = 0; ai < 2; ++ai)
#pragma unroll
                for (int m = 0; m < 4; ++m) { const size_t row = (size_t)(row0 + ai * 128 + m * 16);
#pragma unroll
                    for (int bj = 0; bj < 2; ++bj) { const f32x4 v0 = acc[ai][bj][m][0], v1 = acc[ai][bj][m][1];
                        u32x4 w; w.x = pk2(v0.x, v0.y); w.y = pk2(v0.z, v0.w); w.z = pk2(v1.x, v1.y); w.w = pk2(v1.z, v1.w);
                        *(u32x4*)(dst + row * 512 + 128 * bj) = w; } }
        } else if (pn < 8) {
            const int b = pm >> 4;
#pragma unroll
            for (int ai = 0; ai < 2; ++ai)
#pragma unroll
                for (int m = 0; m < 4; ++m) { const int t = (pm & 15) * 256 + ai * 128 + wr * 64 + m * 16 + fr;
#pragma unroll
                    for (int bj = 0; bj < 2; ++bj) { const int c = (pn - 6) * 256 + 128 * bj + 32 * wc + 8 * fq, g = c >> 4, c2 = c & 15;
                        const f32x4 v0 = acc[ai][bj][m][0], v1 = acc[ai][bj][m][1];
                        u32x4 w; w.x = pk2(v0.x, v0.y); w.y = pk2(v0.z, v0.w); w.z = pk2(v1.x, v1.y); w.w = pk2(v1.z, v1.w);
                        *(u32x4*)(Assm + ((size_t)g * 1024 + b * 256 + (t >> 4)) * 384 + (t & 15) * 16 + c2) = w; } }
        } else {
            bf16_t* dst = (pn < 12 ? sga + (pn - 8) * 256 : sgs + (pn - 12) * 256) + wc * 32 + 8 * fq;
#pragma unroll
            for (int ai = 0; ai < 2; ++ai)
#pragma unroll
                for (int m = 0; m < 4; ++m) { const size_t row = (size_t)(row0 + ai * 128 + m * 16);
#pragma unroll
                    for (int bj = 0; bj < 2; ++bj) { const f32x4 v0 = acc[ai][bj][m][0], v1 = acc[ai][bj][m][1];
                        u32x4 w; w.x = pk2(sigmoidf_(v0.x), sigmoidf_(v0.y)); w.y = pk2(sigmoidf_(v0.z), sigmoidf_(v0.w)); w.z = pk2(sigmoidf_(v1.x), sigmoidf_(v1.y)); w.w = pk2(sigmoidf_(v1.z), sigmoidf_(v1.w));
                        *(u32x4*)(dst + row * 1024 + 128 * bj) = w; } }
        }
    }
};

struct EpiS1 {
    static constexpr bool PERM = false;
    float* Hloc;
    DI void operator()(const AccT& acc, const Unit& u, int wr, int wc, int fr, int fq) const {
        float* base = Hloc + (size_t)u.pm * 256 * 128 + wc * 32 + 4 * fq;
#pragma unroll
        for (int ai = 0; ai < 2; ++ai)
#pragma unroll
            for (int m = 0; m < 4; ++m) { const int r = ai * 128 + wr * 64 + m * 16 + fr;
#pragma unroll
                for (int n = 0; n < 2; ++n) *(f32x4*)(base + (size_t)r * 128 + 16 * n) = acc[ai][0][m][n]; }
    }
};
struct SsmSched {
    int G, c; const char* A; const char* B; size_t bstep;
    DI bool next(int i, Unit& u) const { const int L = i * G + c; if (L >= 128) return false; u.pm = L; u.pn = 0; u.aux = 0; u.half = 0; u.rowtab = nullptr;
        u.A = A + (size_t)L * 256 * 384 * 2; u.B = B + (size_t)(L >> 2) * bstep; return true; }
};
struct EpiS2 {
    static constexpr bool PERM = true;
    const bf16_t* Assm; const float* dskip; bf16_t* gbuf;
    DI void operator()(const AccT& acc, const Unit& u, int wr, int wc, int fr, int fq) const {
        const int g = u.pm >> 2, b = u.pm & 3;
#pragma unroll
        for (int ai = 0; ai < 2; ++ai)
#pragma unroll
            for (int m = 0; m < 4; ++m) { const int r = ai * 128 + wr * 64 + m * 16 + fr;
#pragma unroll
                for (int bj = 0; bj < 2; ++bj) { const int c = 128 * bj + 32 * wc + 8 * fq, s = c >> 4, c2 = c & 15;
                    const int t = 16 * r + s;
                    size_t uo = ((size_t)u.pm * 256 + r) * 384 + c, oo = ((size_t)b * SEQ + t) * 512 + g * 16 + c2;
                    asm volatile("" : "+v"(uo), "+v"(oo));
                    const u32x2* up = (const u32x2*)(Assm + uo);
                    u32x2* op = (u32x2*)(gbuf + oo);
#pragma unroll
                    for (int n = 0; n < 2; ++n) {
                        const u32x2 uu = up[n]; const f32x4 d0 = *(const f32x4*)(dskip + g * 16 + c2 + 4 * n); const f32x4 a0 = acc[ai][bj][m][n];
                        const float y0 = a0.x + d0.x * bflo(uu.x), y1 = a0.y + d0.y * bfhi(uu.x), y2 = a0.z + d0.z * bflo(uu.y), y3 = a0.w + d0.w * bfhi(uu.y);
                        u32x2 w; w.x = pk2(gelu_tanh(y0), gelu_tanh(y1)); w.y = pk2(gelu_tanh(y2), gelu_tanh(y3));
                        op[n] = w; asm volatile("" ::: "memory"); } } }
    }
};
struct EpiGluUp {
    static constexpr bool PERM = true;
    const bf16_t* gbuf; const float* bglu; bf16_t* sout; const bf16_t* sga; bf16_t* P1;
    DI void operator()(const AccT& acc, const Unit& u, int wr, int wc, int fr, int fq) const {
        const int row0 = u.pm * 256 + wr * 64 + fr, col0 = u.pn * 256 + wc * 32 + 8 * fq;
#pragma unroll
        for (int ai = 0; ai < 2; ++ai)
#pragma unroll
            for (int m = 0; m < 4; ++m) { const size_t row = (size_t)(row0 + ai * 128 + m * 16);
#pragma unroll
                for (int bj = 0; bj < 2; ++bj) { const int col = col0 + 128 * bj; const f32x4 a0 = acc[ai][bj][m][0], a1 = acc[ai][bj][m][1]; u32x4 w;
                    if (u.aux == 0) { const u32x4 gg = *(const u32x4*)(gbuf + row * 512 + col); const f32x4 b0 = *(const f32x4*)(bglu + col), b1 = *(const f32x4*)(bglu + col + 4);
                        w.x = pk2(bflo(gg.x) * sigmoidf_(a0.x + b0.x), bfhi(gg.x) * sigmoidf_(a0.y + b0.y)); w.y = pk2(bflo(gg.y) * sigmoidf_(a0.z + b0.z), bfhi(gg.y) * sigmoidf_(a0.w + b0.w));
                        w.z = pk2(bflo(gg.z) * sigmoidf_(a1.x + b1.x), bfhi(gg.z) * sigmoidf_(a1.y + b1.y)); w.w = pk2(bflo(gg.w) * sigmoidf_(a1.z + b1.z), bfhi(gg.w) * sigmoidf_(a1.w + b1.w));
                        *(u32x4*)(sout + row * 512 + col) = w;
                    } else { const u32x4 gg = *(const u32x4*)(sga + row * 1024 + col);
                        w.x = pk2(bflo(gg.x) * a0.x, bfhi(gg.x) * a0.y); w.y = pk2(bflo(gg.y) * a0.z, bfhi(gg.y) * a0.w); w.z = pk2(bflo(gg.z) * a1.x, bfhi(gg.z) * a1.y); w.w = pk2(bflo(gg.w) * a1.z, bfhi(gg.w) * a1.w);
                        *(u32x4*)(P1 + row * 1024 + col) = w; } } }
    }
};
struct GluUpSched {
    int G, c; const char *Ag, *Bg, *Au, *Bu;
    DI bool next(int i, Unit& u) const { const int L = i * G + c; if (L >= 384) return false; u.rowtab = nullptr; u.half = 0;
        if (L < 128) { u.aux = 0; u.pm = L >> 1; u.pn = L & 1; u.A = Ag + (size_t)u.pm * 256 * 512 * 2; u.B = Bg + (size_t)u.pn * 256 * 512 * 2; }
        else { const int l2 = L - 128; u.aux = 1; u.pm = l2 >> 2; u.pn = l2 & 3; u.A = Au + (size_t)u.pm * 256 * 512 * 2; u.B = Bu + (size_t)u.pn * 256 * 512 * 2; }
        return true; }
};
struct EpiUp2 {
    static constexpr bool PERM = true;
    const bf16_t* P1; const bf16_t* sgs; bf16_t* mix;
    DI void operator()(const AccT& acc, const Unit& u, int wr, int wc, int fr, int fq) const {
        const int row0 = u.pm * 256 + wr * 64 + fr, col0 = u.pn * 256 + wc * 32 + 8 * fq;
#pragma unroll
        for (int ai = 0; ai < 2; ++ai)
#pragma unroll
            for (int m = 0; m < 4; ++m) { const size_t row = (size_t)(row0 + ai * 128 + m * 16);
#pragma unroll
                for (int bj = 0; bj < 2; ++bj) { const size_t o = row * 1024 + col0 + 128 * bj; const f32x4 a0 = acc[ai][bj][m][0], a1 = acc[ai][bj][m][1];
                    const u32x4 gg = *(const u32x4*)(sgs + o), pp = *(const u32x4*)(P1 + o); u32x4 w;
                    w.x = pk2(bflo(pp.x) + bflo(gg.x) * a0.x, bfhi(pp.x) + bfhi(gg.x) * a0.y); w.y = pk2(bflo(pp.y) + bflo(gg.y) * a0.z, bfhi(pp.y) + bfhi(gg.y) * a0.w);
                    w.z = pk2(bflo(pp.z) + bflo(gg.z) * a1.x, bfhi(pp.z) + bfhi(gg.z) * a1.y); w.w = pk2(bflo(pp.w) + bflo(gg.w) * a1.z, bfhi(pp.w) + bfhi(gg.w) * a1.w);
                    *(u32x4*)(mix + o) = w; } }
    }
};
struct EpiOut {
    static constexpr bool PERM = true;
    const float* x; const float* mod; float* out;
    DI void operator()(const AccT& acc, const Unit& u, int wr, int wc, int fr, int fq) const {
        const int row0 = u.pm * 256 + wr * 64 + fr, col0 = u.pn * 256 + wc * 32 + 8 * fq, b = u.pm >> 4;
#pragma unroll
        for (int bj = 0; bj < 2; ++bj) { const int col = col0 + 128 * bj;
            const f32x4 g0 = *(const f32x4*)(mod + b * 6144 + 2048 + col), g1 = *(const f32x4*)(mod + b * 6144 + 2048 + col + 4);
#pragma unroll
            for (int ai = 0; ai < 2; ++ai)
#pragma unroll
                for (int m = 0; m < 4; ++m) { const size_t o = (size_t)(row0 + ai * 128 + m * 16) * 1024 + col;
                    const f32x4 x0 = *(const f32x4*)(x + o), x1 = *(const f32x4*)(x + o + 4);
                    *(f32x4*)(out + o) = x0 + g0 * acc[ai][bj][m][0]; *(f32x4*)(out + o + 4) = x1 + g1 * acc[ai][bj][m][1]; } }
    }
};
struct EpiRsh {
    static constexpr bool PERM = true;
    float* scores; bf16_t* hs;
    DI void operator()(const AccT& acc, const Unit& u, int wr, int wc, int fr, int fq) const {
        const int row0 = u.pm * 256 + wr * 64 + fr;
        if (u.pn == 0) {
#pragma unroll
            for (int ai = 0; ai < 2; ++ai)
#pragma unroll
                for (int m = 0; m < 4; ++m) { const size_t row = (size_t)(row0 + ai * 128 + m * 16);
#pragma unroll
                    for (int bj = 0; bj < 2; ++bj) { float* d = scores + row * 256 + 128 * bj + 32 * wc + 8 * fq; const f32x4 a0 = acc[ai][bj][m][0], a1 = acc[ai][bj][m][1];
                        *(f32x4*)d = (f32x4){sigmoidf_(a0.x), sigmoidf_(a0.y), sigmoidf_(a0.z), sigmoidf_(a0.w)}; *(f32x4*)(d + 4) = (f32x4){sigmoidf_(a1.x), sigmoidf_(a1.y), sigmoidf_(a1.z), sigmoidf_(a1.w)}; } }
        } else {
#pragma unroll
            for (int ai = 0; ai < 2; ++ai)
#pragma unroll
                for (int m = 0; m < 4; ++m) { const size_t row = (size_t)(row0 + ai * 128 + m * 16);
                    const f32x4 g0 = acc[ai][0][m][0], g1 = acc[ai][0][m][1], u0 = acc[ai][1][m][0], u1 = acc[ai][1][m][1]; u32x4 w;
                    w.x = pk2(siluf_(g0.x) * u0.x, siluf_(g0.y) * u0.y); w.y = pk2(siluf_(g0.z) * u0.z, siluf_(g0.w) * u0.w); w.z = pk2(siluf_(g1.x) * u1.x, siluf_(g1.y) * u1.y); w.w = pk2(siluf_(g1.z) * u1.z, siluf_(g1.w) * u1.w);
                    *(u32x4*)(hs + row * 256 + 128 * (u.pn - 1) + 32 * wc + 8 * fq) = w; }
        }
    }
};
struct EpiBf16 {
    static constexpr bool PERM = true;
    bf16_t* O; int ldc;
    DI void operator()(const AccT& acc, const Unit& u, int wr, int wc, int fr, int fq) const {
        const int row0 = u.pm * 256 + wr * 64 + fr, col0 = u.pn * 256 + wc * 32 + 8 * fq;
#pragma unroll
        for (int ai = 0; ai < 2; ++ai)
#pragma unroll
            for (int m = 0; m < 4; ++m) { const size_t row = (size_t)(row0 + ai * 128 + m * 16);
#pragma unroll
                for (int bj = 0; bj < 2; ++bj) { const f32x4 v0 = acc[ai][bj][m][0], v1 = acc[ai][bj][m][1];
                    u32x4 w; w.x = pk2(v0.x, v0.y); w.y = pk2(v0.z, v0.w); w.z = pk2(v1.x, v1.y); w.w = pk2(v1.z, v1.w);
                    *(u32x4*)(O + row * ldc + col0 + 128 * bj) = w; } asm volatile("" ::: "memory"); }
    }
};
struct EpiMoe1 {
    static constexpr bool PERM = true;
    bf16_t* Hs;
    DI void operator()(const AccT& acc, const Unit& u, int wr, int wc, int fr, int fq) const {
        const int row0 = u.pm * 256 + wr * 64 + fr;
#pragma unroll
        for (int ai = 0; ai < 2; ++ai)
#pragma unroll
            for (int m = 0; m < 4; ++m) { const size_t row = (size_t)(row0 + ai * 128 + m * 16);
                const f32x4 g0 = acc[ai][0][m][0], g1 = acc[ai][0][m][1], u0 = acc[ai][1][m][0], u1 = acc[ai][1][m][1]; u32x4 w;
                w.x = pk2(siluf_(g0.x) * u0.x, siluf_(g0.y) * u0.y); w.y = pk2(siluf_(g0.z) * u0.z, siluf_(g0.w) * u0.w); w.z = pk2(siluf_(g1.x) * u1.x, siluf_(g1.y) * u1.y); w.w = pk2(siluf_(g1.z) * u1.z, siluf_(g1.w) * u1.w);
                *(u32x4*)(Hs + row * 256 + 128 * u.pn + 32 * wc + 8 * fq) = w; }
    }
};
struct EpiMoe2 {
    static constexpr bool PERM = true;
    const int* dest; const float* roww; bf16_t* Y;
    DI void operator()(const AccT& acc, const Unit& u, int wr, int wc, int fr, int fq) const {
        const int row0 = u.pm * 256 + wr * 64 + fr, col0 = u.pn * 256 + wc * 32 + 8 * fq;
#pragma unroll
        for (int ai = 0; ai < 2; ++ai)
#pragma unroll
            for (int m = 0; m < 4; ++m) { const int row = row0 + ai * 128 + m * 16; const int d = dest[row]; const float wt = roww[row];
                if (d >= 0) {
#pragma unroll
                    for (int bj = 0; bj < 2; ++bj) { const f32x4 v0 = acc[ai][bj][m][0] * wt, v1 = acc[ai][bj][m][1] * wt;
                        u32x4 w; w.x = pk2(v0.x, v0.y); w.y = pk2(v0.z, v0.w); w.z = pk2(v1.x, v1.y); w.w = pk2(v1.z, v1.w);
                        *(u32x4*)(Y + (size_t)d * 1024 + col0 + 128 * bj) = w; } } asm volatile("" ::: "memory"); }
    }
};
struct MoeSched {
    int G, c, npn, ntiles; const LAS unsigned short* tile_e; const char* A; const char* B; size_t astep, bestep, bnstep; const int* rowtab;
    DI bool next(int i, Unit& u) const { const int L = i * G + c; if (L >= ntiles * npn) return false; const int tile = L / npn, pn = L % npn; const int e = tile_e[tile];
        u.pm = tile; u.pn = pn; u.aux = e; u.half = (tile_e[MAXTILES + tile] <= 128) ? 1 : 0; u.rowtab = rowtab + tile * 256; u.A = A + (size_t)tile * astep; u.B = B + (size_t)e * bestep + (size_t)pn * bnstep; return true; }
};

namespace att {
constexpr int DMA_ = 512;
constexpr int NW = 8, QBLK = 32, QB = 256, KVBLK = 64;
DI int crow(int r, int hi) { return (r & 3) + 8 * (r >> 2) + 4 * hi; }
#define SBAR() __builtin_amdgcn_sched_barrier(0)
DI void cmask(f32x16& p0, f32x16& p1, int jb, int qrel, int hi) {
    const float NEG = -INFINITY; int kb = 64 * jb + 4 * hi;
#pragma unroll
    for (int r = 0; r < 16; ++r) { int kv = kb + (r & 3) + 8 * (r >> 2); if (kv > qrel) p0[r] = NEG; if (kv + 32 > qrel) p1[r] = NEG; }
}
constexpr int NSLOT = 3, SLOTB = 8192;
constexpr int LDS_K = 0, LDS_V = NSLOT * SLOTB, LDS_WS = 2 * NSLOT * SLOTB, LDS_OST = LDS_WS + NW * 64 * 4, LDS_KM = LDS_OST + NW * 4096, LDS_BT = LDS_KM + 4096, LDS_END = LDS_BT + 576 * 4;
static_assert(LDS_END <= RING_BYTES, "attention LDS");
DI void glds16(const void* sbase, unsigned voff, unsigned lds_dst) { unsigned keep;
    asm volatile("s_nop 4\n\ts_mov_b32 %0, m0\n\ts_mov_b32 m0, %2\n\ts_nop 0\n\tglobal_load_lds_dwordx4 %1, %3\n\ts_mov_b32 m0, %0" : "=&s"(keep) : "v"(voff), "s"(lds_dst), "s"(sbase) : "memory"); }
DI float max3f(float a, float b, float c) { float r; asm("v_max3_f32 %0, %1, %2, %3" : "=v"(r) : "v"(a), "v"(b), "v"(c)); return r; }
DI float max2f(float a, float b) { float r; asm("v_max_f32_e32 %0, %1, %2" : "=v"(r) : "v"(a), "v"(b)); return r; }
DI float fadd_s(float a, float b) { float r; asm("v_add_f32_e32 %0, %1, %2" : "=v"(r) : "v"(a), "v"(b)); return r; }
DI float fsub_s(float a, float b) { float r; asm("v_sub_f32_e32 %0, %1, %2" : "=v"(r) : "v"(a), "v"(b)); return r; }
DI unsigned cvtpk_s(float lo, float hi) { return pk2(lo, hi); }
#define WAIT_BAR(N) asm volatile("s_waitcnt vmcnt(" #N ") lgkmcnt(0)\n\ts_barrier" ::: "memory")
DI void qkt(f32x16& p0, f32x16& p1, const char* Kslot, const bf16x8* qr, const f32x16& negm, int r32, int hi) {
    const char* kb = Kslot + hi * 1024 + r32 * 16;
#pragma unroll
    for (int d0 = 0; d0 < 4; ++d0) {
        const bf16x8 b0 = *reinterpret_cast<const bf16x8*>(kb + d0 * 2048);
        const bf16x8 b1 = *reinterpret_cast<const bf16x8*>(kb + d0 * 2048 + 512);
        if (d0 == 0) { p0 = __builtin_amdgcn_mfma_f32_32x32x16_bf16(b0, qr[0], negm, 0, 0, 0); p1 = __builtin_amdgcn_mfma_f32_32x32x16_bf16(b1, qr[0], negm, 0, 0, 0); }
        else { p0 = __builtin_amdgcn_mfma_f32_32x32x16_bf16(b0, qr[d0], p0, 0, 0, 0); p1 = __builtin_amdgcn_mfma_f32_32x32x16_bf16(b1, qr[d0], p1, 0, 0, 0); } }
}
typedef LAS const char* lds_cptr;
typedef short v4i16_t __attribute__((ext_vector_type(4)));
DI void kload8(bf16x8* kf, lds_cptr kp) {
    kf[0] = *(const LAS bf16x8*)(kp);        kf[1] = *(const LAS bf16x8*)(kp + 512);
    kf[2] = *(const LAS bf16x8*)(kp + 2048); kf[3] = *(const LAS bf16x8*)(kp + 2560);
    kf[4] = *(const LAS bf16x8*)(kp + 4096); kf[5] = *(const LAS bf16x8*)(kp + 4608);
    kf[6] = *(const LAS bf16x8*)(kp + 6144); kf[7] = *(const LAS bf16x8*)(kp + 6656);
}
DI void kload2(bf16x8* kf, lds_cptr kp, int j) { kf[2 * j] = *(const LAS bf16x8*)(kp + j * 2048); kf[2 * j + 1] = *(const LAS bf16x8*)(kp + j * 2048 + 512); }
DI s16x4 vtr(lds_cptr p) { return __builtin_bit_cast(s16x4, __builtin_amdgcn_ds_read_tr16_b64_v4i16((LAS v4i16_t*)p)); }
DI float rowmax(const f32x16& p0, const f32x16& p1) {
    float a = max3f(p0[0], p0[1], p1[0]), b = max3f(p0[2], p0[3], p1[1]); a = max3f(a, p1[2], p1[3]);
#pragma unroll
    for (int r = 4; r < 16; r += 4) { a = max3f(a, p0[r], p0[r + 1]); b = max3f(b, p0[r + 2], p0[r + 3]); a = max3f(a, p1[r], p1[r + 1]); b = max3f(b, p1[r + 2], p1[r + 3]); }
    const float m = max2f(a, b);
    auto rr = __builtin_amdgcn_permlane32_swap(__float_as_uint(m), __float_as_uint(m), false, false);
    return max2f(__uint_as_float(rr[0]), __uint_as_float(rr[1]));
}
DI void pv(f32x16* o, int vb, bf16x8 pa0, bf16x8 pa1, bf16x8 pa2, bf16x8 pa3) {
#pragma unroll
    for (int d0 = 0; d0 < 2; ++d0) { s16x4 lo[4], hi[4];
#pragma unroll
        for (int ks = 0; ks < 4; ++ks) {
            asm volatile("ds_read_b64_tr_b16 %0,%1 offset:%c2" : "=&v"(lo[ks]) : "v"(vb), "i"(d0 * 4096 + ks * 1024) : "memory");
            asm volatile("ds_read_b64_tr_b16 %0,%1 offset:%c2" : "=&v"(hi[ks]) : "v"(vb), "i"(d0 * 4096 + ks * 1024 + 512) : "memory"); }
        asm volatile("s_waitcnt lgkmcnt(0)" ::: "memory"); SBAR();
#define PK(k) (bf16x8){lo[k][0], lo[k][1], lo[k][2], lo[k][3], hi[k][0], hi[k][1], hi[k][2], hi[k][3]}
        o[d0] = __builtin_amdgcn_mfma_f32_32x32x16_bf16(pa0, PK(0), o[d0], 0, 0, 0);
        o[d0] = __builtin_amdgcn_mfma_f32_32x32x16_bf16(pa1, PK(1), o[d0], 0, 0, 0);
        o[d0] = __builtin_amdgcn_mfma_f32_32x32x16_bf16(pa2, PK(2), o[d0], 0, 0, 0);
        o[d0] = __builtin_amdgcn_mfma_f32_32x32x16_bf16(pa3, PK(3), o[d0], 0, 0, 0);
#undef PK
    }
}
DI int t5_bucket(int n) { if (n < 16) return n; int v = 16 + (int)(logf((float)n * (1.0f / 16.0f)) * (16.0f / 2.0794415416798357f)); return v > 31 ? 31 : v; }

template <int THRL> DI void attn_unit(int wid, int b, int h, int qb, const bf16_t* Q, const bf16_t* __restrict__ K, const bf16_t* __restrict__ V, bf16_t* O, char* shm, const float* kmean, const float* relb) {
    int lane = lane_id(); asm volatile("" : "+v"(lane));
    const int tid = wid * 64 + lane, r32 = lane & 31, hi = lane >> 5;
    const long rowbase = (long)b * SEQ; const int q0 = qb * QB;
    const bf16_t* Qw = Q + (rowbase + q0 + wid * QBLK) * DMA_ + h * 64;
    const bf16_t* Kh = K + rowbase * DMA_ + h * 64, *Vh = V + rowbase * DMA_ + h * 64;
    const unsigned lds0 = (unsigned)(uintptr_t)shm;
    LAS float* wsf = (LAS float*)((LAS char*)shm + LDS_WS) + wid * 64;
    LAS float* kms = (LAS float*)((LAS char*)shm + LDS_KM); LAS float* bt = (LAS float*)((LAS char*)shm + LDS_BT);
    if (tid < 256) *(LAS f32x4*)(kms + 4 * tid) = *(const f32x4*)(kmean + (size_t)(b * 8 + h) * 1024 + 4 * tid) + *(const f32x4*)(kmean + 32768 + (size_t)(b * 8 + h) * 1024 + 4 * tid);
    for (int i = tid; i < 576; i += 512) { const int n = i - 256; float v = 0.f; if (n >= 0 && n < 128) v = (relb[t5_bucket(n) * 8 + h] - relb[31 * 8 + h]) * LOG2E; bt[i] = exp2f(v); }
    asm volatile("s_waitcnt vmcnt(0) lgkmcnt(0)\n\ts_barrier" ::: "memory");
    unsigned selmask = 0;
    {
        float gsc[8];
#pragma unroll
        for (int j = 0; j < 8; ++j) gsc[j] = 0.f;
#pragma unroll
        for (int c8 = 0; c8 < 8; ++c8) { const u32x4 qq = *(const u32x4*)(Qw + (long)r32 * DMA_ + c8 * 8);
            float qv[8] = {bflo(qq.x), bfhi(qq.x), bflo(qq.y), bfhi(qq.y), bflo(qq.z), bfhi(qq.z), bflo(qq.w), bfhi(qq.w)};
#pragma unroll
            for (int j = 0; j < 8; ++j) { const LAS float* kp = kms + (8 * hi + j) * 64 + c8 * 8; const f32x4 k0 = *(const LAS f32x4*)kp, k1 = *(const LAS f32x4*)(kp + 4);
                gsc[j] += qv[0] * k0.x + qv[1] * k0.y + qv[2] * k0.z + qv[3] * k0.w + qv[4] * k1.x + qv[5] * k1.y + qv[6] * k1.z + qv[7] * k1.w; } }
        float ga[16];
#pragma unroll
        for (int j = 0; j < 8; ++j) { const float o = __shfl_xor(gsc[j], 32); ga[j] = hi ? o : gsc[j]; ga[8 + j] = hi ? gsc[j] : o; }
#pragma unroll
        for (int j = 0; j < 16; ++j) if (j >= qb) ga[j] = -INFINITY;
#pragma unroll
        for (int k = 0; k < 3; ++k) { float bv = -INFINITY; int bi = -1;
#pragma unroll
            for (int j = 0; j < 16; ++j) if (ga[j] > bv) { bv = ga[j]; bi = j; }
            if (bi >= 0) { selmask |= 1u << bi;
#pragma unroll
                for (int j = 0; j < 16; ++j) if (j == bi) ga[j] = -INFINITY; } }
        selmask |= 0xffff0000u | (1u << qb);
    }
    const unsigned kvo = (unsigned)(lane * DMA_ * 2);
    const unsigned vvo = (unsigned)(((lane >> 2) * DMA_ + (lane & 3) * 8) * 2);
    const bf16_t* kub = Kh + wid * 8; const bf16_t* vub = Vh + (long)(16 * (wid & 3)) * DMA_ + (wid >> 2) * 32;
    const unsigned kdst = lds0 + LDS_K + wid * 1024, vdst = lds0 + LDS_V + wid * 1024;
#define DMA_K(t, slot) glds16(kub + (long)(t) * KVBLK * DMA_, kvo, (unsigned)__builtin_amdgcn_readfirstlane(kdst + (slot)))
#define DMA_V(t, slot) glds16(vub + (long)(t) * KVBLK * DMA_, vvo, (unsigned)__builtin_amdgcn_readfirstlane(vdst + (slot)))
    const int vb0 = (int)(lds0 + LDS_V) + ((lane >> 4) & 1) * 32 + (lane & 3) * 8 + (4 * hi + ((lane & 15) >> 2)) * 64;
    const char* Kbase = shm + LDS_K; bf16x8 kf[8];
    const lds_cptr shm3 = (lds_cptr)shm; const lds_cptr kp0 = shm3 + LDS_K + hi * 1024 + r32 * 16; const lds_cptr vp0 = shm3 + LDS_V + ((lane >> 4) & 1) * 32 + (lane & 3) * 8 + (4 * hi + ((lane & 15) >> 2)) * 64;
    const int NT = (q0 + QB) / KVBLK;
    DMA_K(0, 0); DMA_V(0, 0); DMA_K(1, SLOTB);
    bf16x8 qr[4];
#pragma unroll
    for (int d0 = 0; d0 < 4; ++d0) qr[d0] = *reinterpret_cast<const bf16x8*>(&Qw[(long)r32 * DMA_ + d0 * 16 + hi * 8]);
    float mhat = 0.f, l_reg = 0.f; f32x16 o[2]; o[0] = f32x16{}; o[1] = f32x16{}; f32x16 negm;
#pragma unroll
    for (int r = 0; r < 16; ++r) negm[r] = (selmask & 1u) ? 0.f : -1e30f;
    asm volatile("" : "+v"(negm));
    const int qrel = wid * QBLK + r32;
#define MASKS(P0, P1, t) do { int jb_ = (t) - (NT - 4); if (jb_ >= 0) cmask(P0, P1, jb_, qrel, hi); } while (0)
#define BIASM(P0, P1, t) do { if ((t) >= NT - 9 && q0 + wid * QBLK - (64 * (t) + 63) < 128) { const LAS float* bp_ = bt + (q0 + qrel - 64 * (t) + 256 - 63 - 4 * hi); \
        _Pragma("unroll") for (int r4 = 0; r4 < 16; r4 += 4) { _Pragma("unroll") for (int r = r4; r < r4 + 4; ++r) { P0[r] *= bp_[63 - crow(r, 0)]; P1[r] *= bp_[31 - crow(r, 0)]; } SBAR(); } } } while (0)
#define MOFF(t) (((selmask >> ((t) >> 2)) & 1u) ? 0.f : -1e30f)
#define UPD(t) do { if (((t) & 3) == 0) { const float nv_ = MOFF(t) - mhat; \
        _Pragma("unroll") for (int r = 0; r < 16; ++r) negm[r] = nv_; asm volatile("" : "+v"(negm)); } } while (0)
    bool resc = false;
#define START(P0, P1) do { const float rm = rowmax(P0, P1); resc = false; \
    { const float dl = __builtin_fmaxf(rm, 0.f); mhat = fadd_s(mhat, dl); \
      _Pragma("unroll") for (int r = 0; r < 16; ++r) { P0[r] = fsub_s(P0[r], dl); P1[r] = fsub_s(P1[r], dl); } \
      const float nv_ = MOFF(0) - mhat; _Pragma("unroll") for (int r = 0; r < 16; ++r) negm[r] = nv_; asm volatile("" : "+v"(negm)); } \
    _Pragma("unroll") for (int r = 0; r < 16; ++r) P0[r] = __builtin_amdgcn_exp2f(P0[r]); } while (0)
#define RESC() do { if (resc) { asm volatile("s_waitcnt lgkmcnt(0)" ::: "memory"); \
      _Pragma("unroll") for (int d_ = 0; d_ < 2; ++d_) _Pragma("unroll") for (int r = 0; r < 16; ++r) o[d_][r] *= wsf[crow(r, hi)]; } } while (0)
    f32x16 pA0, pA1, pB0, pB1;
    int sl_prev = 0, sl_cur = 0, sl_next = SLOTB;
#define ROT() do { sl_prev = sl_cur; sl_cur = sl_next; sl_next = (sl_next == (NSLOT - 1) * SLOTB) ? 0 : sl_next + SLOTB; } while (0)
    DMA_K(2, 2 * SLOTB);
    WAIT_BAR(3);
    qkt(pA0, pA1, Kbase, qr, negm, r32, hi); asm volatile("s_nop 15\n\ts_nop 7" : "+v"(pA0), "+v"(pA1)); MASKS(pA0, pA1, 0);
    START(pA0, pA1);
    _Pragma("unroll") for (int r = 0; r < 16; ++r) pA1[r] = __builtin_amdgcn_exp2f(pA1[r]);
    WAIT_BAR(0);
    DMA_K(3, 0); DMA_V(1, SLOTB);
    ROT();
    kload8(kf, kp0 + sl_cur);
    WAIT_BAR(2);
    BIASM(pA0, pA1, 0);
    s16x4 vlo[8], vhi[8]; u32x4 pw0, pw1, pw2, pw3;
#define PKW(P, B) cvtpk_s(P[B], P[B + 1])
#define PAF(k) __builtin_bit_cast(bf16x8, pw##k)
#define VFR(i) (bf16x8){vlo[i][0], vlo[i][1], vlo[i][2], vlo[i][3], vhi[i][0], vhi[i][1], vhi[i][2], vhi[i][3]}
#define PIN(x) asm volatile("" : "+v"(x))
#define MX3(a, b, c) __builtin_fmaxf(__builtin_fmaxf((a), (b)), (c))
#define GAPA(MF, A0, A1, A2, A3, W0, W1, PW) do { MF; sacc += A0; sacc += A1; sacc += A2; sacc += A3; PIN(sacc); W0; W1; PIN(PW); SBAR(); } while (0)
#define EX(v) __builtin_amdgcn_exp2f(v)
#define GAPB(MF, X, B) do { MF; X[B] = EX(X[B]); X[B + 1] = EX(X[B + 1]); X[B + 2] = EX(X[B + 2]); X[B + 3] = EX(X[B + 3]); PIN(X); SBAR(); } while (0)
#define VRD(i) do { vlo[i] = vtr(vp_ + (((i) >> 2) * 4096 + ((i) & 3) * 1024)); vhi[i] = vtr(vp_ + (((i) >> 2) * 4096 + ((i) & 3) * 1024 + 512)); } while (0)
#define KRD(G, j) do { if (G) { kload2(kf, kp0 + sl_next, j); SBAR(); } } while (0)
#define STEP(C0, C1, P0, P1, t, GK, GV, GL, MSK) do { SBAR(); \
    const lds_cptr vp_ = vp0 + sl_prev; \
    VRD(0); SBAR(); float sacc = (P0[0] + P0[1]); \
    GAPA(C0 = __builtin_amdgcn_mfma_f32_32x32x16_bf16(kf[0], qr[0], negm, 0, 0, 0), P0[2], P0[3], P0[4], P0[5],     pw0[0] = PKW(P0, 0), pw0[1] = PKW(P0, 2), pw0); \
    VRD(4); SBAR(); GAPA(C1 = __builtin_amdgcn_mfma_f32_32x32x16_bf16(kf[1], qr[0], negm, 0, 0, 0), P0[6], P0[7], P0[8], P0[9],     pw0[2] = PKW(P0, 4), pw0[3] = PKW(P0, 6), pw0); \
    VRD(1); SBAR(); GAPA(C0 = __builtin_amdgcn_mfma_f32_32x32x16_bf16(kf[2], qr[1], C0, 0, 0, 0),   P0[10], P0[11], P0[12], P0[13], pw1[0] = PKW(P0, 8), pw1[1] = PKW(P0, 10), pw1); \
    VRD(5); SBAR(); GAPA(C1 = __builtin_amdgcn_mfma_f32_32x32x16_bf16(kf[3], qr[1], C1, 0, 0, 0),   P0[14], P0[15], P1[0], P1[1],   pw1[2] = PKW(P0, 12), pw1[3] = PKW(P0, 14), pw1); \
    VRD(2); SBAR(); GAPA(C0 = __builtin_amdgcn_mfma_f32_32x32x16_bf16(kf[4], qr[2], C0, 0, 0, 0),   P1[2], P1[3], P1[4], P1[5],     pw2[0] = PKW(P1, 0), pw2[1] = PKW(P1, 2), pw2); \
    VRD(6); SBAR(); GAPA(C1 = __builtin_amdgcn_mfma_f32_32x32x16_bf16(kf[5], qr[2], C1, 0, 0, 0),   P1[6], P1[7], P1[8], P1[9],     pw2[2] = PKW(P1, 4), pw2[3] = PKW(P1, 6), pw2); \
    VRD(3); SBAR(); GAPA(C0 = __builtin_amdgcn_mfma_f32_32x32x16_bf16(kf[6], qr[3], C0, 0, 0, 0),   P1[10], P1[11], P1[12], P1[13], pw3[0] = PKW(P1, 8), pw3[1] = PKW(P1, 10), pw3); \
    asm volatile("s_waitcnt lgkmcnt(13)" ::: "memory"); VRD(7); SBAR(); GAPA(C1 = __builtin_amdgcn_mfma_f32_32x32x16_bf16(kf[7], qr[3], C1, 0, 0, 0),   P1[14], P1[15], 0.f, 0.f,       pw3[2] = PKW(P1, 12), pw3[3] = PKW(P1, 14), pw3); \
    l_reg += sacc; \
    if (GK) { DMA_K((t) + 3, sl_cur); } if (GV) { DMA_V((t) + 1, sl_next); } \
    if (MSK) { MASKS(C0, C1, t); } \
    { float a = MX3(C0[0], C0[1], C1[0]), b = MX3(C0[2], C0[3], C1[1]); a = MX3(a, C1[2], C1[3]); \
      _Pragma("unroll") for (int r = 4; r < 16; r += 4) { a = MX3(a, C0[r], C0[r + 1]); b = MX3(b, C0[r + 2], C0[r + 3]); a = MX3(a, C1[r], C1[r + 1]); b = MX3(b, C1[r + 2], C1[r + 3]); } \
      float rm = __builtin_fmaxf(a, b); { auto rr = __builtin_amdgcn_permlane32_swap(__float_as_uint(rm), __float_as_uint(rm), false, false); rm = __builtin_fmaxf(__uint_as_float(rr[0]), __uint_as_float(rr[1])); } \
      resc = false; \
      if (__builtin_expect(__any(rm > (float)THRL), 0)) { const float dl = __builtin_fmaxf(rm, 0.f); mhat += dl; \
        _Pragma("unroll") for (int r = 0; r < 16; ++r) { C0[r] -= dl; C1[r] -= dl; } \
        const float nv_ = MOFF(t) - mhat; _Pragma("unroll") for (int r = 0; r < 16; ++r) negm[r] = nv_; asm volatile("" : "+v"(negm)); \
        const float f = __builtin_amdgcn_exp2f(-dl); l_reg *= f; { const int l2_ = lane_id(); if (l2_ < 32) wsf[l2_] = f; } resc = true; } } \
    SBAR(); \
    GAPB(o[0] = __builtin_amdgcn_mfma_f32_32x32x16_bf16(PAF(0), VFR(0), o[0], 0, 0, 0), C0, 0); \
    GAPB(o[1] = __builtin_amdgcn_mfma_f32_32x32x16_bf16(PAF(0), VFR(4), o[1], 0, 0, 0), C0, 4); \
    KRD(GL, 0); GAPB(o[0] = __builtin_amdgcn_mfma_f32_32x32x16_bf16(PAF(1), VFR(1), o[0], 0, 0, 0), C0, 8); \
    KRD(GL, 1); GAPB(o[1] = __builtin_amdgcn_mfma_f32_32x32x16_bf16(PAF(1), VFR(5), o[1], 0, 0, 0), C0, 12); \
    KRD(GL, 2); GAPB(o[0] = __builtin_amdgcn_mfma_f32_32x32x16_bf16(PAF(2), VFR(2), o[0], 0, 0, 0), C1, 0); \
    KRD(GL, 3); GAPB(o[1] = __builtin_amdgcn_mfma_f32_32x32x16_bf16(PAF(2), VFR(6), o[1], 0, 0, 0), C1, 4); \
    GAPB(o[0] = __builtin_amdgcn_mfma_f32_32x32x16_bf16(PAF(3), VFR(3), o[0], 0, 0, 0), C1, 8); \
    GAPB(o[1] = __builtin_amdgcn_mfma_f32_32x32x16_bf16(PAF(3), VFR(7), o[1], 0, 0, 0), C1, 12); \
    } while (0)
    int t = 1;
    const int tb = (NT - 9 > 1) ? NT - 9 : 1;
    for (; t < tb; t += 2) {
        STEP(pB0, pB1, pA0, pA1, t, true, true, true, false);         WAIT_BAR(2); RESC(); ROT();
        UPD(t + 1);
        STEP(pA0, pA1, pB0, pB1, t + 1, true, true, true, false);     WAIT_BAR(2); RESC(); ROT();
    }
#define ENDW(tt) do { if ((tt) + 3 < NT) { WAIT_BAR(2); } else if ((tt) + 2 < NT) { WAIT_BAR(1); } else { WAIT_BAR(0); } } while (0)
    for (; t + 1 < NT; t += 2) {
        STEP(pB0, pB1, pA0, pA1, t, (t + 3 < NT), (t + 1 < NT), (t + 1 < NT), true);         ENDW(t);     RESC(); BIASM(pB0, pB1, t); ROT();
        UPD(t + 1);
        STEP(pA0, pA1, pB0, pB1, t + 1, (t + 4 < NT), (t + 2 < NT), (t + 2 < NT), true);     ENDW(t + 1); RESC(); BIASM(pA0, pA1, t + 1); ROT();
    }
    STEP(pB0, pB1, pA0, pA1, NT - 1, false, false, false, true); RESC(); asm volatile("s_waitcnt lgkmcnt(0)" ::: "memory"); BIASM(pB0, pB1, NT - 1);
    { float sacc = pB0[0] + pB0[1]; _Pragma("unroll") for (int r = 2; r < 16; ++r) sacc += pB0[r]; _Pragma("unroll") for (int r = 0; r < 16; ++r) sacc += pB1[r]; l_reg += sacc;
      pw0 = (u32x4){PKW(pB0, 0), PKW(pB0, 2), PKW(pB0, 4), PKW(pB0, 6)}; pw1 = (u32x4){PKW(pB0, 8), PKW(pB0, 10), PKW(pB0, 12), PKW(pB0, 14)}; pw2 = (u32x4){PKW(pB1, 0), PKW(pB1, 2), PKW(pB1, 4), PKW(pB1, 6)}; pw3 = (u32x4){PKW(pB1, 8), PKW(pB1, 10), PKW(pB1, 12), PKW(pB1, 14)};
      SBAR(); pv(o, vb0 + sl_cur, PAF(0), PAF(1), PAF(2), PAF(3)); }
#undef PKW
#undef PAF
#undef VFR
#undef PIN
#undef MX3
#undef GAPA
#undef GAPB
#undef EX
#undef VRD
#undef KRD
#undef STEP
#undef ENDW
    { auto rr = __builtin_amdgcn_permlane32_swap(__float_as_uint(l_reg), __float_as_uint(l_reg), false, false); l_reg = __uint_as_float(rr[0]) + __uint_as_float(rr[1]); }
    if (hi == 0) wsf[32 + r32] = l_reg; asm volatile("s_waitcnt lgkmcnt(0)" ::: "memory");
    float rli[16];
#pragma unroll
    for (int r = 0; r < 16; ++r) rli[r] = __builtin_amdgcn_rcpf(wsf[32 + crow(r, hi)]);
    bf16_t* Ow = O + (rowbase + q0 + wid * QBLK) * DMA_ + h * 64;
    { LAS bf16_t* stg = (LAS bf16_t*)((LAS char*)shm + LDS_OST) + wid * 2048;
#pragma unroll
        for (int r = 0; r < 16; ++r) { const int orow = crow(r, hi);
#pragma unroll
            for (int d0 = 0; d0 < 2; ++d0) stg[orow * 64 + d0 * 32 + r32] = (bf16_t)(pk2(o[d0][r] * rli[r], 0.f) & 0xffffu); }
        asm volatile("s_waitcnt lgkmcnt(0)" ::: "memory");
#pragma unroll
        for (int i = 0; i < 4; ++i) { const int row = i * 8 + (lane >> 3), ch = lane & 7; const u32x4 v = *(const LAS u32x4*)(stg + row * 64 + ch * 8); *(u32x4*)(Ow + (long)row * DMA_ + ch * 8) = v; } }
    asm volatile("s_waitcnt lgkmcnt(0)\n\ts_barrier" ::: "memory");
#undef DMA_K
#undef DMA_V
#undef MASKS
#undef BIASM
#undef UPD
#undef MOFF
#undef START
#undef RESC
#undef ROT
}
#undef SBAR
#undef WAIT_BAR
}

DI void ssm_scan(Frame& F) {
    const float* Hloc = (const float*)(F.ws + WS_HLOC); bf16_t* Assm = (bf16_t*)(F.ws + WS_ASSM); const float* a16 = (const float*)(F.ws + WS_SMALL + 128 * 1024);
    const int gw = F.vcu * 8 + F.wave, NGW = F.G * 8, p = FLANE;
    for (int task = gw; task < 128; task += NGW) {
        const int g = task >> 2, b = task & 3;
        const float ar = a16[(g * 64 + p) * 2], ai = a16[(g * 64 + p) * 2 + 1];
        float sr = 0.f, si = 0.f;
        const float* hl = Hloc + ((size_t)g * 1024 + b * 256) * 128; bf16_t* ao = Assm + ((size_t)g * 1024 + b * 256) * 384 + 256;
        for (int c0 = 0; c0 < 256; c0 += 8) {
            float lr[8], li[8];
#pragma unroll
            for (int j = 0; j < 8; ++j) { lr[j] = hl[(size_t)(c0 + j) * 128 + p]; li[j] = hl[(size_t)(c0 + j) * 128 + 64 + p]; }
#pragma unroll
            for (int j = 0; j < 8; ++j) {
                ao[(size_t)(c0 + j) * 384 + p] = (bf16_t)(pk2(sr, 0.f) & 0xffffu); ao[(size_t)(c0 + j) * 384 + 64 + p] = (bf16_t)(pk2(si, 0.f) & 0xffffu);
                const float nr = ar * sr - ai * si + lr[j], ni = ar * si + ai * sr + li[j]; sr = nr; si = ni; }
        }
    }
}

DI void topk_tokens(Frame& F) {
    const float* scores = (const float*)(F.ws + WS_SCORES); const float* rbias = in_ptr<IN_RBIAS>();
    int* top_idx = (int*)(F.ws + WS_ROUTE); float* top_w = (float*)(F.ws + WS_ROUTE + 512 * 1024); int* rank = (int*)(F.ws + WS_ROUTE + 1024 * 1024);
    unsigned* cnt = (unsigned*)(F.ws + WS_CTL) + CW_CNT;
    LAS unsigned* lcnt = (LAS unsigned*)F.lds;
    LAS int* le = (LAS int*)(F.lds + 1024);
    LAS unsigned* lr = (LAS unsigned*)(F.lds + 3072);
    LAS float* lw = (LAS float*)(F.lds + 5120);
    const int l = FLANE, tid = FTID;
    const f32x4 rb = *(const f32x4*)(rbias + 4 * l);
    for (int blk = F.vcu; blk < M / 64; blk += F.G) {
        __syncthreads();
        if (tid < 256) lcnt[tid] = 0u;
        __syncthreads();
#pragma unroll 1
        for (int tt = 0; tt < 8; ++tt) {
            const int tl = F.wave * 8 + tt, t = blk * 64 + tl;
            const f32x4 sc = *(const f32x4*)(scores + (size_t)t * 256 + 4 * l);
            float v[4] = {sc.x + rb.x, sc.y + rb.y, sc.z + rb.z, sc.w + rb.w};
            float m1 = fmaxf(v[0], v[1]), m2 = fminf(v[0], v[1]);
            { const float a = fmaxf(v[2], v[3]), c = fminf(v[2], v[3]); const float n1 = fmaxf(m1, a), n2 = fmaxf(fminf(m1, a), fmaxf(m2, c)); m1 = n1; m2 = n2; }
#pragma unroll
            for (int o = 1; o < 8; o <<= 1) { const float o1 = __shfl_xor(m1, o), o2 = __shfl_xor(m2, o); const float n1 = fmaxf(m1, o1), n2 = fmaxf(fminf(m1, o1), fmaxf(m2, o2)); m1 = n1; m2 = n2; }
            const float gs = m1 + m2; const int myg = l >> 3; int higher = 0;
#pragma unroll
            for (int j = 0; j < 8; ++j) { const float og = __shfl(gs, 8 * j); higher += (og > gs || (og == gs && j < myg)) ? 1 : 0; }
            if (higher >= 4) { v[0] = -1e30f; v[1] = -1e30f; v[2] = -1e30f; v[3] = -1e30f; }
            int my_e = 0; float my_s = 0.f, tot = 0.f;
#pragma unroll
            for (int k = 0; k < 8; ++k) {
                float bv = v[0]; int bi = 4 * l;
                if (v[1] > bv) { bv = v[1]; bi = 4 * l + 1; } if (v[2] > bv) { bv = v[2]; bi = 4 * l + 2; } if (v[3] > bv) { bv = v[3]; bi = 4 * l + 3; }
#pragma unroll
                for (int o = 1; o < 64; o <<= 1) { const float ov = __shfl_xor(bv, o); const int oi = __shfl_xor(bi, o); if (ov > bv || (ov == bv && oi < bi)) { bv = ov; bi = oi; } }
                const float mys = (bi == 4 * l) ? sc.x : (bi == 4 * l + 1) ? sc.y : (bi == 4 * l + 2) ? sc.z : sc.w;
                const float ssel = __shfl(mys, bi >> 2);
                if (bi == 4 * l) v[0] = -3e38f; if (bi == 4 * l + 1) v[1] = -3e38f; if (bi == 4 * l + 2) v[2] = -3e38f; if (bi == 4 * l + 3) v[3] = -3e38f;
                tot += ssel; if (l == k) { my_e = bi; my_s = ssel; }
            }
            if (l < 8) { le[tl * 8 + l] = my_e; lw[tl * 8 + l] = my_s / tot * 2.5f; lr[tl * 8 + l] = __hip_atomic_fetch_add(lcnt + my_e, 1u, __ATOMIC_RELAXED, __HIP_MEMORY_SCOPE_WORKGROUP); }
        }
        __syncthreads();
        if (tid < 256) { const unsigned c = lcnt[tid]; unsigned base = 0u; if (c) base = atomicAdd(cnt + tid, c); lcnt[tid] = base; }
        __syncthreads();
        { const int e = le[tid]; const size_t gi = (size_t)blk * 512 + tid; top_idx[gi] = e; top_w[gi] = lw[tid]; rank[gi] = (int)(lr[tid] + lcnt[e]); }
    }
    __syncthreads();
}
DI int build_tiles(Frame& F) {
    const unsigned* cnt = (const unsigned*)(F.ws + WS_CTL) + CW_CNT;
    LAS unsigned* sa = (LAS unsigned*)(F.lds + SCAN_OFF); LAS unsigned* sb = sa + 256; LAS unsigned short* tile_e = (LAS unsigned short*)(F.lds + TILEE_OFF);
    LAS unsigned* misc = (LAS unsigned*)(F.lds + MISC_OFF);
    const int tid = FTID; unsigned nt = 0, cn = 0;
    __syncthreads();
    if (tid < 256) { cn = __hip_atomic_load(cnt + tid, __ATOMIC_RELAXED, __HIP_MEMORY_SCOPE_AGENT); nt = (cn + 255u) >> 8; sa[tid] = nt; }
    __syncthreads();
    LAS unsigned* src = sa; LAS unsigned* dst = sb;
    for (int o = 1; o < 256; o <<= 1) { if (tid < 256) { unsigned v = src[tid]; if (tid >= o) v += src[tid - o]; dst[tid] = v; } __syncthreads(); LAS unsigned* tmp = src; src = dst; dst = tmp; }
    if (tid < 256) { const unsigned incl = src[tid], first = incl - nt; for (unsigned k = 0; k < nt; ++k) if (first + k < MAXTILES) { tile_e[first + k] = (unsigned short)tid; const unsigned rem = cn - 256u * k; tile_e[MAXTILES + first + k] = (unsigned short)(rem > 256u ? 256u : rem); } dst[tid] = first; if (tid == 255) misc[16] = incl; }
    __syncthreads();
    if (tid < 256) sa[tid] = dst[tid];
    __syncthreads();
    int ntl = (int)misc[16]; if (ntl > MAXTILES) ntl = MAXTILES; return ntl;
}
DI void route_scatter(Frame& F) {
    const int* top_idx = (const int*)(F.ws + WS_ROUTE); const float* top_w = (const float*)(F.ws + WS_ROUTE + 512 * 1024); const int* rank = (const int*)(F.ws + WS_ROUTE + 1024 * 1024);
    int* rowoff = (int*)(F.ws + WS_ROUTE + 2 * MiB); float* roww = (float*)(F.ws + WS_ROUTE + 3 * MiB); int* dest = (int*)(F.ws + WS_ROUTE + 4 * MiB);
    (void)build_tiles(F);
    LAS unsigned* first = (LAS unsigned*)(F.lds + SCAN_OFF);
    const int gt = F.vcu * 512 + FTID, NT = F.G * 512;
    for (int i = gt; i < M * 8; i += NT) { const int e = top_idx[i]; const int pos = (int)first[e] * 256 + rank[i];
        if (pos < MAXROWS) { rowoff[pos] = (i >> 3) * (DM * 2); roww[pos] = top_w[i]; dest[pos] = i; } }
}
DI void route_clear(Frame& F) {
    int* rowoff = (int*)(F.ws + WS_ROUTE + 2 * MiB); float* roww = (float*)(F.ws + WS_ROUTE + 3 * MiB); int* dest = (int*)(F.ws + WS_ROUTE + 4 * MiB);
    const int gt = F.vcu * 512 + FTID, NT = F.G * 512;
    for (int i = gt; i < MAXROWS; i += NT) { rowoff[i] = 0; roww[i] = 0.f; dest[i] = -1; }
}
DI void combine(Frame& F) {
    const float* mod = (const float*)(F.ws + WS_SMALL); const bf16_t* ysh = (const bf16_t*)(F.ws + WS_YSH); const bf16_t* Y = (const bf16_t*)(F.ws + WS_Y);
    const int gw = F.vcu * 8 + F.wave, NGW = F.G * 8;
    for (int t = gw; t < M; t += NGW) { const int b = t / SEQ;
#pragma unroll
        for (int hf = 0; hf < 2; ++hf) { const int col = hf * 512 + FLANE * 8;
            const u32x4 s = *(const u32x4*)(ysh + (size_t)t * 1024 + col);
            float a[8] = {bflo(s.x), bfhi(s.x), bflo(s.y), bfhi(s.y), bflo(s.z), bfhi(s.z), bflo(s.w), bfhi(s.w)};
            u32x4 yv[8];
#pragma unroll
            for (int k = 0; k < 8; ++k) yv[k] = *(const u32x4*)(Y + ((size_t)t * 8 + k) * 1024 + col);
#pragma unroll
            for (int k = 0; k < 8; ++k) { a[0] += bflo(yv[k].x); a[1] += bfhi(yv[k].x); a[2] += bflo(yv[k].y); a[3] += bfhi(yv[k].y); a[4] += bflo(yv[k].z); a[5] += bfhi(yv[k].z); a[6] += bflo(yv[k].w); a[7] += bfhi(yv[k].w); }
            float* o = F.out + (size_t)t * 1024 + col; const float* g2 = mod + b * 6144 + 5120 + col;
            const f32x4 x0 = *(const f32x4*)o, x1 = *(const f32x4*)(o + 4), g0 = *(const f32x4*)g2, g1 = *(const f32x4*)(g2 + 4);
            *(f32x4*)o = x0 + g0 * (f32x4){a[0], a[1], a[2], a[3]}; *(f32x4*)(o + 4) = x1 + g1 * (f32x4){a[4], a[5], a[6], a[7]}; }
    }
}

constexpr int NPHASE = 17;
__global__ void __launch_bounds__(512, 2) mk_fwd(Args args) {
    extern __shared__ __attribute__((aligned(16))) unsigned char lds_raw[];
    Frame F;
    F.lds = (LAS unsigned char*)lds_raw; F.wave = __builtin_amdgcn_readfirstlane((int)threadIdx.x >> 6);
    F.G = gridDim.x; { const int bx = blockIdx.x; F.vcu = (F.G % 8 == 0) ? (bx % 8) * (F.G / 8) + bx / 8 : bx; }
    F.in.dummy = 0; F.out = args.out; F.ws = args.ws;
    unsigned char* ws = args.ws;
    volatile LAS unsigned* MISC = (volatile LAS unsigned*)(F.lds + MISC_OFF);
    LAS unsigned* gtab = (LAS unsigned*)(F.lds + GTAB_OFF);
    for (int u = FTID; u < 64; u += 512) MISC[u] = 0u;
    __syncthreads();
    unsigned* ctl = (unsigned*)(ws + WS_CTL);
    XcdBarrier bar; bar.bar = ctl + CW_BAR; bar.x = 0; bar.st = nullptr; bar.wave = F.wave;
    if (!MK_PER_PHASE) bar = xcd_barrier_post(ctl + CW_BAR, MISC + 8, F.wave);
    const int lo = args.ph_lo, hi = args.ph_hi;
#ifndef ONLY_PHASE
#define ONLY_PHASE -1
#endif
#define IN(k) ((ONLY_PHASE < 0 || ONLY_PHASE == (k)) && lo <= (k) && (k) < hi)
#ifndef PROBE_PHASE
#define PROBE_PHASE -1
#endif
#ifndef PROBE_AMP
#define PROBE_AMP 4
#endif
    unsigned long long pr_t0 = 0, pr_dt = 0;
#define SEAM(k) do { if (IN(k) && IN((k) + 1)) xcd_barrier(bar); \
    if (PROBE_PHASE >= 0) { if ((k) + 1 == PROBE_PHASE) pr_t0 = __builtin_amdgcn_s_memrealtime(); if ((k) == PROBE_PHASE) pr_dt = __builtin_amdgcn_s_memrealtime() - pr_t0; } } while (0)
    const int G = F.G, bx = (int)blockIdx.x;
    float* mod = (float*)(ws + WS_SMALL);

    if (PROBE_PHASE == 0) pr_t0 = __builtin_amdgcn_s_memrealtime();
    if (IN(0)) {
        if (bx < 96) p0_adaln(F, bx); else if (bx < 128) p0_ssm(F, bx - 96);
        conv_items(F, 0, I_SMALL);
    }
    SEAM(0);
    if (IN(1)) norm_mod_rows(F, in_ptr<IN_X>(), in_ptr<IN_LN1G>(), 0, 1024, (bf16_t*)(ws + WS_H));
    SEAM(1);
    if (IN(2)) {
        pg8::Gemm g{DM, DM, DM}; DenseSched S; S.init(M, INW, G, bx, ws + WS_H, DM, ws + WS_WIN, DM);
        EpiInProj E{(bf16_t*)(ws + WS_Q), (bf16_t*)(ws + WS_K), (bf16_t*)(ws + WS_V), (bf16_t*)(ws + WS_ASSM), (bf16_t*)(ws + WS_SGA), (bf16_t*)(ws + WS_SGS), (float*)(ctl + CW_KMEAN), in_ptr<IN_QG>(), in_ptr<IN_KG>()};
        pg8::gemm_phase<EpiInProj, DenseSched, true, false>(F.lds, gtab, F.wave, g, S, E);
    }
    SEAM(2);
    if (IN(3)) {
#pragma unroll 1
        for (int ui = F.vcu * 2; ui < 512; ui += 2 * G) {
#pragma unroll 1
            for (int k2 = 0; k2 < 2; ++k2) { const int pi = ui >> 1, bh = pi >> 3, s = pi & 7, qb = k2 ? s : 15 - s;
                att::attn_unit<8>(F.wave, bh >> 3, bh & 7, qb, (const bf16_t*)(ws + WS_Q), (const bf16_t*)(ws + WS_K), (const bf16_t*)(ws + WS_V), (bf16_t*)(ws + WS_Q), (char*)lds_raw, (const float*)(ctl + CW_KMEAN), in_ptr<IN_RELB>()); } }
        __syncthreads();
        pg8::Gemm g{384, 256, 256}; SsmSched S{G, F.vcu, (const char*)(ws + WS_ASSM), (const char*)(ws + WS_ET), (size_t)256 * 256 * 2};
        EpiS1 E{(float*)(ws + WS_HLOC)};
        pg8::gemm_phase<EpiS1, SsmSched, true, false>(F.lds, gtab, F.wave, g, S, E);
    }
    SEAM(3);
    if (IN(4)) ssm_scan(F);
    SEAM(4);
    if (IN(5)) {
        pg8::Gemm g{384, 384, 384}; SsmSched S{G, F.vcu, (const char*)(ws + WS_ASSM), (const char*)(ws + WS_TF), (size_t)256 * 384 * 2};
        EpiS2 E{(const bf16_t*)(ws + WS_ASSM), in_ptr<IN_SSMD>(), (bf16_t*)(ws + WS_GBUF)};
        pg8::gemm_phase<EpiS2, SsmSched, true, false>(F.lds, gtab, F.wave, g, S, E);
    }
    SEAM(5);
    if (IN(6)) {
        pg8::Gemm g{512, 512, 512}; GluUpSched S{G, F.vcu, (const char*)(ws + WS_GBUF), (const char*)(ws + WS_WGLU), (const char*)(ws + WS_Q), (const char*)(ws + WS_WUPA)};
        EpiGluUp E{(const bf16_t*)(ws + WS_GBUF), in_ptr<IN_BGLU>(), (bf16_t*)(ws + WS_SOUT), (const bf16_t*)(ws + WS_SGA), (bf16_t*)(ws + WS_P1)};
        pg8::gemm_phase<EpiGluUp, GluUpSched, true, false>(F.lds, gtab, F.wave, g, S, E);
    }
    SEAM(6);
    if (IN(7)) {
        pg8::Gemm g{512, 512, 512}; DenseSched S; S.init(M, DM, G, bx, ws + WS_SOUT, 512, ws + WS_WUPS, 512);
        EpiUp2 E{(const bf16_t*)(ws + WS_P1), (const bf16_t*)(ws + WS_SGS), (bf16_t*)(ws + WS_MIX)};
        pg8::gemm_phase<EpiUp2, DenseSched, true, false>(F.lds, gtab, F.wave, g, S, E);
    }
    SEAM(7);
    if (IN(8)) {
        pg8::Gemm g{DM, DM, DM}; DenseSched S; S.init(M, DM, G, bx, ws + WS_MIX, DM, ws + WS_WOUT, DM);
        EpiOut E{in_ptr<IN_X>(), mod, F.out};
        pg8::gemm_phase<EpiOut, DenseSched, true, false>(F.lds, gtab, F.wave, g, S, E);
    }
    SEAM(8);
    if (IN(9)) norm_mod_rows(F, F.out, in_ptr<IN_LN2G>(), 3072, 4096, (bf16_t*)(ws + WS_H));
    SEAM(9);
    if (IN(10)) {
        pg8::Gemm g{DM, DM, DM}; DenseSched S; S.init(M, 768, G, bx, ws + WS_H, DM, ws + WS_WRSH, DM);
        EpiRsh E{(float*)(ws + WS_SCORES), (bf16_t*)(ws + WS_HS)};
        pg8::gemm_phase<EpiRsh, DenseSched, true, false>(F.lds, gtab, F.wave, g, S, E);
    }
    SEAM(10);
    if (IN(11)) {
        route_clear(F);
        topk_tokens(F);
        __syncthreads();
        pg8::Gemm g{ED, ED, ED}; DenseSched S; S.init(M, DM, G, bx, ws + WS_HS, ED, ws + WS_WSHD, ED);
        EpiBf16 E{(bf16_t*)(ws + WS_YSH), 1024};
        pg8::gemm_phase<EpiBf16, DenseSched, true, false>(F.lds, gtab, F.wave, g, S, E);
    }
    SEAM(11);
    if (IN(12)) { route_scatter(F); conv_items(F, I_SMALL, I_SMALL + I_EG + I_EU); }
    SEAM(12);
    if (IN(13)) {
        const int ntl = build_tiles(F);
        pg8::Gemm g{DM, DM, DM};
        MoeSched S{G, F.vcu, 2, ntl, (const LAS unsigned short*)(F.lds + TILEE_OFF), (const char*)(ws + WS_H), (const char*)(ws + WS_WEGU), 0, (size_t)512 * DM * 2, (size_t)256 * DM * 2, (const int*)(ws + WS_ROUTE + 2 * MiB)};
        EpiMoe1 E{(bf16_t*)(ws + WS_HSORT)};
        pg8::gemm_phase<EpiMoe1, MoeSched, true, true>(F.lds, gtab, F.wave, g, S, E);
        conv_items(F, I_SMALL + I_EG + I_EU, NITEMS);
    }
    SEAM(13);
    if (IN(14)) {
        const int ntl = build_tiles(F);
        pg8::Gemm g{ED, ED, ED};
        MoeSched S{G, F.vcu, 4, ntl, (const LAS unsigned short*)(F.lds + TILEE_OFF), (const char*)(ws + WS_HSORT), (const char*)(ws + WS_WED), (size_t)256 * ED * 2, (size_t)DM * ED * 2, (size_t)256 * ED * 2, nullptr};
        EpiMoe2 E{(const int*)(ws + WS_ROUTE + 4 * MiB), (const float*)(ws + WS_ROUTE + 3 * MiB), (bf16_t*)(ws + WS_Y)};
        pg8::gemm_phase<EpiMoe2, MoeSched, true, false>(F.lds, gtab, F.wave, g, S, E);
    }
    SEAM(14);
    if (IN(15)) combine(F);
    if (PROBE_PHASE >= 0) { if (PROBE_PHASE == 15) { asm volatile("s_waitcnt vmcnt(0)" ::: "memory"); pr_dt = __builtin_amdgcn_s_memrealtime() - pr_t0; }
        if (blockIdx.x == 0) { const unsigned long long te = __builtin_amdgcn_s_memrealtime(); while (__builtin_amdgcn_s_memrealtime() - te < (unsigned long long)PROBE_AMP * pr_dt) __builtin_amdgcn_s_sleep(8); } }
#undef IN
#undef SEAM
}

extern "C" void kernel_launch(void* const* d_in, const int* in_sizes, int n_in, void* d_out, int out_size, void* d_ws, size_t ws_size, hipStream_t stream) {
    static int grid = 0;
    if (grid == 0) {
        if (n_in != 31 || out_size != M * DM || ws_size < WS_END) { fprintf(stderr, "kernel_launch: unexpected shapes (n_in %d out %d ws %zu)\n", n_in, out_size, ws_size); grid = -1; return; }
        int dev = 0, cus = 0;
        if (hipGetDevice(&dev) != hipSuccess || hipDeviceGetAttribute(&cus, hipDeviceAttributeMultiprocessorCount, dev) != hipSuccess) { grid = -1; return; }
        if (hipFuncSetAttribute((const void*)mk_fwd, hipFuncAttributeMaxDynamicSharedMemorySize, LDS_BYTES) != hipSuccess) { fprintf(stderr, "kernel_launch: hipFuncSetAttribute failed\n"); grid = -1; return; }
        int per_cu = 0;
        if (hipOccupancyMaxActiveBlocksPerMultiprocessor(&per_cu, (const void*)mk_fwd, 512, LDS_BYTES) != hipSuccess || per_cu < 1) fprintf(stderr, "kernel_launch: occupancy query says %d\n", per_cu);
        (void)hipGetLastError();
        grid = cus;
    }
    if (grid < 0) return;
    (void)hipMemsetAsync((char*)d_ws + WS_CTL, 0, CTL_ZERO_BYTES, stream);
    Args a{};
    for (int i = 0; i < 31; ++i) a.in[i] = (const float*)d_in[i];
    a.out = (float*)d_out; a.ws = (unsigned char*)d_ws;
#if MK_PER_PHASE
    for (int p = 0; p < NPHASE; ++p) { a.ph_lo = p; a.ph_hi = p + 1; hipLaunchKernelGGL(mk_fwd, dim3(grid), dim3(512), LDS_BYTES, stream, a); }
#else
    a.ph_lo = 0; a.ph_hi = NPHASE;
    hipLaunchKernelGGL(mk_fwd, dim3(grid), dim3(512), LDS_BYTES, stream, a);
#endif
}
```

```cpp
#include <hip/hip_runtime.h>
#include <cstdio>
#include <cstdint>

#ifndef MK_PER_PHASE
#define MK_PER_PHASE 0
#endif

#define LAS __attribute__((address_space(3)))
#define GAS __attribute__((address_space(1)))
typedef unsigned short bf16_t;
typedef short bf16x8 __attribute__((ext_vector_type(8)));
typedef short s16x4 __attribute__((ext_vector_type(4)));
typedef float f32x2 __attribute__((ext_vector_type(2)));
typedef float f32x4 __attribute__((ext_vector_type(4)));
typedef float f32x16 __attribute__((ext_vector_type(16)));
typedef unsigned u32x2 __attribute__((ext_vector_type(2)));
typedef unsigned u32x4 __attribute__((ext_vector_type(4)));
typedef __bf16 bf16x2_t __attribute__((ext_vector_type(2)));

#define DI __device__ __forceinline__
DI unsigned pk2(float lo, float hi) { f32x2 v = {lo, hi}; bf16x2_t b = __builtin_convertvector(v, bf16x2_t); return __builtin_bit_cast(unsigned, b); }
DI float bflo(unsigned w) { return __uint_as_float(w << 16); }
DI float bfhi(unsigned w) { return __uint_as_float(w & 0xffff0000u); }
DI float sigmoidf_(float x) { return 1.0f / (1.0f + __expf(-x)); }
DI float siluf_(float x) { return x / (1.0f + __expf(-x)); }
DI float gelu_tanh(float y) { const float z = 0.7978845608028654f * (y + 0.044715f * y * y * y); const float t = 1.0f - 2.0f / (__expf(2.0f * z) + 1.0f); return 0.5f * y * (1.0f + t); }

constexpr int NB = 4, SEQ = 4096, DM = 1024, M = NB * SEQ;
constexpr int NH = 8, HD = 64, AW = 512, SW = 512, INW = 4096;
constexpr int NE = 256, ED = 256, TOPK = 8;
constexpr int NG = 32, GC = 16, NS = 64, CH = 16, NCH = SEQ / CH;
constexpr int MAXTILES = 768, MAXROWS = MAXTILES * 256;
constexpr float EPSF = 1e-6f;
constexpr float LOG2E = 1.4426950408889634f;
constexpr float QC2 = 0.125f * LOG2E;

constexpr size_t MiB = 1u << 20;
constexpr size_t WS_CTL = 0, CTL_ZERO_BYTES = 1 * MiB;
constexpr size_t WS_SMALL = 1 * MiB;
constexpr size_t WS_WIN = 4 * MiB, WS_WGLU = 12 * MiB, WS_WUPA = 13 * MiB, WS_WUPS = 14 * MiB, WS_WOUT = 15 * MiB, WS_WRSH = 17 * MiB, WS_WSHD = 19 * MiB;
constexpr size_t WS_TF = 20 * MiB, WS_ET = 26 * MiB;
constexpr size_t WS_WEGU = 32 * MiB, WS_WED = 288 * MiB;
constexpr size_t WS_H = 416 * MiB;
constexpr size_t WS_Q = 448 * MiB, WS_K = 464 * MiB, WS_V = 480 * MiB;
constexpr size_t WS_ASSM = 496 * MiB, WS_HLOC = 520 * MiB;
constexpr size_t WS_GBUF = 536 * MiB, WS_SOUT = 552 * MiB;
constexpr size_t WS_SGA = 568 * MiB, WS_SGS = 600 * MiB;
constexpr size_t WS_P1 = 632 * MiB, WS_MIX = 664 * MiB;
constexpr size_t WS_SCORES = 696 * MiB, WS_HS = 712 * MiB, WS_YSH = 720 * MiB;
constexpr size_t WS_ROUTE = 752 * MiB;
constexpr size_t WS_HSORT = 760 * MiB;
constexpr size_t WS_Y = 416 * MiB;
constexpr size_t WS_END = 856 * MiB;
constexpr int CW_BAR = 4096;
constexpr int CW_CNT = 16384;
constexpr int CW_KMEAN = 32768;

constexpr int RING_BYTES = 131072;
constexpr int GTAB_OFF = RING_BYTES;
constexpr int TILEE_OFF = GTAB_OFF + 2048;
constexpr int SCAN_OFF = TILEE_OFF + 3072;
constexpr int MISC_OFF = SCAN_OFF + 2048;
constexpr int LDS_BYTES = 147456;
static_assert(MISC_OFF + 256 <= LDS_BYTES, "LDS map");

namespace pg8 {
constexpr int BM = 256, BK = 64, HALF = 128, HTB = HALF * BK * 2, STAGE_BYTES = 8 * HTB, NXCD = 8, WGM = 8;
__host__ __device__ __forceinline__ int lds_byte(int r, int c) { const int st = (r >> 4) * 2 + (c >> 5), rr = r & 15, cc = c & 31, ob = rr * 64 + cc * 2; return st * 1024 + (ob ^ (((ob >> 9) & 1) << 5)); }
__host__ __device__ __forceinline__ void stage_rc(int b, int& R, int& C) { const int st = b / 1024, sb = b % 1024, swz = sb ^ (((sb >> 9) & 1) << 5); R = (st >> 1) * 16 + swz / 64; C = (st & 1) * 32 + (swz % 64) / 2; }
__host__ __device__ __forceinline__ int perm32(int rho) { const int n = rho >> 4, i = rho & 15; return 8 * (i >> 2) + 4 * n + (i & 3); }

struct Unit { const char* A; const char* B; const int* rowtab; int pm, pn, aux, half; };
struct Gemm { int lda, ldb, K; };

struct StaticOrder {
    int nM, nN, nwg, G, c;
    __device__ void init(int M_, int N_, int G_, int c_) { nM = M_ / BM; nN = N_ / BM; nwg = nM * nN; G = G_; c = c_; }
    __device__ bool next(int i, int& pm, int& pn) const {
        const long L = (long)i * G + c; if (L >= nwg) return false;
        int wgid = (int)L; { const int q = nwg / NXCD, r = nwg % NXCD, xcd = wgid % NXCD, off = wgid / NXCD; wgid = (xcd < r ? xcd * (q + 1) : r * (q + 1) + (xcd - r) * q) + off; }
        const int nig = WGM * nN, gid = wgid / nig, fm = gid * WGM, gsz = (nM - fm) < WGM ? (nM - fm) : WGM;
        pm = fm + ((wgid % nig) % gsz); pn = (wgid % nig) / gsz; return true;
    }
};

template <class Epi, class Sched, bool ALIGN_EPI, bool GATHER>
__device__ __forceinline__ void gemm_phase(LAS unsigned char* lds, LAS unsigned* gtab, const int wid, const Gemm g, const Sched& S, const Epi& E) {
    const int lane = (int)__builtin_amdgcn_mbcnt_hi(~0u, __builtin_amdgcn_mbcnt_lo(~0u, 0u)), tid = wid * 64 + lane, wr = wid >> 2, wc = wid & 3, fr = lane & 15, fq = lane >> 4;
    const int K = g.K, nt = K / BK;
    unsigned voffA[2], voffB[2]; int gR[2];
#pragma unroll
    for (int i = 0; i < 2; ++i) { int R, C; stage_rc(tid * 16 + i * 8192, R, C); const int Rb = Epi::PERM ? ((R & ~31) + perm32(R & 31)) : R;
        voffA[i] = GATHER ? (unsigned)(C * 2) : (unsigned)(R * g.lda + C) * 2u; voffB[i] = (unsigned)(Rb * g.ldb + C) * 2u; gR[i] = R; }
    const size_t kstep = (size_t)(BK * 2);
    const size_t hstepA = (size_t)HALF * g.lda * 2, hstepB = (size_t)HALF * g.ldb * 2;
    const unsigned ldsw = (unsigned)wid * 1024u;
    const int aoff = lds_byte(wr * 64 + fr, fq * 8), boff = lds_byte(wc * 32 + fr, fq * 8);
#define PG8_SA(b, h) (((b) * 2 + (h)) * HTB)
#define PG8_SB(b, h) ((4 + (b) * 2 + (h)) * HTB)
#define PG8_STAGEB(bufoff, gbase) do { _Pragma("unroll") for (int _i = 0; _i < 2; ++_i) \
        __builtin_amdgcn_global_load_lds((const unsigned*)((const char*)(gbase) + voffB[_i]), (LAS unsigned*)(lds + (bufoff) + ldsw + _i * 8192), 16, 0, 0); } while (0)
#define PG8_STAGEA(bufoff, gbase, par, half) do { _Pragma("unroll") for (int _i = 0; _i < 2; ++_i) { \
        const char* _src = GATHER ? ((const char*)(gbase) + gtab[(par) * 256 + (half) * 128 + gR[_i]] + voffA[_i]) : ((const char*)(gbase) + (size_t)(half) * hstepA + voffA[_i]); \
        __builtin_amdgcn_global_load_lds((const unsigned*)_src, (LAS unsigned*)(lds + (bufoff) + ldsw + _i * 8192), 16, 0, 0); } } while (0)
#define PG8_TABLOAD(par, un) do { __builtin_amdgcn_global_load_lds((const unsigned*)((un).rowtab + 64 * (wid & 3) + lane), (LAS unsigned*)(gtab + (par) * 256 + 64 * (wid & 3)), 4, 0, 0); } while (0)
#define PG8_LDA(dst, b, h) do { _Pragma("unroll") for (int m = 0; m < 4; ++m) _Pragma("unroll") for (int k = 0; k < 2; ++k) dst[m][k] = *(const LAS bf16x8*)(lds + PG8_SA(b, h) + aoff + m * 2048 + k * 1024); } while (0)
#define PG8_LDB(dst, b, h) do { _Pragma("unroll") for (int n = 0; n < 2; ++n) _Pragma("unroll") for (int k = 0; k < 2; ++k) dst[n][k] = *(const LAS bf16x8*)(lds + PG8_SB(b, h) + boff + n * 2048 + k * 1024); } while (0)
#define PG8_MMA(ai, bj, At, Bt) do { __builtin_amdgcn_s_setprio(1); _Pragma("unroll") for (int m = 0; m < 4; ++m) _Pragma("unroll") for (int n = 0; n < 2; ++n) _Pragma("unroll") for (int k = 0; k < 2; ++k) \
        acc[ai][bj][m][n] = __builtin_amdgcn_mfma_f32_16x16x32_bf16(Bt[n][k], At[m][k], acc[ai][bj][m][n], 0, 0, 0); __builtin_amdgcn_s_setprio(0); } while (0)
#define PG8_WAIT_V(n) asm volatile("s_waitcnt vmcnt(" #n ")" ::: "memory")
#define PG8_WAIT_L(n) asm volatile("s_waitcnt lgkmcnt(" #n ")" ::: "memory")
#define PG8_BAR __builtin_amdgcn_s_barrier()
#define PG8_SCHED __builtin_amdgcn_sched_barrier(0)
    Unit cur, nxt; int ui = 0;
    if (!S.next(0, cur)) return;
    f32x4 acc[2][2][4][2];
#pragma unroll
    for (int a = 0; a < 2; ++a)
#pragma unroll
        for (int b = 0; b < 2; ++b)
#pragma unroll
            for (int m = 0; m < 4; ++m)
#pragma unroll
                for (int n = 0; n < 2; ++n) acc[a][b][m][n] = (f32x4){0.f, 0.f, 0.f, 0.f};
    bf16x8 At[4][2], B0[2][2], B1[2][2];
    const char* cA = cur.A; const char* cB = cur.B;
    if constexpr (GATHER) { PG8_TABLOAD(0, cur); PG8_WAIT_V(0); PG8_BAR; }
    PG8_STAGEB(PG8_SB(0, 0), cB); PG8_STAGEB(PG8_SB(0, 1), cB + hstepB); PG8_STAGEA(PG8_SA(0, 0), cA, 0, 0); PG8_STAGEA(PG8_SA(0, 1), cA, 0, 1);
    if (wr == 1) PG8_BAR;
    PG8_WAIT_V(2); PG8_BAR;
    PG8_STAGEB(PG8_SB(1, 0), cB + kstep); PG8_STAGEA(PG8_SA(1, 0), cA + kstep, 0, 0); PG8_STAGEB(PG8_SB(1, 1), cB + hstepB + kstep);
    PG8_WAIT_V(6); PG8_BAR;
    for (;;) {
        const bool has_next = S.next(ui + 1, nxt);
        const char* nA = has_next ? nxt.A : cA; const char* nB = has_next ? nxt.B : cB;
        const int pc = ui & 1, pnx = has_next ? (pc ^ 1) : pc;
        if constexpr (GATHER) { if (has_next) PG8_TABLOAD(pc ^ 1, nxt); }
#pragma unroll 1
        for (int t = 0; t < nt; t += 2) {
            const bool last = (t == nt - 2);
            const char* a1 = cA + (size_t)(t + 1) * kstep;
            const char* a2 = last ? nA : cA + (size_t)(t + 2) * kstep; const char* b2 = last ? nB : cB + (size_t)(t + 2) * kstep;
            const char* a3 = a2 + kstep; const char* b3 = b2 + kstep;
            const int p2 = last ? pnx : pc;
            PG8_LDB(B0, 0, 0); PG8_LDB(B1, 0, 1); PG8_SCHED; PG8_LDA(At, 0, 0); PG8_STAGEA(PG8_SA(1, 1), a1, pc, 1);
            PG8_WAIT_V(8); PG8_WAIT_L(0); PG8_BAR; PG8_MMA(0, 0, At, B0); PG8_MMA(0, 1, At, B1); PG8_BAR; PG8_SCHED;
            PG8_LDA(At, 0, 1); PG8_STAGEB(PG8_SB(0, 0), b2); PG8_STAGEB(PG8_SB(0, 1), b2 + hstepB); PG8_STAGEA(PG8_SA(0, 0), a2, p2, 0);
            PG8_WAIT_V(8); PG8_WAIT_L(0); PG8_BAR; if (!cur.half) { PG8_MMA(1, 0, At, B0); PG8_MMA(1, 1, At, B1); } PG8_BAR; PG8_SCHED;
            PG8_LDB(B0, 1, 0); PG8_LDB(B1, 1, 1); PG8_SCHED; PG8_LDA(At, 1, 0); PG8_STAGEA(PG8_SA(0, 1), a2, p2, 1);
            PG8_WAIT_V(8); PG8_WAIT_L(0); PG8_BAR; PG8_MMA(0, 0, At, B0); PG8_MMA(0, 1, At, B1); PG8_BAR; PG8_SCHED;
            PG8_LDA(At, 1, 1); PG8_STAGEB(PG8_SB(1, 0), b3); PG8_STAGEB(PG8_SB(1, 1), b3 + hstepB); PG8_STAGEA(PG8_SA(1, 0), a3, p2, 0);
            PG8_WAIT_V(8); PG8_WAIT_L(0); PG8_BAR; if (!cur.half) { PG8_MMA(1, 0, At, B0); PG8_MMA(1, 1, At, B1); } PG8_BAR; PG8_SCHED;
        }
        if constexpr (ALIGN_EPI) { if (wr == 0) PG8_BAR; }
        { int fr_ = fr, fq_ = fq; asm volatile("" : "+v"(fr_), "+v"(fq_)); E(acc, cur, wr, wc, fr_, fq_); }
        if (!has_next) break;
#pragma unroll
        for (int a = 0; a < 2; ++a)
#pragma unroll
            for (int b = 0; b < 2; ++b)
#pragma unroll
                for (int m = 0; m < 4; ++m)
#pragma unroll
                    for (int n = 0; n < 2; ++n) acc[a][b][m][n] = (f32x4){0.f, 0.f, 0.f, 0.f};
        cur = nxt; cA = nA; cB = nB; ++ui;
        if constexpr (ALIGN_EPI) { if (wr == 1) PG8_BAR; }
    }
    PG8_WAIT_V(0);
    if constexpr (!ALIGN_EPI) { if (wr == 0) PG8_BAR; }
    PG8_BAR;
#undef PG8_SA
#undef PG8_SB
#undef PG8_STAGEA
#undef PG8_STAGEB
#undef PG8_TABLOAD
#undef PG8_LDA
#undef PG8_LDB
#undef PG8_MMA
#undef PG8_WAIT_V
#undef PG8_WAIT_L
#undef PG8_BAR
#undef PG8_SCHED
}
}

typedef f32x4 AccT[2][2][4][2];
using pg8::Unit;

typedef GAS unsigned gu32;
#define XB_TMO      128
#define XB_XCNT(j)  (256  + 64 * (j))
#define XB_XSUB(j)  (1280 + 64 * (j))
#define XB_XGEN(j)  (2304 + 64 * (j))
#define XB_TOP      3328
#define XB_TOPGEN   3392
#define XCD_BAR_WORDS 3456
#define XB_SPIN_CAP (1u << 20)
DI unsigned xb_ld(unsigned* p)              { return __hip_atomic_load(p, __ATOMIC_RELAXED, __HIP_MEMORY_SCOPE_AGENT); }
DI unsigned xb_add(unsigned* p, unsigned v) { return __hip_atomic_fetch_add(p, v, __ATOMIC_RELAXED, __HIP_MEMORY_SCOPE_AGENT); }
DI unsigned xb_xcc_id() { return (unsigned)__builtin_amdgcn_s_getreg((3 << 11) | 20) & 0xFu; }
#define XB_SPIN(cond, bar) do { unsigned _sp = 0; while (cond) { __builtin_amdgcn_s_sleep(1); \
    if ((++_sp & 255u) == 0u) { if (xb_ld(&(bar)[XB_TMO])) break; if (_sp > XB_SPIN_CAP) { atomicAdd(&(bar)[XB_TMO], 1u); break; } } } } while (0)
DI int lane_id() { int l = (int)__builtin_amdgcn_mbcnt_hi(~0u, __builtin_amdgcn_mbcnt_lo(~0u, 0u)); asm volatile("" : "+v"(l)); return l; }
struct XcdBarrier { unsigned* bar; unsigned x; volatile LAS unsigned* st; int wave; };
DI XcdBarrier xcd_barrier_post(unsigned* bar, volatile LAS unsigned* st, int wave) {
    XcdBarrier b; b.bar = bar; b.x = xb_xcc_id(); b.st = st; b.wave = wave;
    if (wave == 0 && lane_id() == 0) (void)xb_add(&bar[XB_XCNT(b.x)], 1u);
    return b;
}
DI void xcd_barrier_complete(unsigned* bar, unsigned x, unsigned& nloc, unsigned& nx) {
    const unsigned G = gridDim.x * gridDim.y * gridDim.z;
    unsigned sum, cnt, mine, sp = 0u;
    for (;;) {
        sum = 0u; cnt = 0u; mine = 0u;
#pragma unroll
        for (unsigned j = 0; j < 16; ++j) { const unsigned c = xb_ld(&bar[XB_XCNT(j)]); sum += c; cnt += (c > 0u) ? 1u : 0u; mine = (j == x) ? c : mine; }
        if (sum == G) break;
        __builtin_amdgcn_s_sleep(1);
        if ((++sp & 255u) == 0u) { if (xb_ld(&bar[XB_TMO])) break; if (sp > XB_SPIN_CAP) { atomicAdd(&bar[XB_TMO], 1u); break; } }
    }
    nloc = mine > 0u ? mine : 1u; nx = cnt > 0u ? cnt : 1u;
}
DI void xcd_barrier(const XcdBarrier& b) {
    asm volatile("s_waitcnt vmcnt(0)" ::: "memory");
    __syncthreads();
    if (b.wave == 0 && lane_id() == 0) {
        unsigned* bar = b.bar;
        __builtin_amdgcn_s_waitcnt(0);
        unsigned nloc = b.st[0], nx = b.st[1];
        if (nloc == 0u) { xcd_barrier_complete(bar, b.x, nloc, nx); b.st[0] = nloc; b.st[1] = nx; }
        const unsigned old = xb_add(&bar[XB_XSUB(b.x)], 1u);
        const unsigned gen = old / nloc;
        if (old + 1u == (gen + 1u) * nloc) {
            __builtin_amdgcn_fence(__ATOMIC_RELEASE, "agent");
            asm volatile("s_waitcnt vmcnt(0)" ::: "memory");
            const unsigned og = xb_add(&bar[XB_TOP], 1u);
            const unsigned tg = og / nx;
            if (og + 1u == (tg + 1u) * nx) xb_add(&bar[XB_TOPGEN], 1u);
            else XB_SPIN(xb_ld(&bar[XB_TOPGEN]) == tg, bar);
            __builtin_amdgcn_fence(__ATOMIC_ACQUIRE, "agent");
            xb_add(&bar[XB_XGEN(b.x)], 1u);
            asm volatile("s_waitcnt vmcnt(0)" ::: "memory");
        } else {
            XB_SPIN(xb_ld(&bar[XB_XGEN(b.x)]) == gen, bar);
            __builtin_amdgcn_fence(__ATOMIC_ACQUIRE, "agent");
            asm volatile("s_waitcnt vmcnt(0)" ::: "memory");
        }
    }
    __syncthreads();
}

struct Args { const float* in[31]; float* out; unsigned char* ws; int ph_lo, ph_hi; };
template <int I> DI const float* in_ptr() { const void* kp = (const void*)__builtin_amdgcn_kernarg_segment_ptr(); unsigned long long r;
    asm volatile("s_load_dwordx2 %0, %1, %2\n\ts_waitcnt lgkmcnt(0)" : "=s"(r) : "s"(kp), "i"(I * 8)); return (const float*)(const GAS float*)r; }
struct InTab { int dummy; };
struct Frame {
    LAS unsigned char* lds; int wave, vcu, G;
    InTab in; float* out; unsigned char* ws;
    DI int lane_() const { return lane_id(); }
    DI int tid_() const { return wave * 64 + lane_id(); }
};
#define FTID (F.tid_())
#define FLANE (F.lane_())
#define IN_X 0
#define IN_C 1
#define IN_RELB 2
#define IN_WADA 3
#define IN_BADA 4
#define IN_LN1G 5
#define IN_WIN 6
#define IN_QG 7
#define IN_KG 8
#define IN_LRE 9
#define IN_LIM 10
#define IN_LDT 11
#define IN_BRE 12
#define IN_BIM 13
#define IN_CRE 14
#define IN_CIM 15
#define IN_SSMD 16
#define IN_WGLU 17
#define IN_BGLU 18
#define IN_WUPA 19
#define IN_WUPS 20
#define IN_WOUT 21
#define IN_LN2G 22
#define IN_WROUTER 23
#define IN_RBIAS 24
#define IN_WEG 25
#define IN_WEU 26
#define IN_WED 27
#define IN_WSG 28
#define IN_WSU 29
#define IN_WSD 30

DI float wave_sum(float v) {
#pragma unroll
    for (int o = 1; o < 64; o <<= 1) v += __shfl_xor(v, o);
    return v;
}

template <class RowMap>
DI void tr_item(const float* W, int N, bf16_t* WT, int ldt, int k0, int n0, int lane, RowMap rm) {
    float v[64];
    const float* src = W + (size_t)k0 * N + n0 + lane;
#pragma unroll
    for (int i = 0; i < 64; ++i) v[i] = src[(size_t)i * N];
    bf16_t* dst = WT + (size_t)rm(n0 + lane) * ldt + k0;
#pragma unroll
    for (int j = 0; j < 8; ++j) { u32x4 o; o.x = pk2(v[8 * j], v[8 * j + 1]); o.y = pk2(v[8 * j + 2], v[8 * j + 3]); o.z = pk2(v[8 * j + 4], v[8 * j + 5]); o.w = pk2(v[8 * j + 6], v[8 * j + 7]);
        *(u32x4*)(dst + 8 * j) = o; }
}
struct RmGen { int kind, base; DI int operator()(int n) const { if (kind == 0) return base + n;
    if (kind == 1) { if (n >= 1024) return n; const int tile = n >> 8, w = n & 255, hh = w >> 6, bj = (w >> 5) & 1, i = w & 31; return tile * 256 + 128 * bj + 32 * hh + i; }
    return base + 256 * (n >> 7) + (n & 127); } };
constexpr int I_WIN = 16 * 64, I_GLU = 8 * 8, I_UPA = 8 * 16, I_UPS = 8 * 16, I_OUT = 16 * 16, I_RT = 16 * 4, I_SG = 16 * 4, I_SU = 16 * 4, I_SD = 4 * 16;
constexpr int I_SMALL = I_WIN + I_GLU + I_UPA + I_UPS + I_OUT + I_RT + I_SG + I_SU + I_SD;
constexpr int I_EG = 256 * 64, I_EU = 256 * 64, I_EDN = 256 * 64;
constexpr int NITEMS = I_SMALL + I_EG + I_EU + I_EDN;
DI void conv_items(Frame& F, int lo, int hi) {
    const int gw = F.vcu * 8 + F.wave, NGW = F.G * 8, lane = FLANE;
    unsigned char* ws = F.ws;
#pragma unroll 1
    for (int it = lo + gw; it < hi; it += NGW) {
        int r = it; const float* W; int N, ldt, k0, n0; bf16_t* WT; RmGen rm{0, 0};
        if (r < I_WIN) { W = in_ptr<IN_WIN>(); N = INW; WT = (bf16_t*)(ws + WS_WIN); ldt = DM; k0 = 64 * (r / 64); n0 = 64 * (r % 64); rm.kind = 1; }
        else if ((r -= I_WIN) < I_GLU) { W = in_ptr<IN_WGLU>(); N = SW; WT = (bf16_t*)(ws + WS_WGLU); ldt = SW; k0 = 64 * (r / 8); n0 = 64 * (r % 8); }
        else if ((r -= I_GLU) < I_UPA) { W = in_ptr<IN_WUPA>(); N = DM; WT = (bf16_t*)(ws + WS_WUPA); ldt = AW; k0 = 64 * (r / 16); n0 = 64 * (r % 16); }
        else if ((r -= I_UPA) < I_UPS) { W = in_ptr<IN_WUPS>(); N = DM; WT = (bf16_t*)(ws + WS_WUPS); ldt = SW; k0 = 64 * (r / 16); n0 = 64 * (r % 16); }
        else if ((r -= I_UPS) < I_OUT) { W = in_ptr<IN_WOUT>(); N = DM; WT = (bf16_t*)(ws + WS_WOUT); ldt = DM; k0 = 64 * (r / 16); n0 = 64 * (r % 16); }
        else if ((r -= I_OUT) < I_RT) { W = in_ptr<IN_WROUTER>(); N = NE; WT = (bf16_t*)(ws + WS_WRSH); ldt = DM; k0 = 64 * (r / 4); n0 = 64 * (r % 4); }
        else if ((r -= I_RT) < I_SG) { W = in_ptr<IN_WSG>(); N = ED; WT = (bf16_t*)(ws + WS_WRSH); ldt = DM; k0 = 64 * (r / 4); n0 = 64 * (r % 4); rm.kind = 2; rm.base = 256; }
        else if ((r -= I_SG) < I_SU) { W = in_ptr<IN_WSU>(); N = ED; WT = (bf16_t*)(ws + WS_WRSH); ldt = DM; k0 = 64 * (r / 4); n0 = 64 * (r % 4); rm.kind = 2; rm.base = 256 + 128; }
        else if ((r -= I_SU) < I_SD) { W = in_ptr<IN_WSD>(); N = DM; WT = (bf16_t*)(ws + WS_WSHD); ldt = ED; k0 = 64 * (r / 16); n0 = 64 * (r % 16); }
        else if ((r -= I_SD) < I_EG) { const int e = r / 64, q = r % 64; W = in_ptr<IN_WEG>() + (size_t)e * DM * ED; N = ED; WT = (bf16_t*)(ws + WS_WEGU) + (size_t)e * 512 * DM; ldt = DM; k0 = 64 * (q / 4); n0 = 64 * (q % 4); rm.kind = 2; }
        else if ((r -= I_EG) < I_EU) { const int e = r / 64, q = r % 64; W = in_ptr<IN_WEU>() + (size_t)e * DM * ED; N = ED; WT = (bf16_t*)(ws + WS_WEGU) + (size_t)e * 512 * DM; ldt = DM; k0 = 64 * (q / 4); n0 = 64 * (q % 4); rm.kind = 2; rm.base = 128; }
        else { r -= I_EU; const int e = r / 64, q = r % 64; W = in_ptr<IN_WED>() + (size_t)e * ED * DM; N = DM; WT = (bf16_t*)(ws + WS_WED) + (size_t)e * DM * ED; ldt = ED; k0 = 64 * (q / 16); n0 = 64 * (q % 16); }
        tr_item(W, N, WT, ldt, k0, n0, lane, rm);
    }
}
DI void p0_adaln(Frame& F, int cb) {
    LAS float* sc = (LAS float*)F.lds;
    LAS float* red = (LAS float*)(F.lds + 16384);
    for (int i = FTID; i < 4096; i += 512) sc[i] = siluf_(in_ptr<IN_C>()[i]);
    __syncthreads();
    const int j = cb * 64 + FLANE; const float* w = in_ptr<IN_WADA>() + j;
    float a0 = 0.f, a1 = 0.f, a2 = 0.f, a3 = 0.f;
    const int kb = F.wave * 128;
#pragma unroll 8
    for (int k = 0; k < 128; ++k) { const float wv = w[(size_t)(kb + k) * 6144]; a0 += sc[kb + k] * wv; a1 += sc[1024 + kb + k] * wv; a2 += sc[2048 + kb + k] * wv; a3 += sc[3072 + kb + k] * wv; }
    red[(F.wave * 4 + 0) * 64 + FLANE] = a0; red[(F.wave * 4 + 1) * 64 + FLANE] = a1; red[(F.wave * 4 + 2) * 64 + FLANE] = a2; red[(F.wave * 4 + 3) * 64 + FLANE] = a3;
    __syncthreads();
    if (FTID < 256) { const int b = FTID >> 6, l = FTID & 63; float s = in_ptr<IN_BADA>()[cb * 64 + l];
#pragma unroll
        for (int w8 = 0; w8 < 8; ++w8) s += red[(w8 * 4 + b) * 64 + l];
        ((float*)(F.ws + WS_SMALL))[b * 6144 + cb * 64 + l] = s; }
    __syncthreads();
}
DI void p0_ssm(Frame& F, int g) {
    LAS float* apow = (LAS float*)F.lds;
    LAS float* bb = apow + 17 * 64 * 2;
    LAS float* cc = bb + 64 * 16 * 2;
    LAS float* km = cc + 16 * 64 * 2;
    const int tid = FTID;
    if (tid < 64) {
        const int p = tid;
        const float lre = fminf(in_ptr<IN_LRE>()[g * 64 + p], -1e-4f), lim = in_ptr<IN_LIM>()[g * 64 + p], dt = expf(in_ptr<IN_LDT>()[g]);
        const float mag = expf(lre * dt); float sn, cs; sincosf(lim * dt, &sn, &cs);
        const float are = mag * cs, aim = mag * sn, den = lre * lre + lim * lim, nr = are - 1.0f;
        const float cre = (nr * lre + aim * lim) / den, cim = (aim * lre - nr * lim) / den;
        for (int tau = 0; tau <= 16; ++tau) { const float mg = expf(lre * dt * (float)tau); float s2, c2; sincosf(lim * dt * (float)tau, &s2, &c2); apow[(tau * 64 + p) * 2] = mg * c2; apow[(tau * 64 + p) * 2 + 1] = mg * s2; }
        for (int c = 0; c < 16; ++c) { const float br = in_ptr<IN_BRE>()[(g * 64 + p) * 16 + c], bi = in_ptr<IN_BIM>()[(g * 64 + p) * 16 + c];
            bb[(p * 16 + c) * 2] = cre * br - cim * bi; bb[(p * 16 + c) * 2 + 1] = cre * bi + cim * br; }
        float* a16 = (float*)(F.ws + WS_SMALL + 128 * 1024);
        const float mg = expf(lre * dt * 16.0f); float s2, c2; sincosf(lim * dt * 16.0f, &s2, &c2);
        a16[(g * 64 + p) * 2] = mg * c2; a16[(g * 64 + p) * 2 + 1] = mg * s2;
    }
    for (int i = tid; i < 1024; i += 512) { cc[i * 2] = in_ptr<IN_CRE>()[g * 1024 + i]; cc[i * 2 + 1] = in_ptr<IN_CIM>()[g * 1024 + i]; }
    __syncthreads();
    for (int e = tid; e < 4096; e += 512) { const int tau = e >> 8, c = (e >> 4) & 15, c2 = e & 15; float s = 0.f;
        for (int p = 0; p < 64; ++p) { const float cr = cc[(c * 64 + p) * 2], ci = cc[(c * 64 + p) * 2 + 1], ar = apow[(tau * 64 + p) * 2], ai = apow[(tau * 64 + p) * 2 + 1], br = bb[(p * 16 + c2) * 2], bi = bb[(p * 16 + c2) * 2 + 1];
            const float tr = cr * ar - ci * ai, ti = cr * ai + ci * ar; s += tr * br - ti * bi; }
        km[e] = s; }
    __syncthreads();
    bf16_t* TF = (bf16_t*)(F.ws + WS_TF) + (size_t)g * 256 * 384;
    for (int e = tid; e < 256 * 384; e += 512) { const int n = e / 384, k = e % 384, s = n >> 4, c = n & 15; float v;
        if (k < 256) { const int s2 = k >> 4, c2 = k & 15; v = (s >= s2) ? km[((s - s2) * 16 + c) * 16 + c2] : 0.f; }
        else { const int p = (k - 256) & 63; const float cr = cc[(c * 64 + p) * 2], ci = cc[(c * 64 + p) * 2 + 1], ar = apow[((s + 1) * 64 + p) * 2], ai = apow[((s + 1) * 64 + p) * 2 + 1];
            v = (k < 320) ? (cr * ar - ci * ai) : -(cr * ai + ci * ar); }
        TF[e] = (bf16_t)(pk2(v, 0.f) & 0xffffu); }
    bf16_t* ET = (bf16_t*)(F.ws + WS_ET) + (size_t)g * 256 * 256;
    for (int e = tid; e < 256 * 256; e += 512) { const int n = e >> 8, k = e & 255, s2 = k >> 4, c2 = k & 15; float v = 0.f;
        if (n < 128) { const int p = n & 63; const float ar = apow[((15 - s2) * 64 + p) * 2], ai = apow[((15 - s2) * 64 + p) * 2 + 1], br = bb[(p * 16 + c2) * 2], bi = bb[(p * 16 + c2) * 2 + 1];
            v = (n < 64) ? (ar * br - ai * bi) : (ar * bi + ai * br); }
        ET[e] = (bf16_t)(pk2(v, 0.f) & 0xffffu); }
    __syncthreads();
}

DI void norm_mod_rows(Frame& F, const float* x, const float* gvec, int sh_off, int sc_off, bf16_t* outp) {
    const float* mod = (const float*)(F.ws + WS_SMALL);
    const int gw = F.vcu * 8 + F.wave, NGW = F.G * 8;
    for (int m = gw; m < M; m += NGW) {
        const int b = m / SEQ;
        const f32x4* xr = (const f32x4*)(x + (size_t)m * DM) + FLANE;
        f32x4 v[4]; float s = 0.f;
#pragma unroll
        for (int j = 0; j < 4; ++j) { v[j] = xr[64 * j]; s += (v[j].x * v[j].x + v[j].y * v[j].y) + (v[j].z * v[j].z + v[j].w * v[j].w); }
        const float rstd = 1.0f / sqrtf(wave_sum(s) * (1.0f / DM) + EPSF);
        u32x2* o8 = (u32x2*)(outp + (size_t)m * DM) + FLANE;
#pragma unroll
        for (int j = 0; j < 4; ++j) { const int col = 4 * FLANE + 256 * j;
            const f32x4 gv = *(const f32x4*)(gvec + col), scv = *(const f32x4*)(mod + b * 6144 + sc_off + col), shv = *(const f32x4*)(mod + b * 6144 + sh_off + col);
            const f32x4 y = v[j] * rstd * gv * (scv + 1.0f) + shv;
            u32x2 w; w.x = pk2(y.x, y.y); w.y = pk2(y.z, y.w); o8[64 * j] = w; }
    }
}

struct DenseSched {
    pg8::StaticOrder so; const char* A; const char* B; size_t astep, bstep;
    DI void init(int Mr, int N, int G, int c, const void* A_, int lda, const void* B_, int ldb) { so.init(Mr, N, G, c); A = (const char*)A_; B = (const char*)B_; astep = (size_t)256 * lda * 2; bstep = (size_t)256 * ldb * 2; }
    DI bool next(int i, Unit& u) const { int pm, pn; if (!so.next(i, pm, pn)) return false; u.pm = pm; u.pn = pn; u.aux = 0; u.half = 0; u.rowtab = nullptr; u.A = A + (size_t)pm * astep; u.B = B + (size_t)pn * bstep; return true; }
};

struct EpiInProj {
    static constexpr bool PERM = true;
    bf16_t *Q, *Kb, *V, *Assm, *sga, *sgs; float* kmean; const float *qg, *kg;
    DI void operator()(const AccT& acc, const Unit& u, int wr, int wc, int fr, int fq) const {
        const int pn = u.pn, pm = u.pm;
        const int row0 = pm * 256 + wr * 64 + fr;
        if (pn < 4) {
            const bool isk = pn >= 2; const int hg = (pn & 1) * 4 + wc;
            const float* gp = (isk ? kg : qg) + 8 * fq; const float scl = isk ? 1.0f : QC2;
            f32x4 gv[2][2];
#pragma unroll
            for (int bj = 0; bj < 2; ++bj)
#pragma unroll
                for (int n = 0; n < 2; ++n) gv[bj][n] = *(const f32x4*)(gp + 32 * bj + 4 * n) * scl;
            f32x4 ks[2][2];
#pragma unroll
            for (int bj = 0; bj < 2; ++bj)
#pragma unroll
                for (int n = 0; n < 2; ++n) ks[bj][n] = (f32x4){0.f, 0.f, 0.f, 0.f};
            bf16_t* dst = (isk ? Kb : Q) + hg * 64 + 8 * fq;
#pragma unroll
            for (int ai = 0; ai < 2; ++ai)
#pragma unroll
                for (int m = 0; m < 4; ++m) {
                    float ss = 0.f;
#pragma unroll
                    for (int bj = 0; bj < 2; ++bj)
#pragma unroll
                        for (int n = 0; n < 2; ++n) { const f32x4 a = acc[ai][bj][m][n]; ss += (a.x * a.x + a.y * a.y) + (a.z * a.z + a.w * a.w); }
                    ss += __shfl_xor(ss, 16); ss += __shfl_xor(ss, 32);
                    const float rstd = 1.0f / sqrtf(ss * (1.0f / 64.0f) + EPSF);
                    const size_t row = (size_t)(row0 + ai * 128 + m * 16);
#pragma unroll
                    for (int bj = 0; bj < 2; ++bj) {
                        const f32x4 v0 = acc[ai][bj][m][0] * rstd * gv[bj][0], v1 = acc[ai][bj][m][1] * rstd * gv[bj][1];
                        if (isk) { ks[bj][0] += v0; ks[bj][1] += v1; }
                        u32x4 w; w.x = pk2(v0.x, v0.y); w.y = pk2(v0.z, v0.w); w.z = pk2(v1.x, v1.y); w.w = pk2(v1.z, v1.w);
                        *(u32x4*)(dst + row * 512 + 32 * bj) = w; }
                }
            if (isk) {
                const int b = pm >> 4, blk = pm & 15;
                float* kmp = kmean + ((size_t)((b * 8 + hg) * 16 + blk)) * 64 + 8 * fq;
#pragma unroll
                for (int bj = 0; bj < 2; ++bj)
#pragma unroll
                    for (int n = 0; n < 2; ++n)
#pragma unroll
                        for (int j = 0; j < 4; ++j) { float s = ks[bj][n][j]; s += __shfl_xor(s, 1); s += __shfl_xor(s, 2); s += __shfl_xor(s, 4); s += __shfl_xor(s, 8);
                            if (fr == 0) kmp[wr * 32768 + 32 * bj + 4 * n + j] = s * (1.0f / 256.0f); }
            }
        } else if (pn < 6) {
            bf16_t* dst = V + (pn - 4) * 256 + wc * 32 + 8 * fq;
#pragma unroll
            for (int ai = 0; ai < 2; ++ai)
#pragma unroll
                for (int m = 0; m < 4; ++m) { const size_t row = (size_t)(row0 + ai * 128 + m * 16);
#pragma unroll
                    for (int bj = 0; bj < 2; ++bj) { const f32x4 v0 = acc[ai][bj][m][0], v1 = acc[ai][bj][m][1];
                        u32x4 w; w.x = pk2(v0.x, v0.y); w.y = pk2(v0.z, v0.w); w.z = pk2(v1.x, v1.y); w.w = pk2(v1.z, v1.w);
                        *(u32x4*)(dst + row * 512 + 128 * bj) = w; } }
        } else if (pn < 8) {
            const int b = pm >> 4;
#pragma unroll
            for (int ai = 0; ai < 2; ++ai)
#pragma unroll
                for (int m = 0; m < 4; ++m) { const int t = (pm & 15) * 256 + ai * 128 + wr * 64 + m * 16 + fr;
#pragma unroll
                    for (int bj = 0; bj < 2; ++bj) { const int c = (pn - 6) * 256 + 128 * bj + 32 * wc + 8 * fq, g = c >> 4, c2 = c & 15;
                        const f32x4 v0 = acc[ai][bj][m][0], v1 = acc[ai][bj][m][1];
                        u32x4 w; w.x = pk2(v0.x, v0.y); w.y = pk2(v0.z, v0.w); w.z = pk2(v1.x, v1.y); w.w = pk2(v1.z, v1.w);
                        *(u32x4*)(Assm + ((size_t)g * 1024 + b * 256 + (t >> 4)) * 384 + (t & 15) * 16 + c2) = w; } }
        } else {
            bf16_t* dst = (pn < 12 ? sga + (pn - 8) * 256 : sgs + (pn - 12) * 256) + wc * 32 + 8 * fq;
#pragma unroll
            for (int ai = 0; ai < 2; ++ai)
#pragma unroll
                for (int m = 0; m < 4; ++m) { const size_t row = (size_t)(row0 + ai * 128 + m * 16);
#pragma unroll
                    for (int bj = 0; bj < 2; ++bj) { const f32x4 v0 = acc[ai][bj][m][0], v1 = acc[ai][bj][m][1];
                        u32x4 w; w.x = pk2(sigmoidf_(v0.x), sigmoidf_(v0.y)); w.y = pk2(sigmoidf_(v0.z), sigmoidf_(v0.w)); w.z = pk2(sigmoidf_(v1.x), sigmoidf_(v1.y)); w.w = pk2(sigmoidf_(v1.z), sigmoidf_(v1.w));
                        *(u32x4*)(dst + row * 1024 + 128 * bj) = w; } }
        }
    }
};

struct EpiS1 {
    static constexpr bool PERM = false;
    float* Hloc;
    DI void operator()(const AccT& acc, const Unit& u, int wr, int wc, int fr, int fq) const {
        float* base = Hloc + (size_t)u.pm * 256 * 128 + wc * 32 + 4 * fq;
#pragma unroll
        for (int ai = 0; ai < 2; ++ai)
#pragma unroll
            for (int m = 0; m < 4; ++m) { const int r = ai * 128 + wr * 64 + m * 16 + fr;
#pragma unroll
                for (int n = 0; n < 2; ++n) *(f32x4*)(base + (size_t)r * 128 + 16 * n) = acc[ai][0][m][n]; }
    }
};
struct SsmSched {
    int G, c; const char* A; const char* B; size_t bstep;
    DI bool next(int i, Unit& u) const { const int L = i * G + c; if (L >= 128) return false; u.pm = L; u.pn = 0; u.aux = 0; u.half = 0; u.rowtab = nullptr;
        u.A = A + (size_t)L * 256 * 384 * 2; u.B = B + (size_t)(L >> 2) * bstep; return true; }
};
struct EpiS2 {
    static constexpr bool PERM = true;
    const bf16_t* Assm; const float* dskip; bf16_t* gbuf;
    DI void operator()(const AccT& acc, const Unit& u, int wr, int wc, int fr, int fq) const {
        const int g = u.pm >> 2, b = u.pm & 3;
#pragma unroll
        for (int ai = 0; ai < 2; ++ai)
#pragma unroll
            for (int m = 0; m < 4; ++m) { const int r = ai * 128 + wr * 64 + m * 16 + fr;
#pragma unroll
                for (int bj = 0; bj < 2; ++bj) { const int c = 128 * bj + 32 * wc + 8 * fq, s = c >> 4, c2 = c & 15;
                    const int t = 16 * r + s;
                    size_t uo = ((size_t)u.pm * 256 + r) * 384 + c, oo = ((size_t)b * SEQ + t) * 512 + g * 16 + c2;
                    asm volatile("" : "+v"(uo), "+v"(oo));
                    const u32x2* up = (const u32x2*)(Assm + uo);
                    u32x2* op = (u32x2*)(gbuf + oo);
#pragma unroll
                    for (int n = 0; n < 2; ++n) {
                        const u32x2 uu = up[n]; const f32x4 d0 = *(const f32x4*)(dskip + g * 16 + c2 + 4 * n); const f32x4 a0 = acc[ai][bj][m][n];
                        const float y0 = a0.x + d0.x * bflo(uu.x), y1 = a0.y + d0.y * bfhi(uu.x), y2 = a0.z + d0.z * bflo(uu.y), y3 = a0.w + d0.w * bfhi(uu.y);
                        u32x2 w; w.x = pk2(gelu_tanh(y0), gelu_tanh(y1)); w.y = pk2(gelu_tanh(y2), gelu_tanh(y3));
                        op[n] = w; asm volatile("" ::: "memory"); } } }
    }
};
struct EpiGluUp {
    static constexpr bool PERM = true;
    const bf16_t* gbuf; const float* bglu; bf16_t* sout; const bf16_t* sga; bf16_t* P1;
    DI void operator()(const AccT& acc, const Unit& u, int wr, int wc, int fr, int fq) const {
        const int row0 = u.pm * 256 + wr * 64 + fr, col0 = u.pn * 256 + wc * 32 + 8 * fq;
#pragma unroll
        for (int ai = 0; ai < 2; ++ai)
#pragma unroll
            for (int m = 0; m < 4; ++m) { const size_t row = (size_t)(row0 + ai * 128 + m * 16);
#pragma unroll
                for (int bj = 0; bj < 2; ++bj) { const int col = col0 + 128 * bj; const f32x4 a0 = acc[ai][bj][m][0], a1 = acc[ai][bj][m][1]; u32x4 w;
                    if (u.aux == 0) { const u32x4 gg = *(const u32x4*)(gbuf + row * 512 + col); const f32x4 b0 = *(const f32x4*)(bglu + col), b1 = *(const f32x4*)(bglu + col + 4);
                        w.x = pk2(bflo(gg.x) * sigmoidf_(a0.x + b0.x), bfhi(gg.x) * sigmoidf_(a0.y + b0.y)); w.y = pk2(bflo(gg.y) * sigmoidf_(a0.z + b0.z), bfhi(gg.y) * sigmoidf_(a0.w + b0.w));
                        w.z = pk2(bflo(gg.z) * sigmoidf_(a1.x + b1.x), bfhi(gg.z) * sigmoidf_(a1.y + b1.y)); w.w = pk2(bflo(gg.w) * sigmoidf_(a1.z + b1.z), bfhi(gg.w) * sigmoidf_(a1.w + b1.w));
                        *(u32x4*)(sout + row * 512 + col) = w;
                    } else { const u32x4 gg = *(const u32x4*)(sga + row * 1024 + col);
                        w.x = pk2(bflo(gg.x) * a0.x, bfhi(gg.x) * a0.y); w.y = pk2(bflo(gg.y) * a0.z, bfhi(gg.y) * a0.w); w.z = pk2(bflo(gg.z) * a1.x, bfhi(gg.z) * a1.y); w.w = pk2(bflo(gg.w) * a1.z, bfhi(gg.w) * a1.w);
                        *(u32x4*)(P1 + row * 1024 + col) = w; } } }
    }
};
struct GluUpSched {
    int G, c; const char *Ag, *Bg, *Au, *Bu;
    DI bool next(int i, Unit& u) const { const int L = i * G + c; if (L >= 384) return false; u.rowtab = nullptr; u.half = 0;
        if (L < 128) { u.aux = 0; u.pm = L >> 1; u.pn = L & 1; u.A = Ag + (size_t)u.pm * 256 * 512 * 2; u.B = Bg + (size_t)u.pn * 256 * 512 * 2; }
        else { const int l2 = L - 128; u.aux = 1; u.pm = l2 >> 2; u.pn = l2 & 3; u.A = Au + (size_t)u.pm * 256 * 512 * 2; u.B = Bu + (size_t)u.pn * 256 * 512 * 2; }
        return true; }
};
struct EpiUp2 {
    static constexpr bool PERM = true;
    const bf16_t* P1; const bf16_t* sgs; bf16_t* mix;
    DI void operator()(const AccT& acc, const Unit& u, int wr, int wc, int fr, int fq) const {
        const int row0 = u.pm * 256 + wr * 64 + fr, col0 = u.pn * 256 + wc * 32 + 8 * fq;
#pragma unroll
        for (int ai = 0; ai < 2; ++ai)
#pragma unroll
            for (int m = 0; m < 4; ++m) { const size_t row = (size_t)(row0 + ai * 128 + m * 16);
#pragma unroll
                for (int bj = 0; bj < 2; ++bj) { const size_t o = row * 1024 + col0 + 128 * bj; const f32x4 a0 = acc[ai][bj][m][0], a1 = acc[ai][bj][m][1];
                    const u32x4 gg = *(const u32x4*)(sgs + o), pp = *(const u32x4*)(P1 + o); u32x4 w;
                    w.x = pk2(bflo(pp.x) + bflo(gg.x) * a0.x, bfhi(pp.x) + bfhi(gg.x) * a0.y); w.y = pk2(bflo(pp.y) + bflo(gg.y) * a0.z, bfhi(pp.y) + bfhi(gg.y) * a0.w);
                    w.z = pk2(bflo(pp.z) + bflo(gg.z) * a1.x, bfhi(pp.z) + bfhi(gg.z) * a1.y); w.w = pk2(bflo(pp.w) + bflo(gg.w) * a1.z, bfhi(pp.w) + bfhi(gg.w) * a1.w);
                    *(u32x4*)(mix + o) = w; } }
    }
};
struct EpiOut {
    static constexpr bool PERM = true;
    const float* x; const float* mod; float* out;
    DI void operator()(const AccT& acc, const Unit& u, int wr, int wc, int fr, int fq) const {
        const int row0 = u.pm * 256 + wr * 64 + fr, col0 = u.pn * 256 + wc * 32 + 8 * fq, b = u.pm >> 4;
#pragma unroll
        for (int bj = 0; bj < 2; ++bj) { const int col = col0 + 128 * bj;
            const f32x4 g0 = *(const f32x4*)(mod + b * 6144 + 2048 + col), g1 = *(const f32x4*)(mod + b * 6144 + 2048 + col + 4);
#pragma unroll
            for (int ai = 0; ai < 2; ++ai)
#pragma unroll
                for (int m = 0; m < 4; ++m) { const size_t o = (size_t)(row0 + ai * 128 + m * 16) * 1024 + col;
                    const f32x4 x0 = *(const f32x4*)(x + o), x1 = *(const f32x4*)(x + o + 4);
                    *(f32x4*)(out + o) = x0 + g0 * acc[ai][bj][m][0]; *(f32x4*)(out + o + 4) = x1 + g1 * acc[ai][bj][m][1]; } }
    }
};
struct EpiRsh {
    static constexpr bool PERM = true;
    float* scores; bf16_t* hs;
    DI void operator()(const AccT& acc, const Unit& u, int wr, int wc, int fr, int fq) const {
        const int row0 = u.pm * 256 + wr * 64 + fr;
        if (u.pn == 0) {
#pragma unroll
            for (int ai = 0; ai < 2; ++ai)
#pragma unroll
                for (int m = 0; m < 4; ++m) { const size_t row = (size_t)(row0 + ai * 128 + m * 16);
#pragma unroll
                    for (int bj = 0; bj < 2; ++bj) { float* d = scores + row * 256 + 128 * bj + 32 * wc + 8 * fq; const f32x4 a0 = acc[ai][bj][m][0], a1 = acc[ai][bj][m][1];
                        *(f32x4*)d = (f32x4){sigmoidf_(a0.x), sigmoidf_(a0.y), sigmoidf_(a0.z), sigmoidf_(a0.w)}; *(f32x4*)(d + 4) = (f32x4){sigmoidf_(a1.x), sigmoidf_(a1.y), sigmoidf_(a1.z), sigmoidf_(a1.w)}; } }
        } else {
#pragma unroll
            for (int ai = 0; ai < 2; ++ai)
#pragma unroll
                for (int m = 0; m < 4; ++m) { const size_t row = (size_t)(row0 + ai * 128 + m * 16);
                    const f32x4 g0 = acc[ai][0][m][0], g1 = acc[ai][0][m][1], u0 = acc[ai][1][m][0], u1 = acc[ai][1][m][1]; u32x4 w;
                    w.x = pk2(siluf_(g0.x) * u0.x, siluf_(g0.y) * u0.y); w.y = pk2(siluf_(g0.z) * u0.z, siluf_(g0.w) * u0.w); w.z = pk2(siluf_(g1.x) * u1.x, siluf_(g1.y) * u1.y); w.w = pk2(siluf_(g1.z) * u1.z, siluf_(g1.w) * u1.w);
                    *(u32x4*)(hs + row * 256 + 128 * (u.pn - 1) + 32 * wc + 8 * fq) = w; }
        }
    }
};
struct EpiBf16 {
    static constexpr bool PERM = true;
    bf16_t* O; int ldc;
    DI void operator()(const AccT& acc, const Unit& u, int wr, int wc, int fr, int fq) const {
        const int row0 = u.pm * 256 + wr * 64 + fr, col0 = u.pn * 256 + wc * 32 + 8 * fq;
#pragma unroll
        for (int ai = 0; ai < 2; ++ai)
#pragma unroll
            for (int m = 0; m < 4; ++m) { const size_t row = (size_t)(row0 + ai * 128 + m * 16);
#pragma unroll
                for (int bj = 0; bj < 2; ++bj) { const f32x4 v0 = acc[ai][bj][m][0], v1 = acc[ai][bj][m][1];
                    u32x4 w; w.x = pk2(v0.x, v0.y); w.y = pk2(v0.z, v0.w); w.z = pk2(v1.x, v1.y); w.w = pk2(v1.z, v1.w);
                    *(u32x4*)(O + row * ldc + col0 + 128 * bj) = w; } asm volatile("" ::: "memory"); }
    }
};
struct EpiMoe1 {
    static constexpr bool PERM = true;
    bf16_t* Hs;
    DI void operator()(const AccT& acc, const Unit& u, int wr, int wc, int fr, int fq) const {
        const int row0 = u.pm * 256 + wr * 64 + fr;
#pragma unroll
        for (int ai = 0; ai < 2; ++ai)
#pragma unroll
            for (int m = 0; m < 4; ++m) { const size_t row = (size_t)(row0 + ai * 128 + m * 16);
                const f32x4 g0 = acc[ai][0][m][0], g1 = acc[ai][0][m][1], u0 = acc[ai][1][m][0], u1 = acc[ai][1][m][1]; u32x4 w;
                w.x = pk2(siluf_(g0.x) * u0.x, siluf_(g0.y) * u0.y); w.y = pk2(siluf_(g0.z) * u0.z, siluf_(g0.w) * u0.w); w.z = pk2(siluf_(g1.x) * u1.x, siluf_(g1.y) * u1.y); w.w = pk2(siluf_(g1.z) * u1.z, siluf_(g1.w) * u1.w);
                *(u32x4*)(Hs + row * 256 + 128 * u.pn + 32 * wc + 8 * fq) = w; }
    }
};
struct EpiMoe2 {
    static constexpr bool PERM = true;
    const int* dest; const float* roww; bf16_t* Y;
    DI void operator()(const AccT& acc, const Unit& u, int wr, int wc, int fr, int fq) const {
        const int row0 = u.pm * 256 + wr * 64 + fr, col0 = u.pn * 256 + wc * 32 + 8 * fq;
        int dd[2][4]; float ww[2][4];
#pragma unroll
        for (int ai = 0; ai < 2; ++ai)
#pragma unroll
            for (int m = 0; m < 4; ++m) { const int row = row0 + ai * 128 + m * 16; dd[ai][m] = dest[row]; ww[ai][m] = roww[row]; }
#pragma unroll
        for (int ai = 0; ai < 2; ++ai)
#pragma unroll
            for (int m = 0; m < 4; ++m) { const int d = dd[ai][m]; const float wt = ww[ai][m];
                if (d >= 0) {
#pragma unroll
                    for (int bj = 0; bj < 2; ++bj) { const f32x4 v0 = acc[ai][bj][m][0] * wt, v1 = acc[ai][bj][m][1] * wt;
                        u32x4 w; w.x = pk2(v0.x, v0.y); w.y = pk2(v0.z, v0.w); w.z = pk2(v1.x, v1.y); w.w = pk2(v1.z, v1.w);
                        *(u32x4*)(Y + (size_t)d * 1024 + col0 + 128 * bj) = w; } } }
    }
};
struct MoeSched {
    int G, c, npn, ntiles; const LAS unsigned short* tile_e; const char* A; const char* B; size_t astep, bestep, bnstep; const int* rowtab;
    DI bool next(int i, Unit& u) const { const int L = i * G + c; if (L >= ntiles * npn) return false; const int tile = L / npn, pn = L % npn; const int e = tile_e[tile];
        u.pm = tile; u.pn = pn; u.aux = e; u.half = (tile_e[MAXTILES + tile] <= 128) ? 1 : 0; u.rowtab = rowtab + tile * 256; u.A = A + (size_t)tile * astep; u.B = B + (size_t)e * bestep + (size_t)pn * bnstep; return true; }
};

namespace att {
constexpr int DMA_ = 512;
constexpr int NW = 8, QBLK = 32, QB = 256, KVBLK = 64;
DI int crow(int r, int hi) { return (r & 3) + 8 * (r >> 2) + 4 * hi; }
#define SBAR() __builtin_amdgcn_sched_barrier(0)
DI void cmask(f32x16& p0, f32x16& p1, int jb, int qrel, int hi) {
    const float NEG = -INFINITY; int kb = 64 * jb + 4 * hi;
#pragma unroll
    for (int r = 0; r < 16; ++r) { int kv = kb + (r & 3) + 8 * (r >> 2); if (kv > qrel) p0[r] = NEG; if (kv + 32 > qrel) p1[r] = NEG; }
}
constexpr int NSLOT = 3, SLOTB = 8192;
constexpr int LDS_K = 0, LDS_V = NSLOT * SLOTB, LDS_WS = 2 * NSLOT * SLOTB, LDS_OST = LDS_WS + NW * 64 * 4, LDS_KM = LDS_OST + NW * 4096, LDS_BT = LDS_KM + 4096, LDS_END = LDS_BT + 576 * 4;
static_assert(LDS_END <= RING_BYTES, "attention LDS");
DI void glds16(const void* sbase, unsigned voff, unsigned lds_dst) { unsigned keep;
    asm volatile("s_nop 4\n\ts_mov_b32 %0, m0\n\ts_mov_b32 m0, %2\n\ts_nop 0\n\tglobal_load_lds_dwordx4 %1, %3\n\ts_mov_b32 m0, %0" : "=&s"(keep) : "v"(voff), "s"(lds_dst), "s"(sbase) : "memory"); }
DI float max3f(float a, float b, float c) { float r; asm("v_max3_f32 %0, %1, %2, %3" : "=v"(r) : "v"(a), "v"(b), "v"(c)); return r; }
DI float max2f(float a, float b) { float r; asm("v_max_f32_e32 %0, %1, %2" : "=v"(r) : "v"(a), "v"(b)); return r; }
DI float fadd_s(float a, float b) { float r; asm("v_add_f32_e32 %0, %1, %2" : "=v"(r) : "v"(a), "v"(b)); return r; }
DI float fsub_s(float a, float b) { float r; asm("v_sub_f32_e32 %0, %1, %2" : "=v"(r) : "v"(a), "v"(b)); return r; }
DI unsigned cvtpk_s(float lo, float hi) { return pk2(lo, hi); }
#define WAIT_BAR(N) asm volatile("s_waitcnt vmcnt(" #N ") lgkmcnt(0)\n\ts_barrier" ::: "memory")
DI void qkt(f32x16& p0, f32x16& p1, const char* Kslot, const bf16x8* qr, const f32x16& negm, int r32, int hi) {
    const char* kb = Kslot + hi * 1024 + r32 * 16;
#pragma unroll
    for (int d0 = 0; d0 < 4; ++d0) {
        const bf16x8 b0 = *reinterpret_cast<const bf16x8*>(kb + d0 * 2048);
        const bf16x8 b1 = *reinterpret_cast<const bf16x8*>(kb + d0 * 2048 + 512);
        if (d0 == 0) { p0 = __builtin_amdgcn_mfma_f32_32x32x16_bf16(b0, qr[0], negm, 0, 0, 0); p1 = __builtin_amdgcn_mfma_f32_32x32x16_bf16(b1, qr[0], negm, 0, 0, 0); }
        else { p0 = __builtin_amdgcn_mfma_f32_32x32x16_bf16(b0, qr[d0], p0, 0, 0, 0); p1 = __builtin_amdgcn_mfma_f32_32x32x16_bf16(b1, qr[d0], p1, 0, 0, 0); } }
}
typedef LAS const char* lds_cptr;
typedef short v4i16_t __attribute__((ext_vector_type(4)));
DI void kload8(bf16x8* kf, lds_cptr kp) {
    kf[0] = *(const LAS bf16x8*)(kp);        kf[1] = *(const LAS bf16x8*)(kp + 512);
    kf[2] = *(const LAS bf16x8*)(kp + 2048); kf[3] = *(const LAS bf16x8*)(kp + 2560);
    kf[4] = *(const LAS bf16x8*)(kp + 4096); kf[5] = *(const LAS bf16x8*)(kp + 4608);
    kf[6] = *(const LAS bf16x8*)(kp + 6144); kf[7] = *(const LAS bf16x8*)(kp + 6656);
}
DI void kload2(bf16x8* kf, lds_cptr kp, int j) { kf[2 * j] = *(const LAS bf16x8*)(kp + j * 2048); kf[2 * j + 1] = *(const LAS bf16x8*)(kp + j * 2048 + 512); }
DI s16x4 vtr(lds_cptr p) { return __builtin_bit_cast(s16x4, __builtin_amdgcn_ds_read_tr16_b64_v4i16((LAS v4i16_t*)p)); }
DI float rowmax(const f32x16& p0, const f32x16& p1) {
    float a = max3f(p0[0], p0[1], p1[0]), b = max3f(p0[2], p0[3], p1[1]); a = max3f(a, p1[2], p1[3]);
#pragma unroll
    for (int r = 4; r < 16; r += 4) { a = max3f(a, p0[r], p0[r + 1]); b = max3f(b, p0[r + 2], p0[r + 3]); a = max3f(a, p1[r], p1[r + 1]); b = max3f(b, p1[r + 2], p1[r + 3]); }
    const float m = max2f(a, b);
    auto rr = __builtin_amdgcn_permlane32_swap(__float_as_uint(m), __float_as_uint(m), false, false);
    return max2f(__uint_as_float(rr[0]), __uint_as_float(rr[1]));
}
DI void pv(f32x16* o, int vb, bf16x8 pa0, bf16x8 pa1, bf16x8 pa2, bf16x8 pa3) {
#pragma unroll
    for (int d0 = 0; d0 < 2; ++d0) { s16x4 lo[4], hi[4];
#pragma unroll
        for (int ks = 0; ks < 4; ++ks) {
            asm volatile("ds_read_b64_tr_b16 %0,%1 offset:%c2" : "=&v"(lo[ks]) : "v"(vb), "i"(d0 * 4096 + ks * 1024) : "memory");
            asm volatile("ds_read_b64_tr_b16 %0,%1 offset:%c2" : "=&v"(hi[ks]) : "v"(vb), "i"(d0 * 4096 + ks * 1024 + 512) : "memory"); }
        asm volatile("s_waitcnt lgkmcnt(0)" ::: "memory"); SBAR();
#define PK(k) (bf16x8){lo[k][0], lo[k][1], lo[k][2], lo[k][3], hi[k][0], hi[k][1], hi[k][2], hi[k][3]}
        o[d0] = __builtin_amdgcn_mfma_f32_32x32x16_bf16(pa0, PK(0), o[d0], 0, 0, 0);
        o[d0] = __builtin_amdgcn_mfma_f32_32x32x16_bf16(pa1, PK(1), o[d0], 0, 0, 0);
        o[d0] = __builtin_amdgcn_mfma_f32_32x32x16_bf16(pa2, PK(2), o[d0], 0, 0, 0);
        o[d0] = __builtin_amdgcn_mfma_f32_32x32x16_bf16(pa3, PK(3), o[d0], 0, 0, 0);
#undef PK
    }
}
DI int t5_bucket(int n) { if (n < 16) return n; int v = 16 + (int)(logf((float)n * (1.0f / 16.0f)) * (16.0f / 2.0794415416798357f)); return v > 31 ? 31 : v; }

template <int THRL> DI void attn_unit(int wid, int b, int h, int qb, const bf16_t* Q, const bf16_t* __restrict__ K, const bf16_t* __restrict__ V, bf16_t* O, char* shm, const float* kmean, const float* relb) {
    int lane = lane_id(); asm volatile("" : "+v"(lane));
    const int tid = wid * 64 + lane, r32 = lane & 31, hi = lane >> 5;
    const long rowbase = (long)b * SEQ; const int q0 = qb * QB;
    const bf16_t* Qw = Q + (rowbase + q0 + wid * QBLK) * DMA_ + h * 64;
    const bf16_t* Kh = K + rowbase * DMA_ + h * 64, *Vh = V + rowbase * DMA_ + h * 64;
    const unsigned lds0 = (unsigned)(uintptr_t)shm;
    LAS float* wsf = (LAS float*)((LAS char*)shm + LDS_WS) + wid * 64;
    LAS float* kms = (LAS float*)((LAS char*)shm + LDS_KM); LAS float* bt = (LAS float*)((LAS char*)shm + LDS_BT);
    if (tid < 256) *(LAS f32x4*)(kms + 4 * tid) = *(const f32x4*)(kmean + (size_t)(b * 8 + h) * 1024 + 4 * tid) + *(const f32x4*)(kmean + 32768 + (size_t)(b * 8 + h) * 1024 + 4 * tid);
    for (int i = tid; i < 576; i += 512) { const int n = i - 256; float v = 0.f; if (n >= 0 && n < 128) v = (relb[t5_bucket(n) * 8 + h] - relb[31 * 8 + h]) * LOG2E; bt[i] = exp2f(v); }
    asm volatile("s_waitcnt vmcnt(0) lgkmcnt(0)\n\ts_barrier" ::: "memory");
    unsigned selmask = 0;
    {
        float gsc[8];
#pragma unroll
        for (int j = 0; j < 8; ++j) gsc[j] = 0.f;
#pragma unroll
        for (int c8 = 0; c8 < 8; ++c8) { const u32x4 qq = *(const u32x4*)(Qw + (long)r32 * DMA_ + c8 * 8);
            float qv[8] = {bflo(qq.x), bfhi(qq.x), bflo(qq.y), bfhi(qq.y), bflo(qq.z), bfhi(qq.z), bflo(qq.w), bfhi(qq.w)};
#pragma unroll
            for (int j = 0; j < 8; ++j) { const LAS float* kp = kms + (8 * hi + j) * 64 + c8 * 8; const f32x4 k0 = *(const LAS f32x4*)kp, k1 = *(const LAS f32x4*)(kp + 4);
                gsc[j] += qv[0] * k0.x + qv[1] * k0.y + qv[2] * k0.z + qv[3] * k0.w + qv[4] * k1.x + qv[5] * k1.y + qv[6] * k1.z + qv[7] * k1.w; } }
        float ga[16];
#pragma unroll
        for (int j = 0; j < 8; ++j) { const float o = __shfl_xor(gsc[j], 32); ga[j] = hi ? o : gsc[j]; ga[8 + j] = hi ? gsc[j] : o; }
#pragma unroll
        for (int j = 0; j < 16; ++j) if (j >= qb) ga[j] = -INFINITY;
#pragma unroll
        for (int k = 0; k < 3; ++k) { float bv = -INFINITY; int bi = -1;
#pragma unroll
            for (int j = 0; j < 16; ++j) if (ga[j] > bv) { bv = ga[j]; bi = j; }
            if (bi >= 0) { selmask |= 1u << bi;
#pragma unroll
                for (int j = 0; j < 16; ++j) if (j == bi) ga[j] = -INFINITY; } }
        selmask |= 0xffff0000u | (1u << qb);
    }
    const unsigned kvo = (unsigned)(lane * DMA_ * 2);
    const unsigned vvo = (unsigned)(((lane >> 2) * DMA_ + (lane & 3) * 8) * 2);
    const bf16_t* kub = Kh + wid * 8; const bf16_t* vub = Vh + (long)(16 * (wid & 3)) * DMA_ + (wid >> 2) * 32;
    const unsigned kdst = lds0 + LDS_K + wid * 1024, vdst = lds0 + LDS_V + wid * 1024;
#define DMA_K(t, slot) glds16(kub + (long)(t) * KVBLK * DMA_, kvo, (unsigned)__builtin_amdgcn_readfirstlane(kdst + (slot)))
#define DMA_V(t, slot) glds16(vub + (long)(t) * KVBLK * DMA_, vvo, (unsigned)__builtin_amdgcn_readfirstlane(vdst + (slot)))
    const int vb0 = (int)(lds0 + LDS_V) + ((lane >> 4) & 1) * 32 + (lane & 3) * 8 + (4 * hi + ((lane & 15) >> 2)) * 64;
    const char* Kbase = shm + LDS_K; bf16x8 kf[8];
    const lds_cptr shm3 = (lds_cptr)shm; const lds_cptr kp0 = shm3 + LDS_K + hi * 1024 + r32 * 16; const lds_cptr vp0 = shm3 + LDS_V + ((lane >> 4) & 1) * 32 + (lane & 3) * 8 + (4 * hi + ((lane & 15) >> 2)) * 64;
    const int NT = (q0 + QB) / KVBLK;
    DMA_K(0, 0); DMA_V(0, 0); DMA_K(1, SLOTB);
    bf16x8 qr[4];
#pragma unroll
    for (int d0 = 0; d0 < 4; ++d0) qr[d0] = *reinterpret_cast<const bf16x8*>(&Qw[(long)r32 * DMA_ + d0 * 16 + hi * 8]);
    float mhat = 0.f, l_reg = 0.f; f32x16 o[2]; o[0] = f32x16{}; o[1] = f32x16{}; f32x16 negm;
#pragma unroll
    for (int r = 0; r < 16; ++r) negm[r] = (selmask & 1u) ? 0.f : -1e30f;
    asm volatile("" : "+v"(negm));
    const int qrel = wid * QBLK + r32;
#define MASKS(P0, P1, t) do { int jb_ = (t) - (NT - 4); if (jb_ >= 0) cmask(P0, P1, jb_, qrel, hi); } while (0)
#define BIASM(P0, P1, t) do { if ((t) >= NT - 9 && q0 + wid * QBLK - (64 * (t) + 63) < 128) { const LAS float* bp_ = bt + (q0 + qrel - 64 * (t) + 256 - 63 - 4 * hi); \
        _Pragma("unroll") for (int r4 = 0; r4 < 16; r4 += 4) { _Pragma("unroll") for (int r = r4; r < r4 + 4; ++r) { P0[r] *= bp_[63 - crow(r, 0)]; P1[r] *= bp_[31 - crow(r, 0)]; } SBAR(); } } } while (0)
#define MOFF(t) (((selmask >> ((t) >> 2)) & 1u) ? 0.f : -1e30f)
#define UPD(t) do { if (((t) & 3) == 0) { const float nv_ = MOFF(t) - mhat; \
        _Pragma("unroll") for (int r = 0; r < 16; ++r) negm[r] = nv_; asm volatile("" : "+v"(negm)); } } while (0)
    bool resc = false;
#define START(P0, P1) do { const float rm = rowmax(P0, P1); resc = false; \
    { const float dl = __builtin_fmaxf(rm, 0.f); mhat = fadd_s(mhat, dl); \
      _Pragma("unroll") for (int r = 0; r < 16; ++r) { P0[r] = fsub_s(P0[r], dl); P1[r] = fsub_s(P1[r], dl); } \
      const float nv_ = MOFF(0) - mhat; _Pragma("unroll") for (int r = 0; r < 16; ++r) negm[r] = nv_; asm volatile("" : "+v"(negm)); } \
    _Pragma("unroll") for (int r = 0; r < 16; ++r) P0[r] = __builtin_amdgcn_exp2f(P0[r]); } while (0)
#define RESC() do { if (resc) { asm volatile("s_waitcnt lgkmcnt(0)" ::: "memory"); \
      _Pragma("unroll") for (int d_ = 0; d_ < 2; ++d_) _Pragma("unroll") for (int r = 0; r < 16; ++r) o[d_][r] *= wsf[crow(r, hi)]; } } while (0)
    f32x16 pA0, pA1, pB0, pB1;
    int sl_prev = 0, sl_cur = 0, sl_next = SLOTB;
#define ROT() do { sl_prev = sl_cur; sl_cur = sl_next; sl_next = (sl_next == (NSLOT - 1) * SLOTB) ? 0 : sl_next + SLOTB; } while (0)
    DMA_K(2, 2 * SLOTB);
    WAIT_BAR(3);
    qkt(pA0, pA1, Kbase, qr, negm, r32, hi); asm volatile("s_nop 15\n\ts_nop 7" : "+v"(pA0), "+v"(pA1)); MASKS(pA0, pA1, 0);
    START(pA0, pA1);
    _Pragma("unroll") for (int r = 0; r < 16; ++r) pA1[r] = __builtin_amdgcn_exp2f(pA1[r]);
    WAIT_BAR(0);
    DMA_K(3, 0); DMA_V(1, SLOTB);
    ROT();
    kload8(kf, kp0 + sl_cur);
    WAIT_BAR(2);
    BIASM(pA0, pA1, 0);
    s16x4 vlo[8], vhi[8]; u32x4 pw0, pw1, pw2, pw3;
#define PKW(P, B) cvtpk_s(P[B], P[B + 1])
#define PAF(k) __builtin_bit_cast(bf16x8, pw##k)
#define VFR(i) (bf16x8){vlo[i][0], vlo[i][1], vlo[i][2], vlo[i][3], vhi[i][0], vhi[i][1], vhi[i][2], vhi[i][3]}
#define PIN(x) asm volatile("" : "+v"(x))
#define MX3(a, b, c) __builtin_fmaxf(__builtin_fmaxf((a), (b)), (c))
#define GAPA(MF, A0, A1, A2, A3, W0, W1, PW) do { MF; sacc += A0; sacc += A1; sacc += A2; sacc += A3; PIN(sacc); W0; W1; PIN(PW); SBAR(); } while (0)
#define EX(v) __builtin_amdgcn_exp2f(v)
#define GAPB(MF, X, B) do { MF; X[B] = EX(X[B]); X[B + 1] = EX(X[B + 1]); X[B + 2] = EX(X[B + 2]); X[B + 3] = EX(X[B + 3]); PIN(X); SBAR(); } while (0)
#define VRD(i) do { vlo[i] = vtr(vp_ + (((i) >> 2) * 4096 + ((i) & 3) * 1024)); vhi[i] = vtr(vp_ + (((i) >> 2) * 4096 + ((i) & 3) * 1024 + 512)); } while (0)
#define KRD(G, j) do { if (G) { kload2(kf, kp0 + sl_next, j); SBAR(); } } while (0)
#define STEP(C0, C1, P0, P1, t, GK, GV, GL, MSK) do { SBAR(); \
    const lds_cptr vp_ = vp0 + sl_prev; \
    VRD(0); SBAR(); float sacc = (P0[0] + P0[1]); \
    GAPA(C0 = __builtin_amdgcn_mfma_f32_32x32x16_bf16(kf[0], qr[0], negm, 0, 0, 0), P0[2], P0[3], P0[4], P0[5],     pw0[0] = PKW(P0, 0), pw0[1] = PKW(P0, 2), pw0); \
    VRD(4); SBAR(); GAPA(C1 = __builtin_amdgcn_mfma_f32_32x32x16_bf16(kf[1], qr[0], negm, 0, 0, 0), P0[6], P0[7], P0[8], P0[9],     pw0[2] = PKW(P0, 4), pw0[3] = PKW(P0, 6), pw0); \
    VRD(1); SBAR(); GAPA(C0 = __builtin_amdgcn_mfma_f32_32x32x16_bf16(kf[2], qr[1], C0, 0, 0, 0),   P0[10], P0[11], P0[12], P0[13], pw1[0] = PKW(P0, 8), pw1[1] = PKW(P0, 10), pw1); \
    VRD(5); SBAR(); GAPA(C1 = __builtin_amdgcn_mfma_f32_32x32x16_bf16(kf[3], qr[1], C1, 0, 0, 0),   P0[14], P0[15], P1[0], P1[1],   pw1[2] = PKW(P0, 12), pw1[3] = PKW(P0, 14), pw1); \
    VRD(2); SBAR(); GAPA(C0 = __builtin_amdgcn_mfma_f32_32x32x16_bf16(kf[4], qr[2], C0, 0, 0, 0),   P1[2], P1[3], P1[4], P1[5],     pw2[0] = PKW(P1, 0), pw2[1] = PKW(P1, 2), pw2); \
    VRD(6); SBAR(); GAPA(C1 = __builtin_amdgcn_mfma_f32_32x32x16_bf16(kf[5], qr[2], C1, 0, 0, 0),   P1[6], P1[7], P1[8], P1[9],     pw2[2] = PKW(P1, 4), pw2[3] = PKW(P1, 6), pw2); \
    VRD(3); SBAR(); GAPA(C0 = __builtin_amdgcn_mfma_f32_32x32x16_bf16(kf[6], qr[3], C0, 0, 0, 0),   P1[10], P1[11], P1[12], P1[13], pw3[0] = PKW(P1, 8), pw3[1] = PKW(P1, 10), pw3); \
    asm volatile("s_waitcnt lgkmcnt(13)" ::: "memory"); VRD(7); SBAR(); GAPA(C1 = __builtin_amdgcn_mfma_f32_32x32x16_bf16(kf[7], qr[3], C1, 0, 0, 0),   P1[14], P1[15], 0.f, 0.f,       pw3[2] = PKW(P1, 12), pw3[3] = PKW(P1, 14), pw3); \
    l_reg += sacc; \
    if (GK) { DMA_K((t) + 3, sl_cur); } if (GV) { DMA_V((t) + 1, sl_next); } \
    if (MSK) { MASKS(C0, C1, t); } \
    { float a = MX3(C0[0], C0[1], C1[0]), b = MX3(C0[2], C0[3], C1[1]); a = MX3(a, C1[2], C1[3]); \
      _Pragma("unroll") for (int r = 4; r < 16; r += 4) { a = MX3(a, C0[r], C0[r + 1]); b = MX3(b, C0[r + 2], C0[r + 3]); a = MX3(a, C1[r], C1[r + 1]); b = MX3(b, C1[r + 2], C1[r + 3]); } \
      float rm = __builtin_fmaxf(a, b); { auto rr = __builtin_amdgcn_permlane32_swap(__float_as_uint(rm), __float_as_uint(rm), false, false); rm = __builtin_fmaxf(__uint_as_float(rr[0]), __uint_as_float(rr[1])); } \
      resc = false; \
      if (__builtin_expect(__any(rm > (float)THRL), 0)) { const float dl = __builtin_fmaxf(rm, 0.f); mhat += dl; \
        _Pragma("unroll") for (int r = 0; r < 16; ++r) { C0[r] -= dl; C1[r] -= dl; } \
        const float nv_ = MOFF(t) - mhat; _Pragma("unroll") for (int r = 0; r < 16; ++r) negm[r] = nv_; asm volatile("" : "+v"(negm)); \
        const float f = __builtin_amdgcn_exp2f(-dl); l_reg *= f; { const int l2_ = lane_id(); if (l2_ < 32) wsf[l2_] = f; } resc = true; } } \
    SBAR(); \
    GAPB(o[0] = __builtin_amdgcn_mfma_f32_32x32x16_bf16(PAF(0), VFR(0), o[0], 0, 0, 0), C0, 0); \
    GAPB(o[1] = __builtin_amdgcn_mfma_f32_32x32x16_bf16(PAF(0), VFR(4), o[1], 0, 0, 0), C0, 4); \
    KRD(GL, 0); GAPB(o[0] = __builtin_amdgcn_mfma_f32_32x32x16_bf16(PAF(1), VFR(1), o[0], 0, 0, 0), C0, 8); \
    KRD(GL, 1); GAPB(o[1] = __builtin_amdgcn_mfma_f32_32x32x16_bf16(PAF(1), VFR(5), o[1], 0, 0, 0), C0, 12); \
    KRD(GL, 2); GAPB(o[0] = __builtin_amdgcn_mfma_f32_32x32x16_bf16(PAF(2), VFR(2), o[0], 0, 0, 0), C1, 0); \
    KRD(GL, 3); GAPB(o[1] = __builtin_amdgcn_mfma_f32_32x32x16_bf16(PAF(2), VFR(6), o[1], 0, 0, 0), C1, 4); \
    GAPB(o[0] = __builtin_amdgcn_mfma_f32_32x32x16_bf16(PAF(3), VFR(3), o[0], 0, 0, 0), C1, 8); \
    GAPB(o[1] = __builtin_amdgcn_mfma_f32_32x32x16_bf16(PAF(3), VFR(7), o[1], 0, 0, 0), C1, 12); \
    } while (0)
    int t = 1;
    const int tb = (NT - 9 > 1) ? NT - 9 : 1;
    for (; t < tb; t += 2) {
        STEP(pB0, pB1, pA0, pA1, t, true, true, true, false);         WAIT_BAR(2); RESC(); ROT();
        UPD(t + 1);
        STEP(pA0, pA1, pB0, pB1, t + 1, true, true, true, false);     WAIT_BAR(2); RESC(); ROT();
    }
#define ENDW(tt) do { if ((tt) + 3 < NT) { WAIT_BAR(2); } else if ((tt) + 2 < NT) { WAIT_BAR(1); } else { WAIT_BAR(0); } } while (0)
    for (; t + 1 < NT; t += 2) {
        STEP(pB0, pB1, pA0, pA1, t, (t + 3 < NT), (t + 1 < NT), (t + 1 < NT), true);         ENDW(t);     RESC(); BIASM(pB0, pB1, t); ROT();
        UPD(t + 1);
        STEP(pA0, pA1, pB0, pB1, t + 1, (t + 4 < NT), (t + 2 < NT), (t + 2 < NT), true);     ENDW(t + 1); RESC(); BIASM(pA0, pA1, t + 1); ROT();
    }
    STEP(pB0, pB1, pA0, pA1, NT - 1, false, false, false, true); RESC(); asm volatile("s_waitcnt lgkmcnt(0)" ::: "memory"); BIASM(pB0, pB1, NT - 1);
    { float sacc = pB0[0] + pB0[1]; _Pragma("unroll") for (int r = 2; r < 16; ++r) sacc += pB0[r]; _Pragma("unroll") for (int r = 0; r < 16; ++r) sacc += pB1[r]; l_reg += sacc;
      pw0 = (u32x4){PKW(pB0, 0), PKW(pB0, 2), PKW(pB0, 4), PKW(pB0, 6)}; pw1 = (u32x4){PKW(pB0, 8), PKW(pB0, 10), PKW(pB0, 12), PKW(pB0, 14)}; pw2 = (u32x4){PKW(pB1, 0), PKW(pB1, 2), PKW(pB1, 4), PKW(pB1, 6)}; pw3 = (u32x4){PKW(pB1, 8), PKW(pB1, 10), PKW(pB1, 12), PKW(pB1, 14)};
      SBAR(); pv(o, vb0 + sl_cur, PAF(0), PAF(1), PAF(2), PAF(3)); }
#undef PKW
#undef PAF
#undef VFR
#undef PIN
#undef MX3
#undef GAPA
#undef GAPB
#undef EX
#undef VRD
#undef KRD
#undef STEP
#undef ENDW
    { auto rr = __builtin_amdgcn_permlane32_swap(__float_as_uint(l_reg), __float_as_uint(l_reg), false, false); l_reg = __uint_as_float(rr[0]) + __uint_as_float(rr[1]); }
    if (hi == 0) wsf[32 + r32] = l_reg; asm volatile("s_waitcnt lgkmcnt(0)" ::: "memory");
    float rli[16];
#pragma unroll
    for (int r = 0; r < 16; ++r) rli[r] = __builtin_amdgcn_rcpf(wsf[32 + crow(r, hi)]);
    bf16_t* Ow = O + (rowbase + q0 + wid * QBLK) * DMA_ + h * 64;
    { LAS bf16_t* stg = (LAS bf16_t*)((LAS char*)shm + LDS_OST) + wid * 2048;
#pragma unroll
        for (int r = 0; r < 16; ++r) { const int orow = crow(r, hi);
#pragma unroll
            for (int d0 = 0; d0 < 2; ++d0) stg[orow * 64 + d0 * 32 + r32] = (bf16_t)(pk2(o[d0][r] * rli[r], 0.f) & 0xffffu); }
        asm volatile("s_waitcnt lgkmcnt(0)" ::: "memory");
#pragma unroll
        for (int i = 0; i < 4; ++i) { const int row = i * 8 + (lane >> 3), ch = lane & 7; const u32x4 v = *(const LAS u32x4*)(stg + row * 64 + ch * 8); *(u32x4*)(Ow + (long)row * DMA_ + ch * 8) = v; } }
    asm volatile("s_waitcnt lgkmcnt(0)\n\ts_barrier" ::: "memory");
#undef DMA_K
#undef DMA_V
#undef MASKS
#undef BIASM
#undef UPD
#undef MOFF
#undef START
#undef RESC
#undef ROT
}
#undef SBAR
#undef WAIT_BAR
}

DI void ssm_scan(Frame& F) {
    const float* Hloc = (const float*)(F.ws + WS_HLOC); bf16_t* Assm = (bf16_t*)(F.ws + WS_ASSM); const float* a16 = (const float*)(F.ws + WS_SMALL + 128 * 1024);
    const int gw = F.vcu * 8 + F.wave, NGW = F.G * 8, p = FLANE;
    for (int task = gw; task < 128; task += NGW) {
        const int g = task >> 2, b = task & 3;
        const float ar = a16[(g * 64 + p) * 2], ai = a16[(g * 64 + p) * 2 + 1];
        float sr = 0.f, si = 0.f;
        const float* hl = Hloc + ((size_t)g * 1024 + b * 256) * 128; bf16_t* ao = Assm + ((size_t)g * 1024 + b * 256) * 384 + 256;
        for (int c0 = 0; c0 < 256; c0 += 8) {
            float lr[8], li[8];
#pragma unroll
            for (int j = 0; j < 8; ++j) { lr[j] = hl[(size_t)(c0 + j) * 128 + p]; li[j] = hl[(size_t)(c0 + j) * 128 + 64 + p]; }
#pragma unroll
            for (int j = 0; j < 8; ++j) {
                ao[(size_t)(c0 + j) * 384 + p] = (bf16_t)(pk2(sr, 0.f) & 0xffffu); ao[(size_t)(c0 + j) * 384 + 64 + p] = (bf16_t)(pk2(si, 0.f) & 0xffffu);
                const float nr = ar * sr - ai * si + lr[j], ni = ar * si + ai * sr + li[j]; sr = nr; si = ni; }
        }
    }
}

DI void topk_tokens(Frame& F) {
    const float* scores = (const float*)(F.ws + WS_SCORES); const float* rbias = in_ptr<IN_RBIAS>();
    int* top_idx = (int*)(F.ws + WS_ROUTE); float* top_w = (float*)(F.ws + WS_ROUTE + 512 * 1024); int* rank = (int*)(F.ws + WS_ROUTE + 1024 * 1024);
    unsigned* cnt = (unsigned*)(F.ws + WS_CTL) + CW_CNT;
    LAS unsigned* lcnt = (LAS unsigned*)F.lds;
    LAS int* le = (LAS int*)(F.lds + 1024);
    LAS unsigned* lr = (LAS unsigned*)(F.lds + 3072);
    LAS float* lw = (LAS float*)(F.lds + 5120);
    const int l = FLANE, tid = FTID;
    const f32x4 rb = *(const f32x4*)(rbias + 4 * l);
    for (int blk = F.vcu; blk < M / 64; blk += F.G) {
        __syncthreads();
        if (tid < 256) lcnt[tid] = 0u;
        __syncthreads();
#pragma unroll 1
        for (int tt = 0; tt < 8; ++tt) {
            const int tl = F.wave * 8 + tt, t = blk * 64 + tl;
            const f32x4 sc = *(const f32x4*)(scores + (size_t)t * 256 + 4 * l);
            float v[4] = {sc.x + rb.x, sc.y + rb.y, sc.z + rb.z, sc.w + rb.w};
            float m1 = fmaxf(v[0], v[1]), m2 = fminf(v[0], v[1]);
            { const float a = fmaxf(v[2], v[3]), c = fminf(v[2], v[3]); const float n1 = fmaxf(m1, a), n2 = fmaxf(fminf(m1, a), fmaxf(m2, c)); m1 = n1; m2 = n2; }
#pragma unroll
            for (int o = 1; o < 8; o <<= 1) { const float o1 = __shfl_xor(m1, o), o2 = __shfl_xor(m2, o); const float n1 = fmaxf(m1, o1), n2 = fmaxf(fminf(m1, o1), fmaxf(m2, o2)); m1 = n1; m2 = n2; }
            const float gs = m1 + m2; const int myg = l >> 3; int higher = 0;
#pragma unroll
            for (int j = 0; j < 8; ++j) { const float og = __shfl(gs, 8 * j); higher += (og > gs || (og == gs && j < myg)) ? 1 : 0; }
            if (higher >= 4) { v[0] = -1e30f; v[1] = -1e30f; v[2] = -1e30f; v[3] = -1e30f; }
            int my_e = 0; float my_s = 0.f, tot = 0.f;
#pragma unroll
            for (int k = 0; k < 8; ++k) {
                float bv = v[0]; int bi = 4 * l;
                if (v[1] > bv) { bv = v[1]; bi = 4 * l + 1; } if (v[2] > bv) { bv = v[2]; bi = 4 * l + 2; } if (v[3] > bv) { bv = v[3]; bi = 4 * l + 3; }
#pragma unroll
                for (int o = 1; o < 64; o <<= 1) { const float ov = __shfl_xor(bv, o); const int oi = __shfl_xor(bi, o); if (ov > bv || (ov == bv && oi < bi)) { bv = ov; bi = oi; } }
                const float mys = (bi == 4 * l) ? sc.x : (bi == 4 * l + 1) ? sc.y : (bi == 4 * l + 2) ? sc.z : sc.w;
                const float ssel = __shfl(mys, bi >> 2);
                if (bi == 4 * l) v[0] = -3e38f; if (bi == 4 * l + 1) v[1] = -3e38f; if (bi == 4 * l + 2) v[2] = -3e38f; if (bi == 4 * l + 3) v[3] = -3e38f;
                tot += ssel; if (l == k) { my_e = bi; my_s = ssel; }
            }
            if (l < 8) { le[tl * 8 + l] = my_e; lw[tl * 8 + l] = my_s / tot * 2.5f; lr[tl * 8 + l] = __hip_atomic_fetch_add(lcnt + my_e, 1u, __ATOMIC_RELAXED, __HIP_MEMORY_SCOPE_WORKGROUP); }
        }
        __syncthreads();
        if (tid < 256) { const unsigned c = lcnt[tid]; unsigned base = 0u; if (c) base = atomicAdd(cnt + tid, c); lcnt[tid] = base; }
        __syncthreads();
        { const int e = le[tid]; const size_t gi = (size_t)blk * 512 + tid; top_idx[gi] = e; top_w[gi] = lw[tid]; rank[gi] = (int)(lr[tid] + lcnt[e]); }
    }
    __syncthreads();
}
DI int build_tiles(Frame& F) {
    const unsigned* cnt = (const unsigned*)(F.ws + WS_CTL) + CW_CNT;
    LAS unsigned* sa = (LAS unsigned*)(F.lds + SCAN_OFF); LAS unsigned* sb = sa + 256; LAS unsigned short* tile_e = (LAS unsigned short*)(F.lds + TILEE_OFF);
    LAS unsigned* misc = (LAS unsigned*)(F.lds + MISC_OFF);
    const int tid = FTID; unsigned nt = 0, cn = 0;
    __syncthreads();
    if (tid < 256) { cn = __hip_atomic_load(cnt + tid, __ATOMIC_RELAXED, __HIP_MEMORY_SCOPE_AGENT); nt = (cn + 255u) >> 8; sa[tid] = nt; }
    __syncthreads();
    LAS unsigned* src = sa; LAS unsigned* dst = sb;
    for (int o = 1; o < 256; o <<= 1) { if (tid < 256) { unsigned v = src[tid]; if (tid >= o) v += src[tid - o]; dst[tid] = v; } __syncthreads(); LAS unsigned* tmp = src; src = dst; dst = tmp; }
    if (tid < 256) { const unsigned incl = src[tid], first = incl - nt; for (unsigned k = 0; k < nt; ++k) if (first + k < MAXTILES) { tile_e[first + k] = (unsigned short)tid; const unsigned rem = cn - 256u * k; tile_e[MAXTILES + first + k] = (unsigned short)(rem > 256u ? 256u : rem); } dst[tid] = first; if (tid == 255) misc[16] = incl; }
    __syncthreads();
    if (tid < 256) sa[tid] = dst[tid];
    __syncthreads();
    int ntl = (int)misc[16]; if (ntl > MAXTILES) ntl = MAXTILES; return ntl;
}
DI void route_scatter(Frame& F) {
    const int* top_idx = (const int*)(F.ws + WS_ROUTE); const float* top_w = (const float*)(F.ws + WS_ROUTE + 512 * 1024); const int* rank = (const int*)(F.ws + WS_ROUTE + 1024 * 1024);
    int* rowoff = (int*)(F.ws + WS_ROUTE + 2 * MiB); float* roww = (float*)(F.ws + WS_ROUTE + 3 * MiB); int* dest = (int*)(F.ws + WS_ROUTE + 4 * MiB);
    (void)build_tiles(F);
    LAS unsigned* first = (LAS unsigned*)(F.lds + SCAN_OFF);
    const int gt = F.vcu * 512 + FTID, NT = F.G * 512;
    for (int i = gt; i < M * 8; i += NT) { const int e = top_idx[i]; const int pos = (int)first[e] * 256 + rank[i];
        if (pos < MAXROWS) { rowoff[pos] = (i >> 3) * (DM * 2); roww[pos] = top_w[i]; dest[pos] = i; } }
}
DI void route_clear(Frame& F) {
    int* rowoff = (int*)(F.ws + WS_ROUTE + 2 * MiB); float* roww = (float*)(F.ws + WS_ROUTE + 3 * MiB); int* dest = (int*)(F.ws + WS_ROUTE + 4 * MiB);
    const int gt = F.vcu * 512 + FTID, NT = F.G * 512;
    for (int i = gt; i < MAXROWS; i += NT) { rowoff[i] = 0; roww[i] = 0.f; dest[i] = -1; }
}
DI void combine(Frame& F) {
    const float* mod = (const float*)(F.ws + WS_SMALL); const bf16_t* ysh = (const bf16_t*)(F.ws + WS_YSH); const bf16_t* Y = (const bf16_t*)(F.ws + WS_Y);
    const int gw = F.vcu * 8 + F.wave, NGW = F.G * 8;
    for (int t = gw; t < M; t += NGW) { const int b = t / SEQ;
#pragma unroll
        for (int hf = 0; hf < 2; ++hf) { const int col = hf * 512 + FLANE * 8;
            const u32x4 s = *(const u32x4*)(ysh + (size_t)t * 1024 + col);
            float a[8] = {bflo(s.x), bfhi(s.x), bflo(s.y), bfhi(s.y), bflo(s.z), bfhi(s.z), bflo(s.w), bfhi(s.w)};
            u32x4 yv[8];
#pragma unroll
            for (int k = 0; k < 8; ++k) yv[k] = *(const u32x4*)(Y + ((size_t)t * 8 + k) * 1024 + col);
#pragma unroll
            for (int k = 0; k < 8; ++k) { a[0] += bflo(yv[k].x); a[1] += bfhi(yv[k].x); a[2] += bflo(yv[k].y); a[3] += bfhi(yv[k].y); a[4] += bflo(yv[k].z); a[5] += bfhi(yv[k].z); a[6] += bflo(yv[k].w); a[7] += bfhi(yv[k].w); }
            float* o = F.out + (size_t)t * 1024 + col; const float* g2 = mod + b * 6144 + 5120 + col;
            const f32x4 x0 = *(const f32x4*)o, x1 = *(const f32x4*)(o + 4), g0 = *(const f32x4*)g2, g1 = *(const f32x4*)(g2 + 4);
            *(f32x4*)o = x0 + g0 * (f32x4){a[0], a[1], a[2], a[3]}; *(f32x4*)(o + 4) = x1 + g1 * (f32x4){a[4], a[5], a[6], a[7]}; }
    }
}

constexpr int NPHASE = 17;
__global__ void __launch_bounds__(512, 2) mk_fwd(Args args) {
    extern __shared__ __attribute__((aligned(16))) unsigned char lds_raw[];
    Frame F;
    F.lds = (LAS unsigned char*)lds_raw; F.wave = __builtin_amdgcn_readfirstlane((int)threadIdx.x >> 6);
    F.G = gridDim.x; { const int bx = blockIdx.x; F.vcu = (F.G % 8 == 0) ? (bx % 8) * (F.G / 8) + bx / 8 : bx; }
    F.in.dummy = 0; F.out = args.out; F.ws = args.ws;
    unsigned char* ws = args.ws;
    volatile LAS unsigned* MISC = (volatile LAS unsigned*)(F.lds + MISC_OFF);
    LAS unsigned* gtab = (LAS unsigned*)(F.lds + GTAB_OFF);
    for (int u = FTID; u < 64; u += 512) MISC[u] = 0u;
    __syncthreads();
    unsigned* ctl = (unsigned*)(ws + WS_CTL);
    XcdBarrier bar; bar.bar = ctl + CW_BAR; bar.x = 0; bar.st = nullptr; bar.wave = F.wave;
    if (!MK_PER_PHASE) bar = xcd_barrier_post(ctl + CW_BAR, MISC + 8, F.wave);
    const int lo = args.ph_lo, hi = args.ph_hi;
#ifndef ONLY_PHASE
#define ONLY_PHASE -1
#endif
#define IN(k) ((ONLY_PHASE < 0 || ONLY_PHASE == (k)) && lo <= (k) && (k) < hi)
#ifndef PROBE_PHASE
#define PROBE_PHASE -1
#endif
#ifndef PROBE_AMP
#define PROBE_AMP 4
#endif
    unsigned long long pr_t0 = 0, pr_dt = 0;
#define SEAM(k) do { if (IN(k) && IN((k) + 1)) xcd_barrier(bar); \
    if (PROBE_PHASE >= 0) { if ((k) + 1 == PROBE_PHASE) pr_t0 = __builtin_amdgcn_s_memrealtime(); if ((k) == PROBE_PHASE) pr_dt = __builtin_amdgcn_s_memrealtime() - pr_t0; } } while (0)
    const int G = F.G, bx = (int)blockIdx.x;
    float* mod = (float*)(ws + WS_SMALL);

    if (PROBE_PHASE == 0) pr_t0 = __builtin_amdgcn_s_memrealtime();
    if (IN(0)) {
        if (bx < 96) p0_adaln(F, bx); else if (bx < 128) p0_ssm(F, bx - 96);
        conv_items(F, 0, I_SMALL);
    }
    SEAM(0);
    if (IN(1)) norm_mod_rows(F, in_ptr<IN_X>(), in_ptr<IN_LN1G>(), 0, 1024, (bf16_t*)(ws + WS_H));
    SEAM(1);
    if (IN(2)) {
        pg8::Gemm g{DM, DM, DM}; DenseSched S; S.init(M, INW, G, bx, ws + WS_H, DM, ws + WS_WIN, DM);
        EpiInProj E{(bf16_t*)(ws + WS_Q), (bf16_t*)(ws + WS_K), (bf16_t*)(ws + WS_V), (bf16_t*)(ws + WS_ASSM), (bf16_t*)(ws + WS_SGA), (bf16_t*)(ws + WS_SGS), (float*)(ctl + CW_KMEAN), in_ptr<IN_QG>(), in_ptr<IN_KG>()};
        pg8::gemm_phase<EpiInProj, DenseSched, true, false>(F.lds, gtab, F.wave, g, S, E);
    }
    SEAM(2);
    if (IN(3)) {
#pragma unroll 1
        for (int ui = F.vcu * 2; ui < 512; ui += 2 * G) {
#pragma unroll 1
            for (int k2 = 0; k2 < 2; ++k2) { const int pi = ui >> 1, bh = pi >> 3, s = pi & 7, qb = k2 ? s : 15 - s;
                att::attn_unit<8>(F.wave, bh >> 3, bh & 7, qb, (const bf16_t*)(ws + WS_Q), (const bf16_t*)(ws + WS_K), (const bf16_t*)(ws + WS_V), (bf16_t*)(ws + WS_Q), (char*)lds_raw, (const float*)(ctl + CW_KMEAN), in_ptr<IN_RELB>()); } }
        __syncthreads();
        pg8::Gemm g{384, 256, 256}; SsmSched S{G, F.vcu, (const char*)(ws + WS_ASSM), (const char*)(ws + WS_ET), (size_t)256 * 256 * 2};
        EpiS1 E{(float*)(ws + WS_HLOC)};
        pg8::gemm_phase<EpiS1, SsmSched, true, false>(F.lds, gtab, F.wave, g, S, E);
    }
    SEAM(3);
    if (IN(4)) ssm_scan(F);
    SEAM(4);
    if (IN(5)) {
        pg8::Gemm g{384, 384, 384}; SsmSched S{G, F.vcu, (const char*)(ws + WS_ASSM), (const char*)(ws + WS_TF), (size_t)256 * 384 * 2};
        EpiS2 E{(const bf16_t*)(ws + WS_ASSM), in_ptr<IN_SSMD>(), (bf16_t*)(ws + WS_GBUF)};
        pg8::gemm_phase<EpiS2, SsmSched, true, false>(F.lds, gtab, F.wave, g, S, E);
    }
    SEAM(5);
    if (IN(6)) {
        pg8::Gemm g{512, 512, 512}; GluUpSched S{G, F.vcu, (const char*)(ws + WS_GBUF), (const char*)(ws + WS_WGLU), (const char*)(ws + WS_Q), (const char*)(ws + WS_WUPA)};
        EpiGluUp E{(const bf16_t*)(ws + WS_GBUF), in_ptr<IN_BGLU>(), (bf16_t*)(ws + WS_SOUT), (const bf16_t*)(ws + WS_SGA), (bf16_t*)(ws + WS_P1)};
        pg8::gemm_phase<EpiGluUp, GluUpSched, true, false>(F.lds, gtab, F.wave, g, S, E);
    }
    SEAM(6);
    if (IN(7)) {
        pg8::Gemm g{512, 512, 512}; DenseSched S; S.init(M, DM, G, bx, ws + WS_SOUT, 512, ws + WS_WUPS, 512);
        EpiUp2 E{(const bf16_t*)(ws + WS_P1), (const bf16_t*)(ws + WS_SGS), (bf16_t*)(ws + WS_MIX)};
        pg8::gemm_phase<EpiUp2, DenseSched, true, false>(F.lds, gtab, F.wave, g, S, E);
    }
    SEAM(7);
    if (IN(8)) {
        pg8::Gemm g{DM, DM, DM}; DenseSched S; S.init(M, DM, G, bx, ws + WS_MIX, DM, ws + WS_WOUT, DM);
        EpiOut E{in_ptr<IN_X>(), mod, F.out};
        pg8::gemm_phase<EpiOut, DenseSched, true, false>(F.lds, gtab, F.wave, g, S, E);
    }
    SEAM(8);
    if (IN(9)) norm_mod_rows(F, F.out, in_ptr<IN_LN2G>(), 3072, 4096, (bf16_t*)(ws + WS_H));
    SEAM(9);
    if (IN(10)) {
        pg8::Gemm g{DM, DM, DM}; DenseSched S; S.init(M, 768, G, bx, ws + WS_H, DM, ws + WS_WRSH, DM);
        EpiRsh E{(float*)(ws + WS_SCORES), (bf16_t*)(ws + WS_HS)};
        pg8::gemm_phase<EpiRsh, DenseSched, true, false>(F.lds, gtab, F.wave, g, S, E);
    }
    SEAM(10);
    if (IN(11)) {
        route_clear(F);
        topk_tokens(F);
        __syncthreads();
        pg8::Gemm g{ED, ED, ED}; DenseSched S; S.init(M, DM, G, bx, ws + WS_HS, ED, ws + WS_WSHD, ED);
        EpiBf16 E{(bf16_t*)(ws + WS_YSH), 1024};
        pg8::gemm_phase<EpiBf16, DenseSched, true, false>(F.lds, gtab, F.wave, g, S, E);
    }
    SEAM(11);
    if (IN(12)) { route_scatter(F); conv_items(F, I_SMALL, I_SMALL + I_EG + I_EU); }
    SEAM(12);
    if (IN(13)) {
        const int ntl = build_tiles(F);
        pg8::Gemm g{DM, DM, DM};
        MoeSched S{G, F.vcu, 2, ntl, (const LAS unsigned short*)(F.lds + TILEE_OFF), (const char*)(ws + WS_H), (const char*)(ws + WS_WEGU), 0, (size_t)512 * DM * 2, (size_t)256 * DM * 2, (const int*)(ws + WS_ROUTE + 2 * MiB)};
        EpiMoe1 E{(bf16_t*)(ws + WS_HSORT)};
        pg8::gemm_phase<EpiMoe1, MoeSched, true, true>(F.lds, gtab, F.wave, g, S, E);
        conv_items(F, I_SMALL + I_EG + I_EU, NITEMS);
    }
    SEAM(13);
    if (IN(14)) {
        const int ntl = build_tiles(F);
        pg8::Gemm g{ED, ED, ED};
        MoeSched S{G, F.vcu, 4, ntl, (const LAS unsigned short*)(F.lds + TILEE_OFF), (const char*)(ws + WS_HSORT), (const char*)(ws + WS_WED), (size_t)256 * ED * 2, (size_t)DM * ED * 2, (size_t)256 * ED * 2, nullptr};
        EpiMoe2 E{(const int*)(ws + WS_ROUTE + 4 * MiB), (const float*)(ws + WS_ROUTE + 3 * MiB), (bf16_t*)(ws + WS_Y)};
        pg8::gemm_phase<EpiMoe2, MoeSched, true, false>(F.lds, gtab, F.wave, g, S, E);
    }
    SEAM(14);
    if (IN(15)) combine(F);
    if (PROBE_PHASE >= 0) { if (PROBE_PHASE == 15) { asm volatile("s_waitcnt vmcnt(0)" ::: "memory"); pr_dt = __builtin_amdgcn_s_memrealtime() - pr_t0; }
        if (blockIdx.x == 0) { const unsigned long long te = __builtin_amdgcn_s_memrealtime(); while (__builtin_amdgcn_s_memrealtime() - te < (unsigned long long)PROBE_AMP * pr_dt) __builtin_amdgcn_s_sleep(8); } }
#undef IN
#undef SEAM
}

extern "C" void kernel_launch(void* const* d_in, const int* in_sizes, int n_in, void* d_out, int out_size, void* d_ws, size_t ws_size, hipStream_t stream) {
    static int grid = 0;
    if (grid == 0) {
        if (n_in != 31 || out_size != M * DM || ws_size < WS_END) { fprintf(stderr, "kernel_launch: unexpected shapes (n_in %d out %d ws %zu)\n", n_in, out_size, ws_size); grid = -1; return; }
        int dev = 0, cus = 0;
        if (hipGetDevice(&dev) != hipSuccess || hipDeviceGetAttribute(&cus, hipDeviceAttributeMultiprocessorCount, dev) != hipSuccess) { grid = -1; return; }
        if (hipFuncSetAttribute((const void*)mk_fwd, hipFuncAttributeMaxDynamicSharedMemorySize, LDS_BYTES) != hipSuccess) { fprintf(stderr, "kernel_launch: hipFuncSetAttribute failed\n"); grid = -1; return; }
        int per_cu = 0;
        if (hipOccupancyMaxActiveBlocksPerMultiprocessor(&per_cu, (const void*)mk_fwd, 512, LDS_BYTES) != hipSuccess || per_cu < 1) fprintf(stderr, "kernel_launch: occupancy query says %d\n", per_cu);
        (void)hipGetLastError();
        grid = cus;
    }
    if (grid < 0) return;
    (void)hipMemsetAsync((char*)d_ws + WS_CTL, 0, CTL_ZERO_BYTES, stream);
    Args a{};
    for (int i = 0; i < 31; ++i) a.in[i] = (const float*)d_in[i];
    a.out = (float*)d_out; a.ws = (unsigned char*)d_ws;
#if MK_PER_PHASE
    for (int p = 0; p < NPHASE; ++p) { a.ph_lo = p; a.ph_hi = p + 1; hipLaunchKernelGGL(mk_fwd, dim3(grid), dim3(512), LDS_BYTES, stream, a); }
#else
    a.ph_lo = 0; a.ph_hi = NPHASE;
    hipLaunchKernelGGL(mk_fwd, dim3(grid), dim3(512), LDS_BYTES, stream, a);
#endif
}
```

```cpp
#include <hip/hip_runtime.h>
#include <cstdio>
#include <cstdint>

#ifndef MK_PER_PHASE
#define MK_PER_PHASE 0
#endif

#define LAS __attribute__((address_space(3)))
#define GAS __attribute__((address_space(1)))
typedef unsigned short bf16_t;
typedef short bf16x8 __attribute__((ext_vector_type(8)));
typedef short s16x4 __attribute__((ext_vector_type(4)));
typedef float f32x2 __attribute__((ext_vector_type(2)));
typedef float f32x4 __attribute__((ext_vector_type(4)));
typedef float f32x16 __attribute__((ext_vector_type(16)));
typedef unsigned u32x2 __attribute__((ext_vector_type(2)));
typedef unsigned u32x4 __attribute__((ext_vector_type(4)));
typedef __bf16 bf16x2_t __attribute__((ext_vector_type(2)));

#define DI __device__ __forceinline__
DI unsigned pk2(float lo, float hi) { f32x2 v = {lo, hi}; bf16x2_t b = __builtin_convertvector(v, bf16x2_t); return __builtin_bit_cast(unsigned, b); }
DI float bflo(unsigned w) { return __uint_as_float(w << 16); }
DI float bfhi(unsigned w) { return __uint_as_float(w & 0xffff0000u); }
DI float sigmoidf_(float x) { return 1.0f / (1.0f + __expf(-x)); }
DI float siluf_(float x) { return x / (1.0f + __expf(-x)); }
DI float gelu_tanh(float y) { const float z = 0.7978845608028654f * (y + 0.044715f * y * y * y); const float t = 1.0f - 2.0f / (__expf(2.0f * z) + 1.0f); return 0.5f * y * (1.0f + t); }

constexpr int NB = 4, SEQ = 4096, DM = 1024, M = NB * SEQ;
constexpr int NH = 8, HD = 64, AW = 512, SW = 512, INW = 4096;
constexpr int NE = 256, ED = 256, TOPK = 8;
constexpr int NG = 32, GC = 16, NS = 64, CH = 16, NCH = SEQ / CH;
constexpr int MAXTILES = 768, MAXROWS = MAXTILES * 256;
constexpr float EPSF = 1e-6f;
constexpr float LOG2E = 1.4426950408889634f;
constexpr float QC2 = 0.125f * LOG2E;

constexpr size_t MiB = 1u << 20;
constexpr size_t WS_CTL = 0, CTL_ZERO_BYTES = 1 * MiB;
constexpr size_t WS_SMALL = 1 * MiB;
constexpr size_t WS_WIN = 4 * MiB, WS_WGLU = 12 * MiB, WS_WUPA = 13 * MiB, WS_WUPS = 14 * MiB, WS_WOUT = 15 * MiB, WS_WRSH = 17 * MiB, WS_WSHD = 19 * MiB;
constexpr size_t WS_TF = 20 * MiB, WS_ET = 26 * MiB;
constexpr size_t WS_WEGU = 32 * MiB, WS_WED = 288 * MiB;
constexpr size_t WS_H = 416 * MiB;
constexpr size_t WS_Q = 448 * MiB, WS_K = 464 * MiB, WS_V = 480 * MiB;
constexpr size_t WS_ASSM = 496 * MiB, WS_HLOC = 520 * MiB;
constexpr size_t WS_GBUF = 536 * MiB, WS_SOUT = 552 * MiB;
constexpr size_t WS_SGA = 568 * MiB, WS_SGS = 600 * MiB;
constexpr size_t WS_P1 = 632 * MiB, WS_MIX = 664 * MiB;
constexpr size_t WS_SCORES = 696 * MiB, WS_HS = 712 * MiB, WS_YSH = 720 * MiB;
constexpr size_t WS_ROUTE = 752 * MiB;
constexpr size_t WS_HSORT = 760 * MiB;
constexpr size_t WS_Y = 416 * MiB;
constexpr size_t WS_END = 856 * MiB;
constexpr int CW_BAR = 4096;
constexpr int CW_CNT = 16384;
constexpr int CW_KMEAN = 32768;

constexpr int RING_BYTES = 131072;
constexpr int GTAB_OFF = RING_BYTES;
constexpr int TILEE_OFF = GTAB_OFF + 2048;
constexpr int SCAN_OFF = TILEE_OFF + 3072;
constexpr int MISC_OFF = SCAN_OFF + 2048;
constexpr int LDS_BYTES = 147456;
static_assert(MISC_OFF + 256 <= LDS_BYTES, "LDS map");

namespace pg8 {
constexpr int BM = 256, BK = 64, HALF = 128, HTB = HALF * BK * 2, STAGE_BYTES = 8 * HTB, NXCD = 8, WGM = 8;
__host__ __device__ __forceinline__ int lds_byte(int r, int c) { const int st = (r >> 4) * 2 + (c >> 5), rr = r & 15, cc = c & 31, ob = rr * 64 + cc * 2; return st * 1024 + (ob ^ (((ob >> 9) & 1) << 5)); }
__host__ __device__ __forceinline__ void stage_rc(int b, int& R, int& C) { const int st = b / 1024, sb = b % 1024, swz = sb ^ (((sb >> 9) & 1) << 5); R = (st >> 1) * 16 + swz / 64; C = (st & 1) * 32 + (swz % 64) / 2; }
__host__ __device__ __forceinline__ int perm32(int rho) { const int n = rho >> 4, i = rho & 15; return 8 * (i >> 2) + 4 * n + (i & 3); }

struct Unit { const char* A; const char* B; const int* rowtab; int pm, pn, aux, half; };
struct Gemm { int lda, ldb, K; };

struct StaticOrder {
    int nM, nN, nwg, G, c;
    __device__ void init(int M_, int N_, int G_, int c_) { nM = M_ / BM; nN = N_ / BM; nwg = nM * nN; G = G_; c = c_; }
    __device__ bool next(int i, int& pm, int& pn) const {
        const long L = (long)i * G + c; if (L >= nwg) return false;
        int wgid = (int)L; { const int q = nwg / NXCD, r = nwg % NXCD, xcd = wgid % NXCD, off = wgid / NXCD; wgid = (xcd < r ? xcd * (q + 1) : r * (q + 1) + (xcd - r) * q) + off; }
        const int nig = WGM * nN, gid = wgid / nig, fm = gid * WGM, gsz = (nM - fm) < WGM ? (nM - fm) : WGM;
        pm = fm + ((wgid % nig) % gsz); pn = (wgid % nig) / gsz; return true;
    }
};

template <class Epi, class Sched, bool ALIGN_EPI, bool GATHER>
__device__ __forceinline__ void gemm_phase(LAS unsigned char* lds, LAS unsigned* gtab, const int wid, const Gemm g, const Sched& S, const Epi& E) {
    const int lane = (int)__builtin_amdgcn_mbcnt_hi(~0u, __builtin_amdgcn_mbcnt_lo(~0u, 0u)), tid = wid * 64 + lane, wr = wid >> 2, wc = wid & 3, fr = lane & 15, fq = lane >> 4;
    const int K = g.K, nt = K / BK;
    unsigned voffA[2], voffB[2]; int gR[2];
#pragma unroll
    for (int i = 0; i < 2; ++i) { int R, C; stage_rc(tid * 16 + i * 8192, R, C); const int Rb = Epi::PERM ? ((R & ~31) + perm32(R & 31)) : R;
        voffA[i] = GATHER ? (unsigned)(C * 2) : (unsigned)(R * g.lda + C) * 2u; voffB[i] = (unsigned)(Rb * g.ldb + C) * 2u; gR[i] = R; }
    const size_t kstep = (size_t)(BK * 2);
    const size_t hstepA = (size_t)HALF * g.lda * 2, hstepB = (size_t)HALF * g.ldb * 2;
    const unsigned ldsw = (unsigned)wid * 1024u;
    const int aoff = lds_byte(wr * 64 + fr, fq * 8), boff = lds_byte(wc * 32 + fr, fq * 8);
#define PG8_SA(b, h) (((b) * 2 + (h)) * HTB)
#define PG8_SB(b, h) ((4 + (b) * 2 + (h)) * HTB)
#define PG8_STAGEB(bufoff, gbase) do { _Pragma("unroll") for (int _i = 0; _i < 2; ++_i) \
        __builtin_amdgcn_global_load_lds((const unsigned*)((const char*)(gbase) + voffB[_i]), (LAS unsigned*)(lds + (bufoff) + ldsw + _i * 8192), 16, 0, 0); } while (0)
#define PG8_STAGEA(bufoff, gbase, par, half) do { _Pragma("unroll") for (int _i = 0; _i < 2; ++_i) { \
        const char* _src = GATHER ? ((const char*)(gbase) + gtab[(par) * 256 + (half) * 128 + gR[_i]] + voffA[_i]) : ((const char*)(gbase) + (size_t)(half) * hstepA + voffA[_i]); \
        __builtin_amdgcn_global_load_lds((const unsigned*)_src, (LAS unsigned*)(lds + (bufoff) + ldsw + _i * 8192), 16, 0, 0); } } while (0)
#define PG8_TABLOAD(par, un) do { __builtin_amdgcn_global_load_lds((const unsigned*)((un).rowtab + 64 * (wid & 3) + lane), (LAS unsigned*)(gtab + (par) * 256 + 64 * (wid & 3)), 4, 0, 0); } while (0)
#define PG8_LDA(dst, b, h) do { _Pragma("unroll") for (int m = 0; m < 4; ++m) _Pragma("unroll") for (int k = 0; k < 2; ++k) dst[m][k] = *(const LAS bf16x8*)(lds + PG8_SA(b, h) + aoff + m * 2048 + k * 1024); } while (0)
#define PG8_LDB(dst, b, h) do { _Pragma("unroll") for (int n = 0; n < 2; ++n) _Pragma("unroll") for (int k = 0; k < 2; ++k) dst[n][k] = *(const LAS bf16x8*)(lds + PG8_SB(b, h) + boff + n * 2048 + k * 1024); } while (0)
#define PG8_MMA(ai, bj, At, Bt) do { __builtin_amdgcn_s_setprio(1); _Pragma("unroll") for (int m = 0; m < 4; ++m) _Pragma("unroll") for (int n = 0; n < 2; ++n) _Pragma("unroll") for (int k = 0; k < 2; ++k) \
        acc[ai][bj][m][n] = __builtin_amdgcn_mfma_f32_16x16x32_bf16(Bt[n][k], At[m][k], acc[ai][bj][m][n], 0, 0, 0); __builtin_amdgcn_s_setprio(0); } while (0)
#define PG8_WAIT_V(n) asm volatile("s_waitcnt vmcnt(" #n ")" ::: "memory")
#define PG8_WAIT_L(n) asm volatile("s_waitcnt lgkmcnt(" #n ")" ::: "memory")
#define PG8_BAR __builtin_amdgcn_s_barrier()
#define PG8_SCHED __builtin_amdgcn_sched_barrier(0)
    Unit cur, nxt; int ui = 0;
    if (!S.next(0, cur)) return;
    f32x4 acc[2][2][4][2];
#pragma unroll
    for (int a = 0; a < 2; ++a)
#pragma unroll
        for (int b = 0; b < 2; ++b)
#pragma unroll
            for (int m = 0; m < 4; ++m)
#pragma unroll
                for (int n = 0; n < 2; ++n) acc[a][b][m][n] = (f32x4){0.f, 0.f, 0.f, 0.f};
    bf16x8 At[4][2], B0[2][2], B1[2][2];
    const char* cA = cur.A; const char* cB = cur.B;
    if constexpr (GATHER) { PG8_TABLOAD(0, cur); PG8_WAIT_V(0); PG8_BAR; }
    PG8_STAGEB(PG8_SB(0, 0), cB); PG8_STAGEB(PG8_SB(0, 1), cB + hstepB); PG8_STAGEA(PG8_SA(0, 0), cA, 0, 0); PG8_STAGEA(PG8_SA(0, 1), cA, 0, 1);
    if (wr == 1) PG8_BAR;
    PG8_WAIT_V(2); PG8_BAR;
    PG8_STAGEB(PG8_SB(1, 0), cB + kstep); PG8_STAGEA(PG8_SA(1, 0), cA + kstep, 0, 0); PG8_STAGEB(PG8_SB(1, 1), cB + hstepB + kstep);
    PG8_WAIT_V(6); PG8_BAR;
    for (;;) {
        const bool has_next = S.next(ui + 1, nxt);
        const char* nA = has_next ? nxt.A : cA; const char* nB = has_next ? nxt.B : cB;
        const int pc = ui & 1, pnx = has_next ? (pc ^ 1) : pc;
        if constexpr (GATHER) { if (has_next) PG8_TABLOAD(pc ^ 1, nxt); }
#pragma unroll 1
        for (int t = 0; t < nt; t += 2) {
            const bool last = (t == nt - 2);
            const char* a1 = cA + (size_t)(t + 1) * kstep;
            const char* a2 = last ? nA : cA + (size_t)(t + 2) * kstep; const char* b2 = last ? nB : cB + (size_t)(t + 2) * kstep;
            const char* a3 = a2 + kstep; const char* b3 = b2 + kstep;
            const int p2 = last ? pnx : pc;
            PG8_LDB(B0, 0, 0); PG8_LDB(B1, 0, 1); PG8_SCHED; PG8_LDA(At, 0, 0); PG8_STAGEA(PG8_SA(1, 1), a1, pc, 1);
            PG8_WAIT_V(8); PG8_WAIT_L(0); PG8_BAR; PG8_MMA(0, 0, At, B0); PG8_MMA(0, 1, At, B1); PG8_BAR; PG8_SCHED;
            PG8_LDA(At, 0, 1); PG8_STAGEB(PG8_SB(0, 0), b2); PG8_STAGEB(PG8_SB(0, 1), b2 + hstepB); PG8_STAGEA(PG8_SA(0, 0), a2, p2, 0);
            PG8_WAIT_V(8); PG8_WAIT_L(0); PG8_BAR; if (!cur.half) { PG8_MMA(1, 0, At, B0); PG8_MMA(1, 1, At, B1); } PG8_BAR; PG8_SCHED;
            PG8_LDB(B0, 1, 0); PG8_LDB(B1, 1, 1); PG8_SCHED; PG8_LDA(At, 1, 0); PG8_STAGEA(PG8_SA(0, 1), a2, p2, 1);
            PG8_WAIT_V(8); PG8_WAIT_L(0); PG8_BAR; PG8_MMA(0, 0, At, B0); PG8_MMA(0, 1, At, B1); PG8_BAR; PG8_SCHED;
            PG8_LDA(At, 1, 1); PG8_STAGEB(PG8_SB(1, 0), b3); PG8_STAGEB(PG8_SB(1, 1), b3 + hstepB); PG8_STAGEA(PG8_SA(1, 0), a3, p2, 0);
            PG8_WAIT_V(8); PG8_WAIT_L(0); PG8_BAR; if (!cur.half) { PG8_MMA(1, 0, At, B0); PG8_MMA(1, 1, At, B1); } PG8_BAR; PG8_SCHED;
        }
        if constexpr (ALIGN_EPI) { if (wr == 0) PG8_BAR; }
        { int fr_ = fr, fq_ = fq; asm volatile("" : "+v"(fr_), "+v"(fq_)); E(acc, cur, wr, wc, fr_, fq_); }
        if (!has_next) break;
#pragma unroll
        for (int a = 0; a < 2; ++a)
#pragma unroll
            for (int b = 0; b < 2; ++b)
#pragma unroll
                for (int m = 0; m < 4; ++m)
#pragma unroll
                    for (int n = 0; n < 2; ++n) acc[a][b][m][n] = (f32x4){0.f, 0.f, 0.f, 0.f};
        cur = nxt; cA = nA; cB = nB; ++ui;
        if constexpr (ALIGN_EPI) { if (wr == 1) PG8_BAR; }
    }
    PG8_WAIT_V(0);
    if constexpr (!ALIGN_EPI) { if (wr == 0) PG8_BAR; }
    PG8_BAR;
#undef PG8_SA
#undef PG8_SB
#undef PG8_STAGEA
#undef PG8_STAGEB
#undef PG8_TABLOAD
#undef PG8_LDA
#undef PG8_LDB
#undef PG8_MMA
#undef PG8_WAIT_V
#undef PG8_WAIT_L
#undef PG8_BAR
#undef PG8_SCHED
}
}

typedef f32x4 AccT[2][2][4][2];
using pg8::Unit;

typedef GAS unsigned gu32;
#define XB_TMO      128
#define XB_XCNT(j)  (256  + 64 * (j))
#define XB_XSUB(j)  (1280 + 64 * (j))
#define XB_XGEN(j)  (2304 + 64 * (j))
#define XB_TOP      3328
#define XB_TOPGEN   3392
#define XCD_BAR_WORDS 3456
#define XB_SPIN_CAP (1u << 20)
DI unsigned xb_ld(unsigned* p)              { return __hip_atomic_load(p, __ATOMIC_RELAXED, __HIP_MEMORY_SCOPE_AGENT); }
DI unsigned xb_add(unsigned* p, unsigned v) { return __hip_atomic_fetch_add(p, v, __ATOMIC_RELAXED, __HIP_MEMORY_SCOPE_AGENT); }
DI unsigned xb_xcc_id() { return (unsigned)__builtin_amdgcn_s_getreg((3 << 11) | 20) & 0xFu; }
#define XB_SPIN(cond, bar) do { unsigned _sp = 0; while (cond) { __builtin_amdgcn_s_sleep(1); \
    if ((++_sp & 255u) == 0u) { if (xb_ld(&(bar)[XB_TMO])) break; if (_sp > XB_SPIN_CAP) { atomicAdd(&(bar)[XB_TMO], 1u); break; } } } } while (0)
DI int lane_id() { int l = (int)__builtin_amdgcn_mbcnt_hi(~0u, __builtin_amdgcn_mbcnt_lo(~0u, 0u)); asm volatile("" : "+v"(l)); return l; }
struct XcdBarrier { unsigned* bar; unsigned x; volatile LAS unsigned* st; int wave; };
DI XcdBarrier xcd_barrier_post(unsigned* bar, volatile LAS unsigned* st, int wave) {
    XcdBarrier b; b.bar = bar; b.x = xb_xcc_id(); b.st = st; b.wave = wave;
    if (wave == 0 && lane_id() == 0) (void)xb_add(&bar[XB_XCNT(b.x)], 1u);
    return b;
}
DI void xcd_barrier_complete(unsigned* bar, unsigned x, unsigned& nloc, unsigned& nx) {
    const unsigned G = gridDim.x * gridDim.y * gridDim.z;
    unsigned sum, cnt, mine, sp = 0u;
    for (;;) {
        sum = 0u; cnt = 0u; mine = 0u;
#pragma unroll
        for (unsigned j = 0; j < 16; ++j) { const unsigned c = xb_ld(&bar[XB_XCNT(j)]); sum += c; cnt += (c > 0u) ? 1u : 0u; mine = (j == x) ? c : mine; }
        if (sum == G) break;
        __builtin_amdgcn_s_sleep(1);
        if ((++sp & 255u) == 0u) { if (xb_ld(&bar[XB_TMO])) break; if (sp > XB_SPIN_CAP) { atomicAdd(&bar[XB_TMO], 1u); break; } }
    }
    nloc = mine > 0u ? mine : 1u; nx = cnt > 0u ? cnt : 1u;
}
DI void xcd_barrier(const XcdBarrier& b) {
    asm volatile("s_waitcnt vmcnt(0)" ::: "memory");
    __syncthreads();
    if (b.wave == 0 && lane_id() == 0) {
        unsigned* bar = b.bar;
        __builtin_amdgcn_s_waitcnt(0);
        unsigned nloc = b.st[0], nx = b.st[1];
        if (nloc == 0u) { xcd_barrier_complete(bar, b.x, nloc, nx); b.st[0] = nloc; b.st[1] = nx; }
        const unsigned old = xb_add(&bar[XB_XSUB(b.x)], 1u);
        const unsigned gen = old / nloc;
        if (old + 1u == (gen + 1u) * nloc) {
            __builtin_amdgcn_fence(__ATOMIC_RELEASE, "agent");
            asm volatile("s_waitcnt vmcnt(0)" ::: "memory");
            const unsigned og = xb_add(&bar[XB_TOP], 1u);
            const unsigned tg = og / nx;
            if (og + 1u == (tg + 1u) * nx) xb_add(&bar[XB_TOPGEN], 1u);
            else XB_SPIN(xb_ld(&bar[XB_TOPGEN]) == tg, bar);
            __builtin_amdgcn_fence(__ATOMIC_ACQUIRE, "agent");
            xb_add(&bar[XB_XGEN(b.x)], 1u);
            asm volatile("s_waitcnt vmcnt(0)" ::: "memory");
        } else {
            XB_SPIN(xb_ld(&bar[XB_XGEN(b.x)]) == gen, bar);
            __builtin_amdgcn_fence(__ATOMIC_ACQUIRE, "agent");
            asm volatile("s_waitcnt vmcnt(0)" ::: "memory");
        }
    }
    __syncthreads();
}

struct Args { const float* in[31]; float* out; unsigned char* ws; int ph_lo, ph_hi; };
template <int I> DI const float* in_ptr() { const void* kp = (const void*)__builtin_amdgcn_kernarg_segment_ptr(); unsigned long long r;
    asm volatile("s_load_dwordx2 %0, %1, %2\n\ts_waitcnt lgkmcnt(0)" : "=s"(r) : "s"(kp), "i"(I * 8)); return (const float*)(const GAS float*)r; }
struct InTab { int dummy; };
struct Frame {
    LAS unsigned char* lds; int wave, vcu, G;
    InTab in; float* out; unsigned char* ws;
    DI int lane_() const { return lane_id(); }
    DI int tid_() const { return wave * 64 + lane_id(); }
};
#define FTID (F.tid_())
#define FLANE (F.lane_())
#define IN_X 0
#define IN_C 1
#define IN_RELB 2
#define IN_WADA 3
#define IN_BADA 4
#define IN_LN1G 5
#define IN_WIN 6
#define IN_QG 7
#define IN_KG 8
#define IN_LRE 9
#define IN_LIM 10
#define IN_LDT 11
#define IN_BRE 12
#define IN_BIM 13
#define IN_CRE 14
#define IN_CIM 15
#define IN_SSMD 16
#define IN_WGLU 17
#define IN_BGLU 18
#define IN_WUPA 19
#define IN_WUPS 20
#define IN_WOUT 21
#define IN_LN2G 22
#define IN_WROUTER 23
#define IN_RBIAS 24
#define IN_WEG 25
#define IN_WEU 26
#define IN_WED 27
#define IN_WSG 28
#define IN_WSU 29
#define IN_WSD 30

DI float wave_sum(float v) {
#pragma unroll
    for (int o = 1; o < 64; o <<= 1) v += __shfl_xor(v, o);
    return v;
}

template <class RowMap>
DI void tr_item(const float* W, int N, bf16_t* WT, int ldt, int k0, int n0, int lane, RowMap rm) {
    float v[64];
    const float* src = W + (size_t)k0 * N + n0 + lane;
#pragma unroll
    for (int i = 0; i < 64; ++i) v[i] = src[(size_t)i * N];
    bf16_t* dst = WT + (size_t)rm(n0 + lane) * ldt + k0;
#pragma unroll
    for (int j = 0; j < 8; ++j) { u32x4 o; o.x = pk2(v[8 * j], v[8 * j + 1]); o.y = pk2(v[8 * j + 2], v[8 * j + 3]); o.z = pk2(v[8 * j + 4], v[8 * j + 5]); o.w = pk2(v[8 * j + 6], v[8 * j + 7]);
        *(u32x4*)(dst + 8 * j) = o; }
}
struct RmGen { int kind, base; DI int operator()(int n) const { if (kind == 0) return base + n;
    if (kind == 1) { if (n >= 1024) return n; const int tile = n >> 8, w = n & 255, hh = w >> 6, bj = (w >> 5) & 1, i = w & 31; return tile * 256 + 128 * bj + 32 * hh + i; }
    return base + 256 * (n >> 7) + (n & 127); } };
constexpr int I_WIN = 16 * 64, I_GLU = 8 * 8, I_UPA = 8 * 16, I_UPS = 8 * 16, I_OUT = 16 * 16, I_RT = 16 * 4, I_SG = 16 * 4, I_SU = 16 * 4, I_SD = 4 * 16;
constexpr int I_SMALL = I_WIN + I_GLU + I_UPA + I_UPS + I_OUT + I_RT + I_SG + I_SU + I_SD;
constexpr int I_EG = 256 * 64, I_EU = 256 * 64, I_EDN = 256 * 64;
constexpr int NITEMS = I_SMALL + I_EG + I_EU + I_EDN;
DI void conv_items(Frame& F, int lo, int hi) {
    const int gw = F.vcu * 8 + F.wave, NGW = F.G * 8, lane = FLANE;
    unsigned char* ws = F.ws;
#pragma unroll 1
    for (int it = lo + gw; it < hi; it += NGW) {
        int r = it; const float* W; int N, ldt, k0, n0; bf16_t* WT; RmGen rm{0, 0};
        if (r < I_WIN) { W = in_ptr<IN_WIN>(); N = INW; WT = (bf16_t*)(ws + WS_WIN); ldt = DM; k0 = 64 * (r / 64); n0 = 64 * (r % 64); rm.kind = 1; }
        else if ((r -= I_WIN) < I_GLU) { W = in_ptr<IN_WGLU>(); N = SW; WT = (bf16_t*)(ws + WS_WGLU); ldt = SW; k0 = 64 * (r / 8); n0 = 64 * (r % 8); }
        else if ((r -= I_GLU) < I_UPA) { W = in_ptr<IN_WUPA>(); N = DM; WT = (bf16_t*)(ws + WS_WUPA); ldt = AW; k0 = 64 * (r / 16); n0 = 64 * (r % 16); }
        else if ((r -= I_UPA) < I_UPS) { W = in_ptr<IN_WUPS>(); N = DM; WT = (bf16_t*)(ws + WS_WUPS); ldt = SW; k0 = 64 * (r / 16); n0 = 64 * (r % 16); }
        else if ((r -= I_UPS) < I_OUT) { W = in_ptr<IN_WOUT>(); N = DM; WT = (bf16_t*)(ws + WS_WOUT); ldt = DM; k0 = 64 * (r / 16); n0 = 64 * (r % 16); }
        else if ((r -= I_OUT) < I_RT) { W = in_ptr<IN_WROUTER>(); N = NE; WT = (bf16_t*)(ws + WS_WRSH); ldt = DM; k0 = 64 * (r / 4); n0 = 64 * (r % 4); }
        else if ((r -= I_RT) < I_SG) { W = in_ptr<IN_WSG>(); N = ED; WT = (bf16_t*)(ws + WS_WRSH); ldt = DM; k0 = 64 * (r / 4); n0 = 64 * (r % 4); rm.kind = 2; rm.base = 256; }
        else if ((r -= I_SG) < I_SU) { W = in_ptr<IN_WSU>(); N = ED; WT = (bf16_t*)(ws + WS_WRSH); ldt = DM; k0 = 64 * (r / 4); n0 = 64 * (r % 4); rm.kind = 2; rm.base = 256 + 128; }
        else if ((r -= I_SU) < I_SD) { W = in_ptr<IN_WSD>(); N = DM; WT = (bf16_t*)(ws + WS_WSHD); ldt = ED; k0 = 64 * (r / 16); n0 = 64 * (r % 16); }
        else if ((r -= I_SD) < I_EG) { const int e = r / 64, q = r % 64; W = in_ptr<IN_WEG>() + (size_t)e * DM * ED; N = ED; WT = (bf16_t*)(ws + WS_WEGU) + (size_t)e * 512 * DM; ldt = DM; k0 = 64 * (q / 4); n0 = 64 * (q % 4); rm.kind = 2; }
        else if ((r -= I_EG) < I_EU) { const int e = r / 64, q = r % 64; W = in_ptr<IN_WEU>() + (size_t)e * DM * ED; N = ED; WT = (bf16_t*)(ws + WS_WEGU) + (size_t)e * 512 * DM; ldt = DM; k0 = 64 * (q / 4); n0 = 64 * (q % 4); rm.kind = 2; rm.base = 128; }
        else { r -= I_EU; const int e = r / 64, q = r % 64; W = in_ptr<IN_WED>() + (size_t)e * ED * DM; N = DM; WT = (bf16_t*)(ws + WS_WED) + (size_t)e * DM * ED; ldt = ED; k0 = 64 * (q / 16); n0 = 64 * (q % 16); }
        tr_item(W, N, WT, ldt, k0, n0, lane, rm);
    }
}
DI void p0_adaln(Frame& F, int cb) {
    LAS float* sc = (LAS float*)F.lds;
    LAS float* red = (LAS float*)(F.lds + 16384);
    for (int i = FTID; i < 4096; i += 512) sc[i] = siluf_(in_ptr<IN_C>()[i]);
    __syncthreads();
    const int j = cb * 64 + FLANE; const float* w = in_ptr<IN_WADA>() + j;
    float a0 = 0.f, a1 = 0.f, a2 = 0.f, a3 = 0.f;
    const int kb = F.wave * 128;
#pragma unroll 32
    for (int k = 0; k < 128; ++k) { const float wv = w[(size_t)(kb + k) * 6144]; a0 += sc[kb + k] * wv; a1 += sc[1024 + kb + k] * wv; a2 += sc[2048 + kb + k] * wv; a3 += sc[3072 + kb + k] * wv; }
    red[(F.wave * 4 + 0) * 64 + FLANE] = a0; red[(F.wave * 4 + 1) * 64 + FLANE] = a1; red[(F.wave * 4 + 2) * 64 + FLANE] = a2; red[(F.wave * 4 + 3) * 64 + FLANE] = a3;
    __syncthreads();
    if (FTID < 256) { const int b = FTID >> 6, l = FTID & 63; float s = in_ptr<IN_BADA>()[cb * 64 + l];
#pragma unroll
        for (int w8 = 0; w8 < 8; ++w8) s += red[(w8 * 4 + b) * 64 + l];
        ((float*)(F.ws + WS_SMALL))[b * 6144 + cb * 64 + l] = s; }
    __syncthreads();
}
DI void p0_ssm(Frame& F, int g, int q) {
    LAS float* apow = (LAS float*)F.lds;
    LAS float* bb = apow + 17 * 64 * 2;
    LAS float* cc = bb + 64 * 16 * 2;
    LAS float* km = cc + 16 * 64 * 2;
    const int tid = FTID;
    if (tid < 64) {
        const int p = tid;
        const float lre = fminf(in_ptr<IN_LRE>()[g * 64 + p], -1e-4f), lim = in_ptr<IN_LIM>()[g * 64 + p], dt = expf(in_ptr<IN_LDT>()[g]);
        const float mag = expf(lre * dt); float sn, cs; sincosf(lim * dt, &sn, &cs);
        const float are = mag * cs, aim = mag * sn, den = lre * lre + lim * lim, nr = are - 1.0f;
        const float cre = (nr * lre + aim * lim) / den, cim = (aim * lre - nr * lim) / den;
        for (int tau = 0; tau <= 16; ++tau) { const float mg = expf(lre * dt * (float)tau); float s2, c2; sincosf(lim * dt * (float)tau, &s2, &c2); apow[(tau * 64 + p) * 2] = mg * c2; apow[(tau * 64 + p) * 2 + 1] = mg * s2; }
        for (int c = 0; c < 16; ++c) { const float br = in_ptr<IN_BRE>()[(g * 64 + p) * 16 + c], bi = in_ptr<IN_BIM>()[(g * 64 + p) * 16 + c];
            bb[(p * 16 + c) * 2] = cre * br - cim * bi; bb[(p * 16 + c) * 2 + 1] = cre * bi + cim * br; }
        if (q == 0) { float* a16 = (float*)(F.ws + WS_SMALL + 128 * 1024);
            a16[(g * 64 + p) * 2] = apow[(16 * 64 + p) * 2]; a16[(g * 64 + p) * 2 + 1] = apow[(16 * 64 + p) * 2 + 1]; }
    }
    for (int i = tid; i < 1024; i += 512) { cc[i * 2] = in_ptr<IN_CRE>()[g * 1024 + i]; cc[i * 2 + 1] = in_ptr<IN_CIM>()[g * 1024 + i]; }
    __syncthreads();
    for (int e = tid; e < 4096; e += 512) { const int tau = e >> 8, c = (e >> 4) & 15, c2 = e & 15; float s = 0.f;
        if (tau <= 4 * q + 3) {
            for (int p = 0; p < 64; ++p) { const float cr = cc[(c * 64 + p) * 2], ci = cc[(c * 64 + p) * 2 + 1], ar = apow[(tau * 64 + p) * 2], ai = apow[(tau * 64 + p) * 2 + 1], br = bb[(p * 16 + c2) * 2], bi = bb[(p * 16 + c2) * 2 + 1];
                const float tr = cr * ar - ci * ai, ti = cr * ai + ci * ar; s += tr * br - ti * bi; } }
        km[e] = s; }
    __syncthreads();
    unsigned* TF = (unsigned*)((bf16_t*)(F.ws + WS_TF) + ((size_t)g * 256 + 64 * q) * 384);
    for (int e = tid; e < 64 * 192; e += 512) { const int nl = e / 192, k = 2 * (e % 192), n = 64 * q + nl, s = n >> 4, c = n & 15; float v[2];
#pragma unroll
        for (int j = 0; j < 2; ++j) { const int kk = k + j;
            if (kk < 256) { const int s2 = kk >> 4, c2 = kk & 15; v[j] = (s >= s2) ? km[((s - s2) * 16 + c) * 16 + c2] : 0.f; }
            else { const int p = (kk - 256) & 63; const float cr = cc[(c * 64 + p) * 2], ci = cc[(c * 64 + p) * 2 + 1], ar = apow[((s + 1) * 64 + p) * 2], ai = apow[((s + 1) * 64 + p) * 2 + 1];
                v[j] = (kk < 320) ? (cr * ar - ci * ai) : -(cr * ai + ci * ar); } }
        TF[e] = pk2(v[0], v[1]); }
    unsigned* ET = (unsigned*)((bf16_t*)(F.ws + WS_ET) + ((size_t)g * 256 + 64 * q) * 256);
    for (int e = tid; e < 64 * 128; e += 512) { const int nl = e >> 7, k = 2 * (e & 127), n = 64 * q + nl; float v[2] = {0.f, 0.f};
        if (n < 128) { const int p = n & 63;
#pragma unroll
            for (int j = 0; j < 2; ++j) { const int kk = k + j, s2 = kk >> 4, c2 = kk & 15; const float ar = apow[((15 - s2) * 64 + p) * 2], ai = apow[((15 - s2) * 64 + p) * 2 + 1], br = bb[(p * 16 + c2) * 2], bi = bb[(p * 16 + c2) * 2 + 1];
                v[j] = (n < 64) ? (ar * br - ai * bi) : (ar * bi + ai * br); } }
        ET[e] = pk2(v[0], v[1]); }
    __syncthreads();
}

DI void norm_mod_rows(Frame& F, const float* x, const float* gvec, int sh_off, int sc_off, bf16_t* outp) {
    const float* mod = (const float*)(F.ws + WS_SMALL);
    const int gw = F.vcu * 8 + F.wave, NGW = F.G * 8;
    for (int m = gw; m < M; m += NGW) {
        const int b = m / SEQ;
        const f32x4* xr = (const f32x4*)(x + (size_t)m * DM) + FLANE;
        f32x4 v[4]; float s = 0.f;
#pragma unroll
        for (int j = 0; j < 4; ++j) { v[j] = xr[64 * j]; s += (v[j].x * v[j].x + v[j].y * v[j].y) + (v[j].z * v[j].z + v[j].w * v[j].w); }
        const float rstd = 1.0f / sqrtf(wave_sum(s) * (1.0f / DM) + EPSF);
        u32x2* o8 = (u32x2*)(outp + (size_t)m * DM) + FLANE;
#pragma unroll
        for (int j = 0; j < 4; ++j) { const int col = 4 * FLANE + 256 * j;
            const f32x4 gv = *(const f32x4*)(gvec + col), scv = *(const f32x4*)(mod + b * 6144 + sc_off + col), shv = *(const f32x4*)(mod + b * 6144 + sh_off + col);
            const f32x4 y = v[j] * rstd * gv * (scv + 1.0f) + shv;
            u32x2 w; w.x = pk2(y.x, y.y); w.y = pk2(y.z, y.w); o8[64 * j] = w; }
    }
}

struct DenseSched {
    pg8::StaticOrder so; const char* A; const char* B; size_t astep, bstep;
    DI void init(int Mr, int N, int G, int c, const void* A_, int lda, const void* B_, int ldb) { so.init(Mr, N, G, c); A = (const char*)A_; B = (const char*)B_; astep = (size_t)256 * lda * 2; bstep = (size_t)256 * ldb * 2; }
    DI bool next(int i, Unit& u) const { int pm, pn; if (!so.next(i, pm, pn)) return false; u.pm = pm; u.pn = pn; u.aux = 0; u.half = 0; u.rowtab = nullptr; u.A = A + (size_t)pm * astep; u.B = B + (size_t)pn * bstep; return true; }
};

struct EpiInProj {
    static constexpr bool PERM = true;
    bf16_t *Q, *Kb, *V, *Assm, *sga, *sgs; float* kmean; const float *qg, *kg;
    DI void operator()(const AccT& acc, const Unit& u, int wr, int wc, int fr, int fq) const {
        const int pn = u.pn, pm = u.pm;
        const int row0 = pm * 256 + wr * 64 + fr;
        if (pn < 4) {
            const bool isk = pn >= 2; const int hg = (pn & 1) * 4 + wc;
            const float* gp = (isk ? kg : qg) + 8 * fq; const float scl = isk ? 1.0f : QC2;
            f32x4 gv[2][2];
#pragma unroll
            for (int bj = 0; bj < 2; ++bj)
#pragma unroll
                for (int n = 0; n < 2; ++n) gv[bj][n] = *(const f32x4*)(gp + 32 * bj + 4 * n) * scl;
            f32x4 ks[2][2];
#pragma unroll
            for (int bj = 0; bj < 2; ++bj)
#pragma unroll
                for (int n = 0; n < 2; ++n) ks[bj][n] = (f32x4){0.f, 0.f, 0.f, 0.f};
            bf16_t* dst = (isk ? Kb : Q) + hg * 64 + 8 * fq;
#pragma unroll
            for (int ai = 0; ai < 2; ++ai)
#pragma unroll
                for (int m = 0; m < 4; ++m) {
                    float ss = 0.f;
#pragma unroll
                    for (int bj = 0; bj < 2; ++bj)
#pragma unroll
                        for (int n = 0; n < 2; ++n) { const f32x4 a = acc[ai][bj][m][n]; ss += (a.x * a.x + a.y * a.y) + (a.z * a.z + a.w * a.w); }
                    ss += __shfl_xor(ss, 16); ss += __shfl_xor(ss, 32);
                    const float rstd = 1.0f / sqrtf(ss * (1.0f / 64.0f) + EPSF);
                    const size_t row = (size_t)(row0 + ai * 128 + m * 16);
#pragma unroll
                    for (int bj = 0; bj < 2; ++bj) {
                        const f32x4 v0 = acc[ai][bj][m][0] * rstd * gv[bj][0], v1 = acc[ai][bj][m][1] * rstd * gv[bj][1];
                        if (isk) { ks[bj][0] += v0; ks[bj][1] += v1; }
                        u32x4 w; w.x = pk2(v0.x, v0.y); w.y = pk2(v0.z, v0.w); w.z = pk2(v1.x, v1.y); w.w = pk2(v1.z, v1.w);
                        *(u32x4*)(dst + row * 512 + 32 * bj) = w; }
                }
            if (isk) {
                const int b = pm >> 4, blk = pm & 15;
                float* kmp = kmean + ((size_t)((b * 8 + hg) * 16 + blk)) * 64 + 8 * fq;
#pragma unroll
                for (int bj = 0; bj < 2; ++bj)
#pragma unroll
                    for (int n = 0; n < 2; ++n)
#pragma unroll
                        for (int j = 0; j < 4; ++j) { float s = ks[bj][n][j]; s += __shfl_xor(s, 1); s += __shfl_xor(s, 2); s += __shfl_xor(s, 4); s += __shfl_xor(s, 8);
                            if (fr == 0) kmp[wr * 32768 + 32 * bj + 4 * n + j] = s * (1.0f / 256.0f); }
            }
        } else if (pn < 6) {
            bf16_t* dst = V + (pn - 4) * 256 + wc * 32 + 8 * fq;
#pragma unroll
            for (int ai = 0; ai < 2; ++ai)
#pragma unroll
                for (int m = 0; m < 4; ++m) { const size_t row = (size_t)(row0 + ai * 128 + m * 16);
#pragma unroll
                    for (int bj = 0; bj < 2; ++bj) { const f32x4 v0 = acc[ai][bj][m][0], v1 = acc[ai][bj][m][1];
                        u32x4 w; w.x = pk2(v0.x, v0.y); w.y = pk2(v0.z, v0.w); w.z = pk2(v1.x, v1.y); w.w = pk2(v1.z, v1.w);
                        *(u32x4*)(dst + row * 512 + 128 * bj) = w; } }
        } else if (pn < 8) {
            const int b = pm >> 4;
#pragma unroll
            for (int ai = 0; ai < 2; ++ai)
#pragma unroll
                for (int m = 0; m < 4; ++m) { const int t = (pm & 15) * 256 + ai * 128 + wr * 64 + m * 16 + fr;
#pragma unroll
                    for (int bj = 0; bj < 2; ++bj) { const int c = (pn - 6) * 256 + 128 * bj + 32 * wc + 8 * fq, g = c >> 4, c2 = c & 15;
                        const f32x4 v0 = acc[ai][bj][m][0], v1 = acc[ai][bj][m][1];
                        u32x4 w; w.x = pk2(v0.x, v0.y); w.y = pk2(v0.z, v0.w); w.z = pk2(v1.x, v1.y); w.w = pk2(v1.z, v1.w);
                        *(u32x4*)(Assm + ((size_t)g * 1024 + b * 256 + (t >> 4)) * 384 + (t & 15) * 16 + c2) = w; } }
        } else {
            bf16_t* dst = (pn < 12 ? sga + (pn - 8) * 256 : sgs + (pn - 12) * 256) + wc * 32 + 8 * fq;
#pragma unroll
            for (int ai = 0; ai < 2; ++ai)
#pragma unroll
                for (int m = 0; m < 4; ++m) { const size_t row = (size_t)(row0 + ai * 128 + m * 16);
#pragma unroll
                    for (int bj = 0; bj < 2; ++bj) { const f32x4 v0 = acc[ai][bj][m][0], v1 = acc[ai][bj][m][1];
                        u32x4 w; w.x = pk2(sigmoidf_(v0.x), sigmoidf_(v0.y)); w.y = pk2(sigmoidf_(v0.z), sigmoidf_(v0.w)); w.z = pk2(sigmoidf_(v1.x), sigmoidf_(v1.y)); w.w = pk2(sigmoidf_(v1.z), sigmoidf_(v1.w));
                        *(u32x4*)(dst + row * 1024 + 128 * bj) = w; } }
        }
    }
};

struct EpiS1 {
    static constexpr bool PERM = false;
    float* Hloc;
    DI void operator()(const AccT& acc, const Unit& u, int wr, int wc, int fr, int fq) const {
        float* base = Hloc + (size_t)u.pm * 256 * 128 + wc * 32 + 4 * fq;
#pragma unroll
        for (int ai = 0; ai < 2; ++ai)
#pragma unroll
            for (int m = 0; m < 4; ++m) { const int r = ai * 128 + wr * 64 + m * 16 + fr;
#pragma unroll
                for (int n = 0; n < 2; ++n) *(f32x4*)(base + (size_t)r * 128 + 16 * n) = acc[ai][0][m][n]; }
    }
};
struct SsmSched {
    int G, c; const char* A; const char* B; size_t bstep;
    DI bool next(int i, Unit& u) const { const int L = i * G + c; if (L >= 128) return false; u.pm = L; u.pn = 0; u.aux = 0; u.half = 0; u.rowtab = nullptr;
        u.A = A + (size_t)L * 256 * 384 * 2; u.B = B + (size_t)(L >> 2) * bstep; return true; }
};
struct EpiS2 {
    static constexpr bool PERM = true;
    const bf16_t* Assm; const float* dskip; bf16_t* gbuf;
    DI void operator()(const AccT& acc, const Unit& u, int wr, int wc, int fr, int fq) const {
        const int g = u.pm >> 2, b = u.pm & 3;
#pragma unroll
        for (int ai = 0; ai < 2; ++ai)
#pragma unroll
            for (int m = 0; m < 4; ++m) { const int r = ai * 128 + wr * 64 + m * 16 + fr;
#pragma unroll
                for (int bj = 0; bj < 2; ++bj) { const int c = 128 * bj + 32 * wc + 8 * fq, s = c >> 4, c2 = c & 15;
                    const int t = 16 * r + s;
                    size_t uo = ((size_t)u.pm * 256 + r) * 384 + c, oo = ((size_t)b * SEQ + t) * 512 + g * 16 + c2;
                    asm volatile("" : "+v"(uo), "+v"(oo));
                    const u32x2* up = (const u32x2*)(Assm + uo);
                    u32x2* op = (u32x2*)(gbuf + oo);
#pragma unroll
                    for (int n = 0; n < 2; ++n) {
                        const u32x2 uu = up[n]; const f32x4 d0 = *(const f32x4*)(dskip + g * 16 + c2 + 4 * n); const f32x4 a0 = acc[ai][bj][m][n];
                        const float y0 = a0.x + d0.x * bflo(uu.x), y1 = a0.y + d0.y * bfhi(uu.x), y2 = a0.z + d0.z * bflo(uu.y), y3 = a0.w + d0.w * bfhi(uu.y);
                        u32x2 w; w.x = pk2(gelu_tanh(y0), gelu_tanh(y1)); w.y = pk2(gelu_tanh(y2), gelu_tanh(y3));
                        op[n] = w; asm volatile("" ::: "memory"); } } }
    }
};
struct EpiGluUp {
    static constexpr bool PERM = true;
    const bf16_t* gbuf; const float* bglu; bf16_t* sout; const bf16_t* sga; bf16_t* P1;
    DI void operator()(const AccT& acc, const Unit& u, int wr, int wc, int fr, int fq) const {
        const int row0 = u.pm * 256 + wr * 64 + fr, col0 = u.pn * 256 + wc * 32 + 8 * fq;
#pragma unroll
        for (int ai = 0; ai < 2; ++ai)
#pragma unroll
            for (int m = 0; m < 4; ++m) { const size_t row = (size_t)(row0 + ai * 128 + m * 16);
#pragma unroll
                for (int bj = 0; bj < 2; ++bj) { const int col = col0 + 128 * bj; const f32x4 a0 = acc[ai][bj][m][0], a1 = acc[ai][bj][m][1]; u32x4 w;
                    if (u.aux == 0) { const u32x4 gg = *(const u32x4*)(gbuf + row * 512 + col); const f32x4 b0 = *(const f32x4*)(bglu + col), b1 = *(const f32x4*)(bglu + col + 4);
                        w.x = pk2(bflo(gg.x) * sigmoidf_(a0.x + b0.x), bfhi(gg.x) * sigmoidf_(a0.y + b0.y)); w.y = pk2(bflo(gg.y) * sigmoidf_(a0.z + b0.z), bfhi(gg.y) * sigmoidf_(a0.w + b0.w));
                        w.z = pk2(bflo(gg.z) * sigmoidf_(a1.x + b1.x), bfhi(gg.z) * sigmoidf_(a1.y + b1.y)); w.w = pk2(bflo(gg.w) * sigmoidf_(a1.z + b1.z), bfhi(gg.w) * sigmoidf_(a1.w + b1.w));
                        *(u32x4*)(sout + row * 512 + col) = w;
                    } else { const u32x4 gg = *(const u32x4*)(sga + row * 1024 + col);
                        w.x = pk2(bflo(gg.x) * a0.x, bfhi(gg.x) * a0.y); w.y = pk2(bflo(gg.y) * a0.z, bfhi(gg.y) * a0.w); w.z = pk2(bflo(gg.z) * a1.x, bfhi(gg.z) * a1.y); w.w = pk2(bflo(gg.w) * a1.z, bfhi(gg.w) * a1.w);
                        *(u32x4*)(P1 + row * 1024 + col) = w; } } }
    }
};
struct GluUpSched {
    int G, c; const char *Ag, *Bg, *Au, *Bu;
    DI bool next(int i, Unit& u) const { const int L = i * G + c; if (L >= 384) return false; u.rowtab = nullptr; u.half = 0;
        if (L < 128) { u.aux = 0; u.pm = L >> 1; u.pn = L & 1; u.A = Ag + (size_t)u.pm * 256 * 512 * 2; u.B = Bg + (size_t)u.pn * 256 * 512 * 2; }
        else { const int l2 = L - 128; u.aux = 1; u.pm = l2 >> 2; u.pn = l2 & 3; u.A = Au + (size_t)u.pm * 256 * 512 * 2; u.B = Bu + (size_t)u.pn * 256 * 512 * 2; }
        return true; }
};
struct EpiUp2 {
    static constexpr bool PERM = true;
    const bf16_t* P1; const bf16_t* sgs; bf16_t* mix;
    DI void operator()(const AccT& acc, const Unit& u, int wr, int wc, int fr, int fq) const {
        const int row0 = u.pm * 256 + wr * 64 + fr, col0 = u.pn * 256 + wc * 32 + 8 * fq;
#pragma unroll
        for (int ai = 0; ai < 2; ++ai)
#pragma unroll
            for (int m = 0; m < 4; ++m) { const size_t row = (size_t)(row0 + ai * 128 + m * 16);
#pragma unroll
                for (int bj = 0; bj < 2; ++bj) { const size_t o = row * 1024 + col0 + 128 * bj; const f32x4 a0 = acc[ai][bj][m][0], a1 = acc[ai][bj][m][1];
                    const u32x4 gg = *(const u32x4*)(sgs + o), pp = *(const u32x4*)(P1 + o); u32x4 w;
                    w.x = pk2(bflo(pp.x) + bflo(gg.x) * a0.x, bfhi(pp.x) + bfhi(gg.x) * a0.y); w.y = pk2(bflo(pp.y) + bflo(gg.y) * a0.z, bfhi(pp.y) + bfhi(gg.y) * a0.w);
                    w.z = pk2(bflo(pp.z) + bflo(gg.z) * a1.x, bfhi(pp.z) + bfhi(gg.z) * a1.y); w.w = pk2(bflo(pp.w) + bflo(gg.w) * a1.z, bfhi(pp.w) + bfhi(gg.w) * a1.w);
                    *(u32x4*)(mix + o) = w; } }
    }
};
struct EpiOut {
    static constexpr bool PERM = true;
    const float* x; const float* mod; float* out;
    DI void operator()(const AccT& acc, const Unit& u, int wr, int wc, int fr, int fq) const {
        const int row0 = u.pm * 256 + wr * 64 + fr, col0 = u.pn * 256 + wc * 32 + 8 * fq, b = u.pm >> 4;
#pragma unroll
        for (int bj = 0; bj < 2; ++bj) { const int col = col0 + 128 * bj;
            const f32x4 g0 = *(const f32x4*)(mod + b * 6144 + 2048 + col), g1 = *(const f32x4*)(mod + b * 6144 + 2048 + col + 4);
#pragma unroll
            for (int ai = 0; ai < 2; ++ai)
#pragma unroll
                for (int m = 0; m < 4; ++m) { const size_t o = (size_t)(row0 + ai * 128 + m * 16) * 1024 + col;
                    const f32x4 x0 = *(const f32x4*)(x + o), x1 = *(const f32x4*)(x + o + 4);
                    *(f32x4*)(out + o) = x0 + g0 * acc[ai][bj][m][0]; *(f32x4*)(out + o + 4) = x1 + g1 * acc[ai][bj][m][1]; } }
    }
};
struct EpiRsh {
    static constexpr bool PERM = true;
    float* scores; bf16_t* hs;
    DI void operator()(const AccT& acc, const Unit& u, int wr, int wc, int fr, int fq) const {
        const int row0 = u.pm * 256 + wr * 64 + fr;
        if (u.pn == 0) {
#pragma unroll
            for (int ai = 0; ai < 2; ++ai)
#pragma unroll
                for (int m = 0; m < 4; ++m) { const size_t row = (size_t)(row0 + ai * 128 + m * 16);
#pragma unroll
                    for (int bj = 0; bj < 2; ++bj) { float* d = scores + row * 256 + 128 * bj + 32 * wc + 8 * fq; const f32x4 a0 = acc[ai][bj][m][0], a1 = acc[ai][bj][m][1];
                        *(f32x4*)d = (f32x4){sigmoidf_(a0.x), sigmoidf_(a0.y), sigmoidf_(a0.z), sigmoidf_(a0.w)}; *(f32x4*)(d + 4) = (f32x4){sigmoidf_(a1.x), sigmoidf_(a1.y), sigmoidf_(a1.z), sigmoidf_(a1.w)}; } }
        } else {
#pragma unroll
            for (int ai = 0; ai < 2; ++ai)
#pragma unroll
                for (int m = 0; m < 4; ++m) { const size_t row = (size_t)(row0 + ai * 128 + m * 16);
                    const f32x4 g0 = acc[ai][0][m][0], g1 = acc[ai][0][m][1], u0 = acc[ai][1][m][0], u1 = acc[ai][1][m][1]; u32x4 w;
                    w.x = pk2(siluf_(g0.x) * u0.x, siluf_(g0.y) * u0.y); w.y = pk2(siluf_(g0.z) * u0.z, siluf_(g0.w) * u0.w); w.z = pk2(siluf_(g1.x) * u1.x, siluf_(g1.y) * u1.y); w.w = pk2(siluf_(g1.z) * u1.z, siluf_(g1.w) * u1.w);
                    *(u32x4*)(hs + row * 256 + 128 * (u.pn - 1) + 32 * wc + 8 * fq) = w; }
        }
    }
};
struct EpiBf16 {
    static constexpr bool PERM = true;
    bf16_t* O; int ldc;
    DI void operator()(const AccT& acc, const Unit& u, int wr, int wc, int fr, int fq) const {
        const int row0 = u.pm * 256 + wr * 64 + fr, col0 = u.pn * 256 + wc * 32 + 8 * fq;
#pragma unroll
        for (int ai = 0; ai < 2; ++ai)
#pragma unroll
            for (int m = 0; m < 4; ++m) { const size_t row = (size_t)(row0 + ai * 128 + m * 16);
#pragma unroll
                for (int bj = 0; bj < 2; ++bj) { const f32x4 v0 = acc[ai][bj][m][0], v1 = acc[ai][bj][m][1];
                    u32x4 w; w.x = pk2(v0.x, v0.y); w.y = pk2(v0.z, v0.w); w.z = pk2(v1.x, v1.y); w.w = pk2(v1.z, v1.w);
                    *(u32x4*)(O + row * ldc + col0 + 128 * bj) = w; } asm volatile("" ::: "memory"); }
    }
};
struct EpiMoe1 {
    static constexpr bool PERM = true;
    bf16_t* Hs;
    DI void operator()(const AccT& acc, const Unit& u, int wr, int wc, int fr, int fq) const {
        const int row0 = u.pm * 256 + wr * 64 + fr;
#pragma unroll
        for (int ai = 0; ai < 2; ++ai)
#pragma unroll
            for (int m = 0; m < 4; ++m) { const size_t row = (size_t)(row0 + ai * 128 + m * 16);
                const f32x4 g0 = acc[ai][0][m][0], g1 = acc[ai][0][m][1], u0 = acc[ai][1][m][0], u1 = acc[ai][1][m][1]; u32x4 w;
                w.x = pk2(siluf_(g0.x) * u0.x, siluf_(g0.y) * u0.y); w.y = pk2(siluf_(g0.z) * u0.z, siluf_(g0.w) * u0.w); w.z = pk2(siluf_(g1.x) * u1.x, siluf_(g1.y) * u1.y); w.w = pk2(siluf_(g1.z) * u1.z, siluf_(g1.w) * u1.w);
                *(u32x4*)(Hs + row * 256 + 128 * u.pn + 32 * wc + 8 * fq) = w; }
    }
};
struct EpiMoe2 {
    static constexpr bool PERM = true;
    const int* dest; const float* roww; bf16_t* Y;
    DI void operator()(const AccT& acc, const Unit& u, int wr, int wc, int fr, int fq) const {
        const int row0 = u.pm * 256 + wr * 64 + fr, col0 = u.pn * 256 + wc * 32 + 8 * fq;
        int dd[2][4]; float ww[2][4];
#pragma unroll
        for (int ai = 0; ai < 2; ++ai)
#pragma unroll
            for (int m = 0; m < 4; ++m) { const int row = row0 + ai * 128 + m * 16; dd[ai][m] = dest[row]; ww[ai][m] = roww[row]; }
#pragma unroll
        for (int ai = 0; ai < 2; ++ai)
#pragma unroll
            for (int m = 0; m < 4; ++m) { const int d = dd[ai][m]; const float wt = ww[ai][m];
                if (d >= 0) {
#pragma unroll
                    for (int bj = 0; bj < 2; ++bj) { const f32x4 v0 = acc[ai][bj][m][0] * wt, v1 = acc[ai][bj][m][1] * wt;
                        u32x4 w; w.x = pk2(v0.x, v0.y); w.y = pk2(v0.z, v0.w); w.z = pk2(v1.x, v1.y); w.w = pk2(v1.z, v1.w);
                        *(u32x4*)(Y + (size_t)d * 1024 + col0 + 128 * bj) = w; } } }
    }
};
struct MoeSched {
    int G, c, npn, ntiles; const LAS unsigned short* tile_e; const char* A; const char* B; size_t astep, bestep, bnstep; const int* rowtab;
    DI bool next(int i, Unit& u) const { const int L = i * G + c; if (L >= ntiles * npn) return false; const int tile = L / npn, pn = L % npn; const int e = tile_e[tile];
        u.pm = tile; u.pn = pn; u.aux = e; u.half = (tile_e[MAXTILES + tile] <= 128) ? 1 : 0; u.rowtab = rowtab + tile * 256; u.A = A + (size_t)tile * astep; u.B = B + (size_t)e * bestep + (size_t)pn * bnstep; return true; }
};

namespace att {
constexpr int DMA_ = 512;
constexpr int NW = 8, QBLK = 32, QB = 256, KVBLK = 64;
DI int crow(int r, int hi) { return (r & 3) + 8 * (r >> 2) + 4 * hi; }
#define SBAR() __builtin_amdgcn_sched_barrier(0)
DI void cmask(f32x16& p0, f32x16& p1, int jb, int qrel, int hi) {
    const float NEG = -INFINITY; int kb = 64 * jb + 4 * hi;
#pragma unroll
    for (int r = 0; r < 16; ++r) { int kv = kb + (r & 3) + 8 * (r >> 2); if (kv > qrel) p0[r] = NEG; if (kv + 32 > qrel) p1[r] = NEG; }
}
constexpr int NSLOT = 3, SLOTB = 8192;
constexpr int LDS_K = 0, LDS_V = NSLOT * SLOTB, LDS_WS = 2 * NSLOT * SLOTB, LDS_OST = LDS_WS + NW * 64 * 4, LDS_KM = LDS_OST + NW * 4096, LDS_BT = LDS_KM + 4096, LDS_END = LDS_BT + 576 * 4;
static_assert(LDS_END <= RING_BYTES, "attention LDS");
DI void glds16(const void* sbase, unsigned voff, unsigned lds_dst) { unsigned keep;
    asm volatile("s_nop 4\n\ts_mov_b32 %0, m0\n\ts_mov_b32 m0, %2\n\ts_nop 0\n\tglobal_load_lds_dwordx4 %1, %3\n\ts_mov_b32 m0, %0" : "=&s"(keep) : "v"(voff), "s"(lds_dst), "s"(sbase) : "memory"); }
DI float max3f(float a, float b, float c) { float r; asm("v_max3_f32 %0, %1, %2, %3" : "=v"(r) : "v"(a), "v"(b), "v"(c)); return r; }
DI float max2f(float a, float b) { float r; asm("v_max_f32_e32 %0, %1, %2" : "=v"(r) : "v"(a), "v"(b)); return r; }
DI float fadd_s(float a, float b) { float r; asm("v_add_f32_e32 %0, %1, %2" : "=v"(r) : "v"(a), "v"(b)); return r; }
DI float fsub_s(float a, float b) { float r; asm("v_sub_f32_e32 %0, %1, %2" : "=v"(r) : "v"(a), "v"(b)); return r; }
DI unsigned cvtpk_s(float lo, float hi) { return pk2(lo, hi); }
#define WAIT_BAR(N) asm volatile("s_waitcnt vmcnt(" #N ") lgkmcnt(0)\n\ts_barrier" ::: "memory")
DI void qkt(f32x16& p0, f32x16& p1, const char* Kslot, const bf16x8* qr, const f32x16& negm, int r32, int hi) {
    const char* kb = Kslot + hi * 1024 + r32 * 16;
#pragma unroll
    for (int d0 = 0; d0 < 4; ++d0) {
        const bf16x8 b0 = *reinterpret_cast<const bf16x8*>(kb + d0 * 2048);
        const bf16x8 b1 = *reinterpret_cast<const bf16x8*>(kb + d0 * 2048 + 512);
        if (d0 == 0) { p0 = __builtin_amdgcn_mfma_f32_32x32x16_bf16(b0, qr[0], negm, 0, 0, 0); p1 = __builtin_amdgcn_mfma_f32_32x32x16_bf16(b1, qr[0], negm, 0, 0, 0); }
        else { p0 = __builtin_amdgcn_mfma_f32_32x32x16_bf16(b0, qr[d0], p0, 0, 0, 0); p1 = __builtin_amdgcn_mfma_f32_32x32x16_bf16(b1, qr[d0], p1, 0, 0, 0); } }
}
typedef LAS const char* lds_cptr;
typedef short v4i16_t __attribute__((ext_vector_type(4)));
DI void kload8(bf16x8* kf, lds_cptr kp) {
    kf[0] = *(const LAS bf16x8*)(kp);        kf[1] = *(const LAS bf16x8*)(kp + 512);
    kf[2] = *(const LAS bf16x8*)(kp + 2048); kf[3] = *(const LAS bf16x8*)(kp + 2560);
    kf[4] = *(const LAS bf16x8*)(kp + 4096); kf[5] = *(const LAS bf16x8*)(kp + 4608);
    kf[6] = *(const LAS bf16x8*)(kp + 6144); kf[7] = *(const LAS bf16x8*)(kp + 6656);
}
DI void kload2(bf16x8* kf, lds_cptr kp, int j) { kf[2 * j] = *(const LAS bf16x8*)(kp + j * 2048); kf[2 * j + 1] = *(const LAS bf16x8*)(kp + j * 2048 + 512); }
DI s16x4 vtr(lds_cptr p) { return __builtin_bit_cast(s16x4, __builtin_amdgcn_ds_read_tr16_b64_v4i16((LAS v4i16_t*)p)); }
DI float rowmax(const f32x16& p0, const f32x16& p1) {
    float a = max3f(p0[0], p0[1], p1[0]), b = max3f(p0[2], p0[3], p1[1]); a = max3f(a, p1[2], p1[3]);
#pragma unroll
    for (int r = 4; r < 16; r += 4) { a = max3f(a, p0[r], p0[r + 1]); b = max3f(b, p0[r + 2], p0[r + 3]); a = max3f(a, p1[r], p1[r + 1]); b = max3f(b, p1[r + 2], p1[r + 3]); }
    const float m = max2f(a, b);
    auto rr = __builtin_amdgcn_permlane32_swap(__float_as_uint(m), __float_as_uint(m), false, false);
    return max2f(__uint_as_float(rr[0]), __uint_as_float(rr[1]));
}
DI void pv(f32x16* o, int vb, bf16x8 pa0, bf16x8 pa1, bf16x8 pa2, bf16x8 pa3) {
#pragma unroll
    for (int d0 = 0; d0 < 2; ++d0) { s16x4 lo[4], hi[4];
#pragma unroll
        for (int ks = 0; ks < 4; ++ks) {
            asm volatile("ds_read_b64_tr_b16 %0,%1 offset:%c2" : "=&v"(lo[ks]) : "v"(vb), "i"(d0 * 4096 + ks * 1024) : "memory");
            asm volatile("ds_read_b64_tr_b16 %0,%1 offset:%c2" : "=&v"(hi[ks]) : "v"(vb), "i"(d0 * 4096 + ks * 1024 + 512) : "memory"); }
        asm volatile("s_waitcnt lgkmcnt(0)" ::: "memory"); SBAR();
#define PK(k) (bf16x8){lo[k][0], lo[k][1], lo[k][2], lo[k][3], hi[k][0], hi[k][1], hi[k][2], hi[k][3]}
        o[d0] = __builtin_amdgcn_mfma_f32_32x32x16_bf16(pa0, PK(0), o[d0], 0, 0, 0);
        o[d0] = __builtin_amdgcn_mfma_f32_32x32x16_bf16(pa1, PK(1), o[d0], 0, 0, 0);
        o[d0] = __builtin_amdgcn_mfma_f32_32x32x16_bf16(pa2, PK(2), o[d0], 0, 0, 0);
        o[d0] = __builtin_amdgcn_mfma_f32_32x32x16_bf16(pa3, PK(3), o[d0], 0, 0, 0);
#undef PK
    }
}
DI int t5_bucket(int n) { if (n < 16) return n; int v = 16 + (int)(logf((float)n * (1.0f / 16.0f)) * (16.0f / 2.0794415416798357f)); return v > 31 ? 31 : v; }

template <int THRL> DI void attn_unit(int wid, int b, int h, int qb, const bf16_t* Q, const bf16_t* __restrict__ K, const bf16_t* __restrict__ V, bf16_t* O, char* shm, const float* kmean, const float* relb) {
    int lane = lane_id(); asm volatile("" : "+v"(lane));
    const int tid = wid * 64 + lane, r32 = lane & 31, hi = lane >> 5;
    const long rowbase = (long)b * SEQ; const int q0 = qb * QB;
    const bf16_t* Qw = Q + (rowbase + q0 + wid * QBLK) * DMA_ + h * 64;
    const bf16_t* Kh = K + rowbase * DMA_ + h * 64, *Vh = V + rowbase * DMA_ + h * 64;
    const unsigned lds0 = (unsigned)(uintptr_t)shm;
    LAS float* wsf = (LAS float*)((LAS char*)shm + LDS_WS) + wid * 64;
    LAS float* kms = (LAS float*)((LAS char*)shm + LDS_KM); LAS float* bt = (LAS float*)((LAS char*)shm + LDS_BT);
    if (tid < 256) *(LAS f32x4*)(kms + 4 * tid) = *(const f32x4*)(kmean + (size_t)(b * 8 + h) * 1024 + 4 * tid) + *(const f32x4*)(kmean + 32768 + (size_t)(b * 8 + h) * 1024 + 4 * tid);
    for (int i = tid; i < 576; i += 512) { const int n = i - 256; float v = 0.f; if (n >= 0 && n < 128) v = (relb[t5_bucket(n) * 8 + h] - relb[31 * 8 + h]) * LOG2E; bt[i] = exp2f(v); }
    asm volatile("s_waitcnt vmcnt(0) lgkmcnt(0)\n\ts_barrier" ::: "memory");
    unsigned selmask = 0;
    {
        float gsc[8];
#pragma unroll
        for (int j = 0; j < 8; ++j) gsc[j] = 0.f;
#pragma unroll
        for (int c8 = 0; c8 < 8; ++c8) { const u32x4 qq = *(const u32x4*)(Qw + (long)r32 * DMA_ + c8 * 8);
            float qv[8] = {bflo(qq.x), bfhi(qq.x), bflo(qq.y), bfhi(qq.y), bflo(qq.z), bfhi(qq.z), bflo(qq.w), bfhi(qq.w)};
#pragma unroll
            for (int j = 0; j < 8; ++j) { const LAS float* kp = kms + (8 * hi + j) * 64 + c8 * 8; const f32x4 k0 = *(const LAS f32x4*)kp, k1 = *(const LAS f32x4*)(kp + 4);
                gsc[j] += qv[0] * k0.x + qv[1] * k0.y + qv[2] * k0.z + qv[3] * k0.w + qv[4] * k1.x + qv[5] * k1.y + qv[6] * k1.z + qv[7] * k1.w; } }
        float ga[16];
#pragma unroll
        for (int j = 0; j < 8; ++j) { const float o = __shfl_xor(gsc[j], 32); ga[j] = hi ? o : gsc[j]; ga[8 + j] = hi ? gsc[j] : o; }
#pragma unroll
        for (int j = 0; j < 16; ++j) if (j >= qb) ga[j] = -INFINITY;
#pragma unroll
        for (int k = 0; k < 3; ++k) { float bv = -INFINITY; int bi = -1;
#pragma unroll
            for (int j = 0; j < 16; ++j) if (ga[j] > bv) { bv = ga[j]; bi = j; }
            if (bi >= 0) { selmask |= 1u << bi;
#pragma unroll
                for (int j = 0; j < 16; ++j) if (j == bi) ga[j] = -INFINITY; } }
        selmask |= 0xffff0000u | (1u << qb);
    }
    const unsigned kvo = (unsigned)(lane * DMA_ * 2);
    const unsigned vvo = (unsigned)(((lane >> 2) * DMA_ + (lane & 3) * 8) * 2);
    const bf16_t* kub = Kh + wid * 8; const bf16_t* vub = Vh + (long)(16 * (wid & 3)) * DMA_ + (wid >> 2) * 32;
    const unsigned kdst = lds0 + LDS_K + wid * 1024, vdst = lds0 + LDS_V + wid * 1024;
#define DMA_K(t, slot) glds16(kub + (long)(t) * KVBLK * DMA_, kvo, (unsigned)__builtin_amdgcn_readfirstlane(kdst + (slot)))
#define DMA_V(t, slot) glds16(vub + (long)(t) * KVBLK * DMA_, vvo, (unsigned)__builtin_amdgcn_readfirstlane(vdst + (slot)))
    const int vb0 = (int)(lds0 + LDS_V) + ((lane >> 4) & 1) * 32 + (lane & 3) * 8 + (4 * hi + ((lane & 15) >> 2)) * 64;
    const char* Kbase = shm + LDS_K; bf16x8 kf[8];
    const lds_cptr shm3 = (lds_cptr)shm; const lds_cptr kp0 = shm3 + LDS_K + hi * 1024 + r32 * 16; const lds_cptr vp0 = shm3 + LDS_V + ((lane >> 4) & 1) * 32 + (lane & 3) * 8 + (4 * hi + ((lane & 15) >> 2)) * 64;
    const int NT = (q0 + QB) / KVBLK;
    DMA_K(0, 0); DMA_V(0, 0); DMA_K(1, SLOTB);
    bf16x8 qr[4];
#pragma unroll
    for (int d0 = 0; d0 < 4; ++d0) qr[d0] = *reinterpret_cast<const bf16x8*>(&Qw[(long)r32 * DMA_ + d0 * 16 + hi * 8]);
    float mhat = 0.f, l_reg = 0.f; f32x16 o[2]; o[0] = f32x16{}; o[1] = f32x16{}; f32x16 negm;
#pragma unroll
    for (int r = 0; r < 16; ++r) negm[r] = (selmask & 1u) ? 0.f : -1e30f;
    asm volatile("" : "+v"(negm));
    const int qrel = wid * QBLK + r32;
#define MASKS(P0, P1, t) do { int jb_ = (t) - (NT - 4); if (jb_ >= 0) cmask(P0, P1, jb_, qrel, hi); } while (0)
#define BIASM(P0, P1, t) do { if ((t) >= NT - 9 && q0 + wid * QBLK - (64 * (t) + 63) < 128) { const LAS float* bp_ = bt + (q0 + qrel - 64 * (t) + 256 - 63 - 4 * hi); \
        _Pragma("unroll") for (int r4 = 0; r4 < 16; r4 += 4) { _Pragma("unroll") for (int r = r4; r < r4 + 4; ++r) { P0[r] *= bp_[63 - crow(r, 0)]; P1[r] *= bp_[31 - crow(r, 0)]; } SBAR(); } } } while (0)
#define MOFF(t) (((selmask >> ((t) >> 2)) & 1u) ? 0.f : -1e30f)
#define UPD(t) do { if (((t) & 3) == 0) { const float nv_ = MOFF(t) - mhat; \
        _Pragma("unroll") for (int r = 0; r < 16; ++r) negm[r] = nv_; asm volatile("" : "+v"(negm)); } } while (0)
    bool resc = false;
#define START(P0, P1) do { const float rm = rowmax(P0, P1); resc = false; \
    { const float dl = __builtin_fmaxf(rm, 0.f); mhat = fadd_s(mhat, dl); \
      _Pragma("unroll") for (int r = 0; r < 16; ++r) { P0[r] = fsub_s(P0[r], dl); P1[r] = fsub_s(P1[r], dl); } \
      const float nv_ = MOFF(0) - mhat; _Pragma("unroll") for (int r = 0; r < 16; ++r) negm[r] = nv_; asm volatile("" : "+v"(negm)); } \
    _Pragma("unroll") for (int r = 0; r < 16; ++r) P0[r] = __builtin_amdgcn_exp2f(P0[r]); } while (0)
#define RESC() do { if (resc) { asm volatile("s_waitcnt lgkmcnt(0)" ::: "memory"); \
      _Pragma("unroll") for (int d_ = 0; d_ < 2; ++d_) _Pragma("unroll") for (int r = 0; r < 16; ++r) o[d_][r] *= wsf[crow(r, hi)]; } } while (0)
    f32x16 pA0, pA1, pB0, pB1;
    int sl_prev = 0, sl_cur = 0, sl_next = SLOTB;
#define ROT() do { sl_prev = sl_cur; sl_cur = sl_next; sl_next = (sl_next == (NSLOT - 1) * SLOTB) ? 0 : sl_next + SLOTB; } while (0)
    DMA_K(2, 2 * SLOTB);
    WAIT_BAR(3);
    qkt(pA0, pA1, Kbase, qr, negm, r32, hi); asm volatile("s_nop 15\n\ts_nop 7" : "+v"(pA0), "+v"(pA1)); MASKS(pA0, pA1, 0);
    START(pA0, pA1);
    _Pragma("unroll") for (int r = 0; r < 16; ++r) pA1[r] = __builtin_amdgcn_exp2f(pA1[r]);
    WAIT_BAR(0);
    DMA_K(3, 0); DMA_V(1, SLOTB);
    ROT();
    kload8(kf, kp0 + sl_cur);
    WAIT_BAR(2);
    BIASM(pA0, pA1, 0);
    s16x4 vlo[8], vhi[8]; u32x4 pw0, pw1, pw2, pw3;
#define PKW(P, B) cvtpk_s(P[B], P[B + 1])
#define PAF(k) __builtin_bit_cast(bf16x8, pw##k)
#define VFR(i) (bf16x8){vlo[i][0], vlo[i][1], vlo[i][2], vlo[i][3], vhi[i][0], vhi[i][1], vhi[i][2], vhi[i][3]}
#define PIN(x) asm volatile("" : "+v"(x))
#define MX3(a, b, c) __builtin_fmaxf(__builtin_fmaxf((a), (b)), (c))
#define GAPA(MF, A0, A1, A2, A3, W0, W1, PW) do { MF; sacc += A0; sacc += A1; sacc += A2; sacc += A3; PIN(sacc); W0; W1; PIN(PW); SBAR(); } while (0)
#define EX(v) __builtin_amdgcn_exp2f(v)
#define GAPB(MF, X, B) do { MF; X[B] = EX(X[B]); X[B + 1] = EX(X[B + 1]); X[B + 2] = EX(X[B + 2]); X[B + 3] = EX(X[B + 3]); PIN(X); SBAR(); } while (0)
#define VRD(i) do { vlo[i] = vtr(vp_ + (((i) >> 2) * 4096 + ((i) & 3) * 1024)); vhi[i] = vtr(vp_ + (((i) >> 2) * 4096 + ((i) & 3) * 1024 + 512)); } while (0)
#define KRD(G, j) do { if (G) { kload2(kf, kp0 + sl_next, j); SBAR(); } } while (0)
#define STEP(C0, C1, P0, P1, t, GK, GV, GL, MSK) do { SBAR(); \
    const lds_cptr vp_ = vp0 + sl_prev; \
    VRD(0); SBAR(); float sacc = (P0[0] + P0[1]); \
    GAPA(C0 = __builtin_amdgcn_mfma_f32_32x32x16_bf16(kf[0], qr[0], negm, 0, 0, 0), P0[2], P0[3], P0[4], P0[5],     pw0[0] = PKW(P0, 0), pw0[1] = PKW(P0, 2), pw0); \
    VRD(4); SBAR(); GAPA(C1 = __builtin_amdgcn_mfma_f32_32x32x16_bf16(kf[1], qr[0], negm, 0, 0, 0), P0[6], P0[7], P0[8], P0[9],     pw0[2] = PKW(P0, 4), pw0[3] = PKW(P0, 6), pw0); \
    VRD(1); SBAR(); GAPA(C0 = __builtin_amdgcn_mfma_f32_32x32x16_bf16(kf[2], qr[1], C0, 0, 0, 0),   P0[10], P0[11], P0[12], P0[13], pw1[0] = PKW(P0, 8), pw1[1] = PKW(P0, 10), pw1); \
    VRD(5); SBAR(); GAPA(C1 = __builtin_amdgcn_mfma_f32_32x32x16_bf16(kf[3], qr[1], C1, 0, 0, 0),   P0[14], P0[15], P1[0], P1[1],   pw1[2] = PKW(P0, 12), pw1[3] = PKW(P0, 14), pw1); \
    VRD(2); SBAR(); GAPA(C0 = __builtin_amdgcn_mfma_f32_32x32x16_bf16(kf[4], qr[2], C0, 0, 0, 0),   P1[2], P1[3], P1[4], P1[5],     pw2[0] = PKW(P1, 0), pw2[1] = PKW(P1, 2), pw2); \
    VRD(6); SBAR(); GAPA(C1 = __builtin_amdgcn_mfma_f32_32x32x16_bf16(kf[5], qr[2], C1, 0, 0, 0),   P1[6], P1[7], P1[8], P1[9],     pw2[2] = PKW(P1, 4), pw2[3] = PKW(P1, 6), pw2); \
    VRD(3); SBAR(); GAPA(C0 = __builtin_amdgcn_mfma_f32_32x32x16_bf16(kf[6], qr[3], C0, 0, 0, 0),   P1[10], P1[11], P1[12], P1[13], pw3[0] = PKW(P1, 8), pw3[1] = PKW(P1, 10), pw3); \
    asm volatile("s_waitcnt lgkmcnt(13)" ::: "memory"); VRD(7); SBAR(); GAPA(C1 = __builtin_amdgcn_mfma_f32_32x32x16_bf16(kf[7], qr[3], C1, 0, 0, 0),   P1[14], P1[15], 0.f, 0.f,       pw3[2] = PKW(P1, 12), pw3[3] = PKW(P1, 14), pw3); \
    l_reg += sacc; \
    if (GK) { DMA_K((t) + 3, sl_cur); } if (GV) { DMA_V((t) + 1, sl_next); } \
    if (MSK) { MASKS(C0, C1, t); } \
    { float a = MX3(C0[0], C0[1], C1[0]), b = MX3(C0[2], C0[3], C1[1]); a = MX3(a, C1[2], C1[3]); \
      _Pragma("unroll") for (int r = 4; r < 16; r += 4) { a = MX3(a, C0[r], C0[r + 1]); b = MX3(b, C0[r + 2], C0[r + 3]); a = MX3(a, C1[r], C1[r + 1]); b = MX3(b, C1[r + 2], C1[r + 3]); } \
      float rm = __builtin_fmaxf(a, b); { auto rr = __builtin_amdgcn_permlane32_swap(__float_as_uint(rm), __float_as_uint(rm), false, false); rm = __builtin_fmaxf(__uint_as_float(rr[0]), __uint_as_float(rr[1])); } \
      resc = false; \
      if (__builtin_expect(__any(rm > (float)THRL), 0)) { const float dl = __builtin_fmaxf(rm, 0.f); mhat += dl; \
        _Pragma("unroll") for (int r = 0; r < 16; ++r) { C0[r] -= dl; C1[r] -= dl; } \
        const float nv_ = MOFF(t) - mhat; _Pragma("unroll") for (int r = 0; r < 16; ++r) negm[r] = nv_; asm volatile("" : "+v"(negm)); \
        const float f = __builtin_amdgcn_exp2f(-dl); l_reg *= f; { const int l2_ = lane_id(); if (l2_ < 32) wsf[l2_] = f; } resc = true; } } \
    SBAR(); \
    GAPB(o[0] = __builtin_amdgcn_mfma_f32_32x32x16_bf16(PAF(0), VFR(0), o[0], 0, 0, 0), C0, 0); \
    GAPB(o[1] = __builtin_amdgcn_mfma_f32_32x32x16_bf16(PAF(0), VFR(4), o[1], 0, 0, 0), C0, 4); \
    KRD(GL, 0); GAPB(o[0] = __builtin_amdgcn_mfma_f32_32x32x16_bf16(PAF(1), VFR(1), o[0], 0, 0, 0), C0, 8); \
    KRD(GL, 1); GAPB(o[1] = __builtin_amdgcn_mfma_f32_32x32x16_bf16(PAF(1), VFR(5), o[1], 0, 0, 0), C0, 12); \
    KRD(GL, 2); GAPB(o[0] = __builtin_amdgcn_mfma_f32_32x32x16_bf16(PAF(2), VFR(2), o[0], 0, 0, 0), C1, 0); \
    KRD(GL, 3); GAPB(o[1] = __builtin_amdgcn_mfma_f32_32x32x16_bf16(PAF(2), VFR(6), o[1], 0, 0, 0), C1, 4); \
    GAPB(o[0] = __builtin_amdgcn_mfma_f32_32x32x16_bf16(PAF(3), VFR(3), o[0], 0, 0, 0), C1, 8); \
    GAPB(o[1] = __builtin_amdgcn_mfma_f32_32x32x16_bf16(PAF(3), VFR(7), o[1], 0, 0, 0), C1, 12); \
    } while (0)
    int t = 1;
    const int tb = (NT - 9 > 1) ? NT - 9 : 1;
    for (; t < tb; t += 2) {
        STEP(pB0, pB1, pA0, pA1, t, true, true, true, false);         WAIT_BAR(2); RESC(); ROT();
        UPD(t + 1);
        STEP(pA0, pA1, pB0, pB1, t + 1, true, true, true, false);     WAIT_BAR(2); RESC(); ROT();
    }
#define ENDW(tt) do { if ((tt) + 3 < NT) { WAIT_BAR(2); } else if ((tt) + 2 < NT) { WAIT_BAR(1); } else { WAIT_BAR(0); } } while (0)
    for (; t + 1 < NT; t += 2) {
        STEP(pB0, pB1, pA0, pA1, t, (t + 3 < NT), (t + 1 < NT), (t + 1 < NT), true);         ENDW(t);     RESC(); BIASM(pB0, pB1, t); ROT();
        UPD(t + 1);
        STEP(pA0, pA1, pB0, pB1, t + 1, (t + 4 < NT), (t + 2 < NT), (t + 2 < NT), true);     ENDW(t + 1); RESC(); BIASM(pA0, pA1, t + 1); ROT();
    }
    STEP(pB0, pB1, pA0, pA1, NT - 1, false, false, false, true); RESC(); asm volatile("s_waitcnt lgkmcnt(0)" ::: "memory"); BIASM(pB0, pB1, NT - 1);
    { float sacc = pB0[0] + pB0[1]; _Pragma("unroll") for (int r = 2; r < 16; ++r) sacc += pB0[r]; _Pragma("unroll") for (int r = 0; r < 16; ++r) sacc += pB1[r]; l_reg += sacc;
      pw0 = (u32x4){PKW(pB0, 0), PKW(pB0, 2), PKW(pB0, 4), PKW(pB0, 6)}; pw1 = (u32x4){PKW(pB0, 8), PKW(pB0, 10), PKW(pB0, 12), PKW(pB0, 14)}; pw2 = (u32x4){PKW(pB1, 0), PKW(pB1, 2), PKW(pB1, 4), PKW(pB1, 6)}; pw3 = (u32x4){PKW(pB1, 8), PKW(pB1, 10), PKW(pB1, 12), PKW(pB1, 14)};
      SBAR(); pv(o, vb0 + sl_cur, PAF(0), PAF(1), PAF(2), PAF(3)); }
#undef PKW
#undef PAF
#undef VFR
#undef PIN
#undef MX3
#undef GAPA
#undef GAPB
#undef EX
#undef VRD
#undef KRD
#undef STEP
#undef ENDW
    { auto rr = __builtin_amdgcn_permlane32_swap(__float_as_uint(l_reg), __float_as_uint(l_reg), false, false); l_reg = __uint_as_float(rr[0]) + __uint_as_float(rr[1]); }
    if (hi == 0) wsf[32 + r32] = l_reg; asm volatile("s_waitcnt lgkmcnt(0)" ::: "memory");
    float rli[16];
#pragma unroll
    for (int r = 0; r < 16; ++r) rli[r] = __builtin_amdgcn_rcpf(wsf[32 + crow(r, hi)]);
    bf16_t* Ow = O + (rowbase + q0 + wid * QBLK) * DMA_ + h * 64;
    { LAS bf16_t* stg = (LAS bf16_t*)((LAS char*)shm + LDS_OST) + wid * 2048;
#pragma unroll
        for (int r = 0; r < 16; ++r) { const int orow = crow(r, hi);
#pragma unroll
            for (int d0 = 0; d0 < 2; ++d0) stg[orow * 64 + d0 * 32 + r32] = (bf16_t)(pk2(o[d0][r] * rli[r], 0.f) & 0xffffu); }
        asm volatile("s_waitcnt lgkmcnt(0)" ::: "memory");
#pragma unroll
        for (int i = 0; i < 4; ++i) { const int row = i * 8 + (lane >> 3), ch = lane & 7; const u32x4 v = *(const LAS u32x4*)(stg + row * 64 + ch * 8); *(u32x4*)(Ow + (long)row * DMA_ + ch * 8) = v; } }
    asm volatile("s_waitcnt lgkmcnt(0)\n\ts_barrier" ::: "memory");
#undef DMA_K
#undef DMA_V
#undef MASKS
#undef BIASM
#undef UPD
#undef MOFF
#undef START
#undef RESC
#undef ROT
}
#undef SBAR
#undef WAIT_BAR
}

DI void ssm_scan(Frame& F) {
    const float* Hloc = (const float*)(F.ws + WS_HLOC); bf16_t* Assm = (bf16_t*)(F.ws + WS_ASSM); const float* a16 = (const float*)(F.ws + WS_SMALL + 128 * 1024);
    const int gw = F.vcu * 8 + F.wave, NGW = F.G * 8, p = FLANE;
    for (int task = gw; task < 128; task += NGW) {
        const int g = task >> 2, b = task & 3;
        const float ar = a16[(g * 64 + p) * 2], ai = a16[(g * 64 + p) * 2 + 1];
        float sr = 0.f, si = 0.f;
        const float* hl = Hloc + ((size_t)g * 1024 + b * 256) * 128; bf16_t* ao = Assm + ((size_t)g * 1024 + b * 256) * 384 + 256;
        for (int c0 = 0; c0 < 256; c0 += 8) {
            float lr[8], li[8];
#pragma unroll
            for (int j = 0; j < 8; ++j) { lr[j] = hl[(size_t)(c0 + j) * 128 + p]; li[j] = hl[(size_t)(c0 + j) * 128 + 64 + p]; }
#pragma unroll
            for (int j = 0; j < 8; ++j) {
                ao[(size_t)(c0 + j) * 384 + p] = (bf16_t)(pk2(sr, 0.f) & 0xffffu); ao[(size_t)(c0 + j) * 384 + 64 + p] = (bf16_t)(pk2(si, 0.f) & 0xffffu);
                const float nr = ar * sr - ai * si + lr[j], ni = ar * si + ai * sr + li[j]; sr = nr; si = ni; }
        }
    }
}

DI void topk_tokens(Frame& F) {
    const float* scores = (const float*)(F.ws + WS_SCORES); const float* rbias = in_ptr<IN_RBIAS>();
    int* top_idx = (int*)(F.ws + WS_ROUTE); float* top_w = (float*)(F.ws + WS_ROUTE + 512 * 1024); int* rank = (int*)(F.ws + WS_ROUTE + 1024 * 1024);
    unsigned* cnt = (unsigned*)(F.ws + WS_CTL) + CW_CNT;
    LAS unsigned* lcnt = (LAS unsigned*)F.lds;
    LAS int* le = (LAS int*)(F.lds + 1024);
    LAS unsigned* lr = (LAS unsigned*)(F.lds + 3072);
    LAS float* lw = (LAS float*)(F.lds + 5120);
    const int l = FLANE, tid = FTID;
    const f32x4 rb = *(const f32x4*)(rbias + 4 * l);
    for (int blk = F.vcu; blk < M / 64; blk += F.G) {
        __syncthreads();
        if (tid < 256) lcnt[tid] = 0u;
        __syncthreads();
#pragma unroll 1
        for (int tt = 0; tt < 8; ++tt) {
            const int tl = F.wave * 8 + tt, t = blk * 64 + tl;
            const f32x4 sc = *(const f32x4*)(scores + (size_t)t * 256 + 4 * l);
            float v[4] = {sc.x + rb.x, sc.y + rb.y, sc.z + rb.z, sc.w + rb.w};
            float m1 = fmaxf(v[0], v[1]), m2 = fminf(v[0], v[1]);
            { const float a = fmaxf(v[2], v[3]), c = fminf(v[2], v[3]); const float n1 = fmaxf(m1, a), n2 = fmaxf(fminf(m1, a), fmaxf(m2, c)); m1 = n1; m2 = n2; }
#pragma unroll
            for (int o = 1; o < 8; o <<= 1) { const float o1 = __shfl_xor(m1, o), o2 = __shfl_xor(m2, o); const float n1 = fmaxf(m1, o1), n2 = fmaxf(fminf(m1, o1), fmaxf(m2, o2)); m1 = n1; m2 = n2; }
            const float gs = m1 + m2; const int myg = l >> 3; int higher = 0;
#pragma unroll
            for (int j = 0; j < 8; ++j) { const float og = __shfl(gs, 8 * j); higher += (og > gs || (og == gs && j < myg)) ? 1 : 0; }
            if (higher >= 4) { v[0] = -1e30f; v[1] = -1e30f; v[2] = -1e30f; v[3] = -1e30f; }
            int my_e = 0; float my_s = 0.f, tot = 0.f;
#pragma unroll
            for (int k = 0; k < 8; ++k) {
                float bv = v[0]; int bi = 4 * l;
                if (v[1] > bv) { bv = v[1]; bi = 4 * l + 1; } if (v[2] > bv) { bv = v[2]; bi = 4 * l + 2; } if (v[3] > bv) { bv = v[3]; bi = 4 * l + 3; }
#pragma unroll
                for (int o = 1; o < 64; o <<= 1) { const float ov = __shfl_xor(bv, o); const int oi = __shfl_xor(bi, o); if (ov > bv || (ov == bv && oi < bi)) { bv = ov; bi = oi; } }
                const float mys = (bi == 4 * l) ? sc.x : (bi == 4 * l + 1) ? sc.y : (bi == 4 * l + 2) ? sc.z : sc.w;
                const float ssel = __shfl(mys, bi >> 2);
                if (bi == 4 * l) v[0] = -3e38f; if (bi == 4 * l + 1) v[1] = -3e38f; if (bi == 4 * l + 2) v[2] = -3e38f; if (bi == 4 * l + 3) v[3] = -3e38f;
                tot += ssel; if (l == k) { my_e = bi; my_s = ssel; }
            }
            if (l < 8) { le[tl * 8 + l] = my_e; lw[tl * 8 + l] = my_s / tot * 2.5f; lr[tl * 8 + l] = __hip_atomic_fetch_add(lcnt + my_e, 1u, __ATOMIC_RELAXED, __HIP_MEMORY_SCOPE_WORKGROUP); }
        }
        __syncthreads();
        if (tid < 256) { const unsigned c = lcnt[tid]; unsigned base = 0u; if (c) base = atomicAdd(cnt + tid, c); lcnt[tid] = base; }
        __syncthreads();
        { const int e = le[tid]; const size_t gi = (size_t)blk * 512 + tid; top_idx[gi] = e; top_w[gi] = lw[tid]; rank[gi] = (int)(lr[tid] + lcnt[e]); }
    }
    __syncthreads();
}
DI int build_tiles(Frame& F) {
    const unsigned* cnt = (const unsigned*)(F.ws + WS_CTL) + CW_CNT;
    LAS unsigned* sa = (LAS unsigned*)(F.lds + SCAN_OFF); LAS unsigned* sb = sa + 256; LAS unsigned short* tile_e = (LAS unsigned short*)(F.lds + TILEE_OFF);
    LAS unsigned* misc = (LAS unsigned*)(F.lds + MISC_OFF);
    const int tid = FTID; unsigned nt = 0, cn = 0;
    __syncthreads();
    if (tid < 256) { cn = __hip_atomic_load(cnt + tid, __ATOMIC_RELAXED, __HIP_MEMORY_SCOPE_AGENT); nt = (cn + 255u) >> 8; sa[tid] = nt; }
    __syncthreads();
    LAS unsigned* src = sa; LAS unsigned* dst = sb;
    for (int o = 1; o < 256; o <<= 1) { if (tid < 256) { unsigned v = src[tid]; if (tid >= o) v += src[tid - o]; dst[tid] = v; } __syncthreads(); LAS unsigned* tmp = src; src = dst; dst = tmp; }
    if (tid < 256) { const unsigned incl = src[tid], first = incl - nt; for (unsigned k = 0; k < nt; ++k) if (first + k < MAXTILES) { tile_e[first + k] = (unsigned short)tid; const unsigned rem = cn - 256u * k; tile_e[MAXTILES + first + k] = (unsigned short)(rem > 256u ? 256u : rem); } dst[tid] = first; if (tid == 255) misc[16] = incl; }
    __syncthreads();
    if (tid < 256) sa[tid] = dst[tid];
    __syncthreads();
    int ntl = (int)misc[16]; if (ntl > MAXTILES) ntl = MAXTILES; return ntl;
}
DI void route_scatter(Frame& F) {
    const int* top_idx = (const int*)(F.ws + WS_ROUTE); const float* top_w = (const float*)(F.ws + WS_ROUTE + 512 * 1024); const int* rank = (const int*)(F.ws + WS_ROUTE + 1024 * 1024);
    int* rowoff = (int*)(F.ws + WS_ROUTE + 2 * MiB); float* roww = (float*)(F.ws + WS_ROUTE + 3 * MiB); int* dest = (int*)(F.ws + WS_ROUTE + 4 * MiB);
    (void)build_tiles(F);
    LAS unsigned* first = (LAS unsigned*)(F.lds + SCAN_OFF);
    const int gt = F.vcu * 512 + FTID, NT = F.G * 512;
    for (int i = gt; i < M * 8; i += NT) { const int e = top_idx[i]; const int pos = (int)first[e] * 256 + rank[i];
        if (pos < MAXROWS) { rowoff[pos] = (i >> 3) * (DM * 2); roww[pos] = top_w[i]; dest[pos] = i; } }
}
DI void route_clear(Frame& F) {
    int* rowoff = (int*)(F.ws + WS_ROUTE + 2 * MiB); float* roww = (float*)(F.ws + WS_ROUTE + 3 * MiB); int* dest = (int*)(F.ws + WS_ROUTE + 4 * MiB);
    const int gt = F.vcu * 512 + FTID, NT = F.G * 512;
    for (int i = gt; i < MAXROWS; i += NT) { rowoff[i] = 0; roww[i] = 0.f; dest[i] = -1; }
}
DI void combine(Frame& F) {
    const float* mod = (const float*)(F.ws + WS_SMALL); const bf16_t* ysh = (const bf16_t*)(F.ws + WS_YSH); const bf16_t* Y = (const bf16_t*)(F.ws + WS_Y);
    const int gw = F.vcu * 8 + F.wave, NGW = F.G * 8;
    for (int t = gw; t < M; t += NGW) { const int b = t / SEQ;
#pragma unroll
        for (int hf = 0; hf < 2; ++hf) { const int col = hf * 512 + FLANE * 8;
            const u32x4 s = *(const u32x4*)(ysh + (size_t)t * 1024 + col);
            float a[8] = {bflo(s.x), bfhi(s.x), bflo(s.y), bfhi(s.y), bflo(s.z), bfhi(s.z), bflo(s.w), bfhi(s.w)};
            u32x4 yv[8];
#pragma unroll
            for (int k = 0; k < 8; ++k) yv[k] = *(const u32x4*)(Y + ((size_t)t * 8 + k) * 1024 + col);
#pragma unroll
            for (int k = 0; k < 8; ++k) { a[0] += bflo(yv[k].x); a[1] += bfhi(yv[k].x); a[2] += bflo(yv[k].y); a[3] += bfhi(yv[k].y); a[4] += bflo(yv[k].z); a[5] += bfhi(yv[k].z); a[6] += bflo(yv[k].w); a[7] += bfhi(yv[k].w); }
            float* o = F.out + (size_t)t * 1024 + col; const float* g2 = mod + b * 6144 + 5120 + col;
            const f32x4 x0 = *(const f32x4*)o, x1 = *(const f32x4*)(o + 4), g0 = *(const f32x4*)g2, g1 = *(const f32x4*)(g2 + 4);
            *(f32x4*)o = x0 + g0 * (f32x4){a[0], a[1], a[2], a[3]}; *(f32x4*)(o + 4) = x1 + g1 * (f32x4){a[4], a[5], a[6], a[7]}; }
    }
}

constexpr int NPHASE = 17;
__global__ void __launch_bounds__(512, 2) mk_fwd(Args args) {
    extern __shared__ __attribute__((aligned(16))) unsigned char lds_raw[];
    Frame F;
    F.lds = (LAS unsigned char*)lds_raw; F.wave = __builtin_amdgcn_readfirstlane((int)threadIdx.x >> 6);
    F.G = gridDim.x; { const int bx = blockIdx.x; F.vcu = (F.G % 8 == 0) ? (bx % 8) * (F.G / 8) + bx / 8 : bx; }
    F.in.dummy = 0; F.out = args.out; F.ws = args.ws;
    unsigned char* ws = args.ws;
    volatile LAS unsigned* MISC = (volatile LAS unsigned*)(F.lds + MISC_OFF);
    LAS unsigned* gtab = (LAS unsigned*)(F.lds + GTAB_OFF);
    for (int u = FTID; u < 64; u += 512) MISC[u] = 0u;
    __syncthreads();
    unsigned* ctl = (unsigned*)(ws + WS_CTL);
    XcdBarrier bar; bar.bar = ctl + CW_BAR; bar.x = 0; bar.st = nullptr; bar.wave = F.wave;
    if (!MK_PER_PHASE) bar = xcd_barrier_post(ctl + CW_BAR, MISC + 8, F.wave);
    const int lo = args.ph_lo, hi = args.ph_hi;
#ifndef ONLY_PHASE
#define ONLY_PHASE -1
#endif
#define IN(k) ((ONLY_PHASE < 0 || ONLY_PHASE == (k)) && lo <= (k) && (k) < hi)
#ifndef PROBE_PHASE
#define PROBE_PHASE -1
#endif
#ifndef PROBE_AMP
#define PROBE_AMP 4
#endif
    unsigned long long pr_t0 = 0, pr_dt = 0;
#define SEAM(k) do { if (IN(k) && IN((k) + 1)) xcd_barrier(bar); \
    if (PROBE_PHASE >= 0) { if ((k) + 1 == PROBE_PHASE) pr_t0 = __builtin_amdgcn_s_memrealtime(); if ((k) == PROBE_PHASE) pr_dt = __builtin_amdgcn_s_memrealtime() - pr_t0; } } while (0)
    const int G = F.G, bx = (int)blockIdx.x;
    float* mod = (float*)(ws + WS_SMALL);

    if (PROBE_PHASE == 0) pr_t0 = __builtin_amdgcn_s_memrealtime();
    if (IN(0)) {
        if (bx < 96) p0_adaln(F, bx); else if (bx < 224) p0_ssm(F, (bx - 96) >> 2, (bx - 96) & 3);
        conv_items(F, 0, I_SMALL);
    }
    SEAM(0);
    if (IN(1)) norm_mod_rows(F, in_ptr<IN_X>(), in_ptr<IN_LN1G>(), 0, 1024, (bf16_t*)(ws + WS_H));
    SEAM(1);
    if (IN(2)) {
        pg8::Gemm g{DM, DM, DM}; DenseSched S; S.init(M, INW, G, bx, ws + WS_H, DM, ws + WS_WIN, DM);
        EpiInProj E{(bf16_t*)(ws + WS_Q), (bf16_t*)(ws + WS_K), (bf16_t*)(ws + WS_V), (bf16_t*)(ws + WS_ASSM), (bf16_t*)(ws + WS_SGA), (bf16_t*)(ws + WS_SGS), (float*)(ctl + CW_KMEAN), in_ptr<IN_QG>(), in_ptr<IN_KG>()};
        pg8::gemm_phase<EpiInProj, DenseSched, true, false>(F.lds, gtab, F.wave, g, S, E);
    }
    SEAM(2);
    if (IN(3)) {
#pragma unroll 1
        for (int ui = F.vcu * 2; ui < 512; ui += 2 * G) {
#pragma unroll 1
            for (int k2 = 0; k2 < 2; ++k2) { const int pi = ui >> 1, bh = pi >> 3, s = pi & 7, qb = k2 ? s : 15 - s;
                att::attn_unit<8>(F.wave, bh >> 3, bh & 7, qb, (const bf16_t*)(ws + WS_Q), (const bf16_t*)(ws + WS_K), (const bf16_t*)(ws + WS_V), (bf16_t*)(ws + WS_Q), (char*)lds_raw, (const float*)(ctl + CW_KMEAN), in_ptr<IN_RELB>()); } }
        __syncthreads();
        pg8::Gemm g{384, 256, 256}; SsmSched S{G, F.vcu, (const char*)(ws + WS_ASSM), (const char*)(ws + WS_ET), (size_t)256 * 256 * 2};
        EpiS1 E{(float*)(ws + WS_HLOC)};
        pg8::gemm_phase<EpiS1, SsmSched, true, false>(F.lds, gtab, F.wave, g, S, E);
    }
    SEAM(3);
    if (IN(4)) ssm_scan(F);
    SEAM(4);
    if (IN(5)) {
        pg8::Gemm g{384, 384, 384}; SsmSched S{G, F.vcu, (const char*)(ws + WS_ASSM), (const char*)(ws + WS_TF), (size_t)256 * 384 * 2};
        EpiS2 E{(const bf16_t*)(ws + WS_ASSM), in_ptr<IN_SSMD>(), (bf16_t*)(ws + WS_GBUF)};
        pg8::gemm_phase<EpiS2, SsmSched, true, false>(F.lds, gtab, F.wave, g, S, E);
    }
    SEAM(5);
    if (IN(6)) {
        pg8::Gemm g{512, 512, 512}; GluUpSched S{G, F.vcu, (const char*)(ws + WS_GBUF), (const char*)(ws + WS_WGLU), (const char*)(ws + WS_Q), (const char*)(ws + WS_WUPA)};
        EpiGluUp E{(const bf16_t*)(ws + WS_GBUF), in_ptr<IN_BGLU>(), (bf16_t*)(ws + WS_SOUT), (const bf16_t*)(ws + WS_SGA), (bf16_t*)(ws + WS_P1)};
        pg8::gemm_phase<EpiGluUp, GluUpSched, true, false>(F.lds, gtab, F.wave, g, S, E);
    }
    SEAM(6);
    if (IN(7)) {
        pg8::Gemm g{512, 512, 512}; DenseSched S; S.init(M, DM, G, bx, ws + WS_SOUT, 512, ws + WS_WUPS, 512);
        EpiUp2 E{(const bf16_t*)(ws + WS_P1), (const bf16_t*)(ws + WS_SGS), (bf16_t*)(ws + WS_MIX)};
        pg8::gemm_phase<EpiUp2, DenseSched, true, false>(F.lds, gtab, F.wave, g, S, E);
    }
    SEAM(7);
    if (IN(8)) {
        pg8::Gemm g{DM, DM, DM}; DenseSched S; S.init(M, DM, G, bx, ws + WS_MIX, DM, ws + WS_WOUT, DM);
        EpiOut E{in_ptr<IN_X>(), mod, F.out};
        pg8::gemm_phase<EpiOut, DenseSched, true, false>(F.lds, gtab, F.wave, g, S, E);
    }
    SEAM(8);
    if (IN(9)) norm_mod_rows(F, F.out, in_ptr<IN_LN2G>(), 3072, 4096, (bf16_t*)(ws + WS_H));
    SEAM(9);
    if (IN(10)) {
        pg8::Gemm g{DM, DM, DM}; DenseSched S; S.init(M, 768, G, bx, ws + WS_H, DM, ws + WS_WRSH, DM);
        EpiRsh E{(float*)(ws + WS_SCORES), (bf16_t*)(ws + WS_HS)};
        pg8::gemm_phase<EpiRsh, DenseSched, true, false>(F.lds, gtab, F.wave, g, S, E);
    }
    SEAM(10);
    if (IN(11)) {
        route_clear(F);
        topk_tokens(F);
        __syncthreads();
        pg8::Gemm g{ED, ED, ED}; DenseSched S; S.init(M, DM, G, bx, ws + WS_HS, ED, ws + WS_WSHD, ED);
        EpiBf16 E{(bf16_t*)(ws + WS_YSH), 1024};
        pg8::gemm_phase<EpiBf16, DenseSched, true, false>(F.lds, gtab, F.wave, g, S, E);
    }
    SEAM(11);
    if (IN(12)) { route_scatter(F); conv_items(F, I_SMALL, I_SMALL + I_EG + I_EU); }
    SEAM(12);
    if (IN(13)) {
        const int ntl = build_tiles(F);
        pg8::Gemm g{DM, DM, DM};
        MoeSched S{G, F.vcu, 2, ntl, (const LAS unsigned short*)(F.lds + TILEE_OFF), (const char*)(ws + WS_H), (const char*)(ws + WS_WEGU), 0, (size_t)512 * DM * 2, (size_t)256 * DM * 2, (const int*)(ws + WS_ROUTE + 2 * MiB)};
        EpiMoe1 E{(bf16_t*)(ws + WS_HSORT)};
        pg8::gemm_phase<EpiMoe1, MoeSched, true, true>(F.lds, gtab, F.wave, g, S, E);
        conv_items(F, I_SMALL + I_EG + I_EU, NITEMS);
    }
    SEAM(13);
    if (IN(14)) {
        const int ntl = build_tiles(F);
        pg8::Gemm g{ED, ED, ED};
        MoeSched S{G, F.vcu, 4, ntl, (const LAS unsigned short*)(F.lds + TILEE_OFF), (const char*)(ws + WS_HSORT), (const char*)(ws + WS_WED), (size_t)256 * ED * 2, (size_t)DM * ED * 2, (size_t)256 * ED * 2, nullptr};
        EpiMoe2 E{(const int*)(ws + WS_ROUTE + 4 * MiB), (const float*)(ws + WS_ROUTE + 3 * MiB), (bf16_t*)(ws + WS_Y)};
        pg8::gemm_phase<EpiMoe2, MoeSched, true, false>(F.lds, gtab, F.wave, g, S, E);
    }
    SEAM(14);
    if (IN(15)) combine(F);
    if (PROBE_PHASE >= 0) { if (PROBE_PHASE == 15) { asm volatile("s_waitcnt vmcnt(0)" ::: "memory"); pr_dt = __builtin_amdgcn_s_memrealtime() - pr_t0; }
        if (blockIdx.x == 0) { const unsigned long long te = __builtin_amdgcn_s_memrealtime(); while (__builtin_amdgcn_s_memrealtime() - te < (unsigned long long)PROBE_AMP * pr_dt) __builtin_amdgcn_s_sleep(8); } }
#undef IN
#undef SEAM
}

extern "C" void kernel_launch(void* const* d_in, const int* in_sizes, int n_in, void* d_out, int out_size, void* d_ws, size_t ws_size, hipStream_t stream) {
    static int grid = 0;
    if (grid == 0) {
        if (n_in != 31 || out_size != M * DM || ws_size < WS_END) { fprintf(stderr, "kernel_launch: unexpected shapes (n_in %d out %d ws %zu)\n", n_in, out_size, ws_size); grid = -1; return; }
        int dev = 0, cus = 0;
        if (hipGetDevice(&dev) != hipSuccess || hipDeviceGetAttribute(&cus, hipDeviceAttributeMultiprocessorCount, dev) != hipSuccess) { grid = -1; return; }
        if (hipFuncSetAttribute((const void*)mk_fwd, hipFuncAttributeMaxDynamicSharedMemorySize, LDS_BYTES) != hipSuccess) { fprintf(stderr, "kernel_launch: hipFuncSetAttribute failed\n"); grid = -1; return; }
        int per_cu = 0;
        if (hipOccupancyMaxActiveBlocksPerMultiprocessor(&per_cu, (const void*)mk_fwd, 512, LDS_BYTES) != hipSuccess || per_cu < 1) fprintf(stderr, "kernel_launch: occupancy query says %d\n", per_cu);
        (void)hipGetLastError();
        grid = cus;
    }
    if (grid < 0) return;
    (void)hipMemsetAsync((char*)d_ws + WS_CTL, 0, CTL_ZERO_BYTES, stream);
    Args a{};
    for (int i = 0; i < 31; ++i) a.in[i] = (const float*)d_in[i];
    a.out = (float*)d_out; a.ws = (unsigned char*)d_ws;
#if MK_PER_PHASE
    for (int p = 0; p < NPHASE; ++p) { a.ph_lo = p; a.ph_hi = p + 1; hipLaunchKernelGGL(mk_fwd, dim3(grid), dim3(512), LDS_BYTES, stream, a); }
#else
    a.ph_lo = 0; a.ph_hi = NPHASE;
    hipLaunchKernelGGL(mk_fwd, dim3(grid), dim3(512), LDS_BYTES, stream, a);
#endif
}
```

```cpp
#include <hip/hip_runtime.h>
#include <cstdio>
#include <cstdint>

#ifndef MK_PER_PHASE
#define MK_PER_PHASE 0
#endif

#define LAS __attribute__((address_space(3)))
#define GAS __attribute__((address_space(1)))
typedef unsigned short bf16_t;
typedef short bf16x8 __attribute__((ext_vector_type(8)));
typedef short s16x4 __attribute__((ext_vector_type(4)));
typedef float f32x2 __attribute__((ext_vector_type(2)));
typedef float f32x4 __attribute__((ext_vector_type(4)));
typedef float f32x16 __attribute__((ext_vector_type(16)));
typedef unsigned u32x2 __attribute__((ext_vector_type(2)));
typedef unsigned u32x4 __attribute__((ext_vector_type(4)));
typedef __bf16 bf16x2_t __attribute__((ext_vector_type(2)));

#define DI __device__ __forceinline__
DI unsigned pk2(float lo, float hi) { f32x2 v = {lo, hi}; bf16x2_t b = __builtin_convertvector(v, bf16x2_t); return __builtin_bit_cast(unsigned, b); }
DI float bflo(unsigned w) { return __uint_as_float(w << 16); }
DI float bfhi(unsigned w) { return __uint_as_float(w & 0xffff0000u); }
DI float sigmoidf_(float x) { return 1.0f / (1.0f + __expf(-x)); }
DI float siluf_(float x) { return x / (1.0f + __expf(-x)); }
DI float gelu_tanh(float y) { const float z = 0.7978845608028654f * (y + 0.044715f * y * y * y); const float t = 1.0f - 2.0f / (__expf(2.0f * z) + 1.0f); return 0.5f * y * (1.0f + t); }

constexpr int NB = 4, SEQ = 4096, DM = 1024, M = NB * SEQ;
constexpr int NH = 8, HD = 64, AW = 512, SW = 512, INW = 4096;
constexpr int NE = 256, ED = 256, TOPK = 8;
constexpr int NG = 32, GC = 16, NS = 64, CH = 16, NCH = SEQ / CH;
constexpr int MAXTILES = 768, MAXROWS = MAXTILES * 256;
constexpr float EPSF = 1e-6f;
constexpr float LOG2E = 1.4426950408889634f;
constexpr float QC2 = 0.125f * LOG2E;

constexpr size_t MiB = 1u << 20;
constexpr size_t WS_CTL = 0, CTL_ZERO_BYTES = 1 * MiB;
constexpr size_t WS_SMALL = 1 * MiB;
constexpr size_t WS_WIN = 4 * MiB, WS_WGLU = 12 * MiB, WS_WUPA = 13 * MiB, WS_WUPS = 14 * MiB, WS_WOUT = 15 * MiB, WS_WRSH = 17 * MiB, WS_WSHD = 19 * MiB;
constexpr size_t WS_TF = 20 * MiB, WS_ET = 26 * MiB;
constexpr size_t WS_WEGU = 32 * MiB, WS_WED = 288 * MiB;
constexpr size_t WS_H = 416 * MiB;
constexpr size_t WS_Q = 448 * MiB, WS_K = 464 * MiB, WS_V = 480 * MiB;
constexpr size_t WS_ASSM = 496 * MiB, WS_HLOC = 520 * MiB;
constexpr size_t WS_GBUF = 536 * MiB, WS_SOUT = 552 * MiB;
constexpr size_t WS_SGA = 568 * MiB, WS_SGS = 600 * MiB;
constexpr size_t WS_P1 = 632 * MiB, WS_MIX = 664 * MiB;
constexpr size_t WS_SCORES = 696 * MiB, WS_HS = 712 * MiB, WS_YSH = 720 * MiB;
constexpr size_t WS_ROUTE = 752 * MiB;
constexpr size_t WS_HSORT = 760 * MiB;
constexpr size_t WS_Y = 416 * MiB;
constexpr size_t WS_END = 856 * MiB;
constexpr int CW_BAR = 4096;
constexpr int CW_CNT = 16384;
constexpr int CW_KMEAN = 32768;

constexpr int RING_BYTES = 131072;
constexpr int GTAB_OFF = RING_BYTES;
constexpr int TILEE_OFF = GTAB_OFF + 2048;
constexpr int SCAN_OFF = TILEE_OFF + 3072;
constexpr int MISC_OFF = SCAN_OFF + 2048;
constexpr int LDS_BYTES = 147456;
static_assert(MISC_OFF + 256 <= LDS_BYTES, "LDS map");

namespace pg8 {
constexpr int BM = 256, BK = 64, HALF = 128, HTB = HALF * BK * 2, STAGE_BYTES = 8 * HTB, NXCD = 8, WGM = 8;
__host__ __device__ __forceinline__ int lds_byte(int r, int c) { const int st = (r >> 4) * 2 + (c >> 5), rr = r & 15, cc = c & 31, ob = rr * 64 + cc * 2; return st * 1024 + (ob ^ (((ob >> 9) & 1) << 5)); }
__host__ __device__ __forceinline__ void stage_rc(int b, int& R, int& C) { const int st = b / 1024, sb = b % 1024, swz = sb ^ (((sb >> 9) & 1) << 5); R = (st >> 1) * 16 + swz / 64; C = (st & 1) * 32 + (swz % 64) / 2; }
__host__ __device__ __forceinline__ int perm32(int rho) { const int n = rho >> 4, i = rho & 15; return 8 * (i >> 2) + 4 * n + (i & 3); }

struct Unit { const char* A; const char* B; const int* rowtab; int pm, pn, aux, half; };
struct Gemm { int lda, ldb, K; };

struct StaticOrder {
    int nM, nN, nwg, G, c;
    __device__ void init(int M_, int N_, int G_, int c_) { nM = M_ / BM; nN = N_ / BM; nwg = nM * nN; G = G_; c = c_; }
    __device__ bool next(int i, int& pm, int& pn) const {
        const long L = (long)i * G + c; if (L >= nwg) return false;
        int wgid = (int)L; { const int q = nwg / NXCD, r = nwg % NXCD, xcd = wgid % NXCD, off = wgid / NXCD; wgid = (xcd < r ? xcd * (q + 1) : r * (q + 1) + (xcd - r) * q) + off; }
        const int nig = WGM * nN, gid = wgid / nig, fm = gid * WGM, gsz = (nM - fm) < WGM ? (nM - fm) : WGM;
        pm = fm + ((wgid % nig) % gsz); pn = (wgid % nig) / gsz; return true;
    }
};

template <class Epi, class Sched, bool ALIGN_EPI, bool GATHER>
__device__ __forceinline__ void gemm_phase(LAS unsigned char* lds, LAS unsigned* gtab, const int wid, const Gemm g, const Sched& S, const Epi& E) {
    const int lane = (int)__builtin_amdgcn_mbcnt_hi(~0u, __builtin_amdgcn_mbcnt_lo(~0u, 0u)), tid = wid * 64 + lane, wr = wid >> 2, wc = wid & 3, fr = lane & 15, fq = lane >> 4;
    const int K = g.K, nt = K / BK;
    unsigned voffA[2], voffB[2]; int gR[2];
#pragma unroll
    for (int i = 0; i < 2; ++i) { int R, C; stage_rc(tid * 16 + i * 8192, R, C); const int Rb = Epi::PERM ? ((R & ~31) + perm32(R & 31)) : R;
        voffA[i] = GATHER ? (unsigned)(C * 2) : (unsigned)(R * g.lda + C) * 2u; voffB[i] = (unsigned)(Rb * g.ldb + C) * 2u; gR[i] = R; }
    const size_t kstep = (size_t)(BK * 2);
    const size_t hstepA = (size_t)HALF * g.lda * 2, hstepB = (size_t)HALF * g.ldb * 2;
    const unsigned ldsw = (unsigned)wid * 1024u;
    const int aoff = lds_byte(wr * 64 + fr, fq * 8), boff = lds_byte(wc * 32 + fr, fq * 8);
#define PG8_SA(b, h) (((b) * 2 + (h)) * HTB)
#define PG8_SB(b, h) ((4 + (b) * 2 + (h)) * HTB)
#define PG8_STAGEB(bufoff, gbase) do { _Pragma("unroll") for (int _i = 0; _i < 2; ++_i) \
        __builtin_amdgcn_global_load_lds((const unsigned*)((const char*)(gbase) + voffB[_i]), (LAS unsigned*)(lds + (bufoff) + ldsw + _i * 8192), 16, 0, 0); } while (0)
#define PG8_STAGEA(bufoff, gbase, par, half) do { _Pragma("unroll") for (int _i = 0; _i < 2; ++_i) { \
        const char* _src = GATHER ? ((const char*)(gbase) + gtab[(par) * 256 + (half) * 128 + gR[_i]] + voffA[_i]) : ((const char*)(gbase) + (size_t)(half) * hstepA + voffA[_i]); \
        __builtin_amdgcn_global_load_lds((const unsigned*)_src, (LAS unsigned*)(lds + (bufoff) + ldsw + _i * 8192), 16, 0, 0); } } while (0)
#define PG8_TABLOAD(par, un) do { __builtin_amdgcn_global_load_lds((const unsigned*)((un).rowtab + 64 * (wid & 3) + lane), (LAS unsigned*)(gtab + (par) * 256 + 64 * (wid & 3)), 4, 0, 0); } while (0)
#define PG8_LDA(dst, b, h) do { _Pragma("unroll") for (int m = 0; m < 4; ++m) _Pragma("unroll") for (int k = 0; k < 2; ++k) dst[m][k] = *(const LAS bf16x8*)(lds + PG8_SA(b, h) + aoff + m * 2048 + k * 1024); } while (0)
#define PG8_LDB(dst, b, h) do { _Pragma("unroll") for (int n = 0; n < 2; ++n) _Pragma("unroll") for (int k = 0; k < 2; ++k) dst[n][k] = *(const LAS bf16x8*)(lds + PG8_SB(b, h) + boff + n * 2048 + k * 1024); } while (0)
#define PG8_MMA(ai, bj, At, Bt) do { __builtin_amdgcn_s_setprio(1); _Pragma("unroll") for (int m = 0; m < 4; ++m) _Pragma("unroll") for (int n = 0; n < 2; ++n) _Pragma("unroll") for (int k = 0; k < 2; ++k) \
        acc[ai][bj][m][n] = __builtin_amdgcn_mfma_f32_16x16x32_bf16(Bt[n][k], At[m][k], acc[ai][bj][m][n], 0, 0, 0); __builtin_amdgcn_s_setprio(0); } while (0)
#define PG8_WAIT_V(n) asm volatile("s_waitcnt vmcnt(" #n ")" ::: "memory")
#define PG8_WAIT_L(n) asm volatile("s_waitcnt lgkmcnt(" #n ")" ::: "memory")
#define PG8_BAR __builtin_amdgcn_s_barrier()
#define PG8_SCHED __builtin_amdgcn_sched_barrier(0)
    Unit cur, nxt; int ui = 0;
    if (!S.next(0, cur)) return;
    f32x4 acc[2][2][4][2];
#pragma unroll
    for (int a = 0; a < 2; ++a)
#pragma unroll
        for (int b = 0; b < 2; ++b)
#pragma unroll
            for (int m = 0; m < 4; ++m)
#pragma unroll
                for (int n = 0; n < 2; ++n) acc[a][b][m][n] = (f32x4){0.f, 0.f, 0.f, 0.f};
    bf16x8 At[4][2], B0[2][2], B1[2][2];
    const char* cA = cur.A; const char* cB = cur.B;
    if constexpr (GATHER) { PG8_TABLOAD(0, cur); PG8_WAIT_V(0); PG8_BAR; }
    PG8_STAGEB(PG8_SB(0, 0), cB); PG8_STAGEB(PG8_SB(0, 1), cB + hstepB); PG8_STAGEA(PG8_SA(0, 0), cA, 0, 0); PG8_STAGEA(PG8_SA(0, 1), cA, 0, 1);
    if (wr == 1) PG8_BAR;
    PG8_WAIT_V(2); PG8_BAR;
    PG8_STAGEB(PG8_SB(1, 0), cB + kstep); PG8_STAGEA(PG8_SA(1, 0), cA + kstep, 0, 0); PG8_STAGEB(PG8_SB(1, 1), cB + hstepB + kstep);
    PG8_WAIT_V(6); PG8_BAR;
    for (;;) {
        const bool has_next = S.next(ui + 1, nxt);
        const char* nA = has_next ? nxt.A : cA; const char* nB = has_next ? nxt.B : cB;
        const int pc = ui & 1, pnx = has_next ? (pc ^ 1) : pc;
        if constexpr (GATHER) { if (has_next) PG8_TABLOAD(pc ^ 1, nxt); }
#pragma unroll 1
        for (int t = 0; t < nt; t += 2) {
            const bool last = (t == nt - 2);
            const char* a1 = cA + (size_t)(t + 1) * kstep;
            const char* a2 = last ? nA : cA + (size_t)(t + 2) * kstep; const char* b2 = last ? nB : cB + (size_t)(t + 2) * kstep;
            const char* a3 = a2 + kstep; const char* b3 = b2 + kstep;
            const int p2 = last ? pnx : pc;
            PG8_LDB(B0, 0, 0); PG8_LDB(B1, 0, 1); PG8_SCHED; PG8_LDA(At, 0, 0); PG8_STAGEA(PG8_SA(1, 1), a1, pc, 1);
            PG8_WAIT_V(8); PG8_WAIT_L(0); PG8_BAR; PG8_MMA(0, 0, At, B0); PG8_MMA(0, 1, At, B1); PG8_BAR; PG8_SCHED;
            PG8_LDA(At, 0, 1); PG8_STAGEB(PG8_SB(0, 0), b2); PG8_STAGEB(PG8_SB(0, 1), b2 + hstepB); PG8_STAGEA(PG8_SA(0, 0), a2, p2, 0);
            PG8_WAIT_V(8); PG8_WAIT_L(0); PG8_BAR; if (!cur.half) { PG8_MMA(1, 0, At, B0); PG8_MMA(1, 1, At, B1); } PG8_BAR; PG8_SCHED;
            PG8_LDB(B0, 1, 0); PG8_LDB(B1, 1, 1); PG8_SCHED; PG8_LDA(At, 1, 0); PG8_STAGEA(PG8_SA(0, 1), a2, p2, 1);
            PG8_WAIT_V(8); PG8_WAIT_L(0); PG8_BAR; PG8_MMA(0, 0, At, B0); PG8_MMA(0, 1, At, B1); PG8_BAR; PG8_SCHED;
            PG8_LDA(At, 1, 1); PG8_STAGEB(PG8_SB(1, 0), b3); PG8_STAGEB(PG8_SB(1, 1), b3 + hstepB); PG8_STAGEA(PG8_SA(1, 0), a3, p2, 0);
            PG8_WAIT_V(8); PG8_WAIT_L(0); PG8_BAR; if (!cur.half) { PG8_MMA(1, 0, At, B0); PG8_MMA(1, 1, At, B1); } PG8_BAR; PG8_SCHED;
        }
        if constexpr (ALIGN_EPI) { if (wr == 0) PG8_BAR; }
        { int fr_ = fr, fq_ = fq; asm volatile("" : "+v"(fr_), "+v"(fq_)); E(acc, cur, wr, wc, fr_, fq_); }
        if (!has_next) break;
#pragma unroll
        for (int a = 0; a < 2; ++a)
#pragma unroll
            for (int b = 0; b < 2; ++b)
#pragma unroll
                for (int m = 0; m < 4; ++m)
#pragma unroll
                    for (int n = 0; n < 2; ++n) acc[a][b][m][n] = (f32x4){0.f, 0.f, 0.f, 0.f};
        cur = nxt; cA = nA; cB = nB; ++ui;
        if constexpr (ALIGN_EPI) { if (wr == 1) PG8_BAR; }
    }
    PG8_WAIT_V(0);
    if constexpr (!ALIGN_EPI) { if (wr == 0) PG8_BAR; }
    PG8_BAR;
#undef PG8_SA
#undef PG8_SB
#undef PG8_STAGEA
#undef PG8_STAGEB
#undef PG8_TABLOAD
#undef PG8_LDA
#undef PG8_LDB
#undef PG8_MMA
#undef PG8_WAIT_V
#undef PG8_WAIT_L
#undef PG8_BAR
#undef PG8_SCHED
}
}

typedef f32x4 AccT[2][2][4][2];
using pg8::Unit;

typedef GAS unsigned gu32;
#define XB_TMO      128
#define XB_XCNT(j)  (256  + 64 * (j))
#define XB_XSUB(j)  (1280 + 64 * (j))
#define XB_XGEN(j)  (2304 + 64 * (j))
#define XB_TOP      3328
#define XB_TOPGEN   3392
#define XCD_BAR_WORDS 3456
#define XB_SPIN_CAP (1u << 20)
DI unsigned xb_ld(unsigned* p)              { return __hip_atomic_load(p, __ATOMIC_RELAXED, __HIP_MEMORY_SCOPE_AGENT); }
DI unsigned xb_add(unsigned* p, unsigned v) { return __hip_atomic_fetch_add(p, v, __ATOMIC_RELAXED, __HIP_MEMORY_SCOPE_AGENT); }
DI unsigned xb_xcc_id() { return (unsigned)__builtin_amdgcn_s_getreg((3 << 11) | 20) & 0xFu; }
#define XB_SPIN(cond, bar) do { unsigned _sp = 0; while (cond) { __builtin_amdgcn_s_sleep(1); \
    if ((++_sp & 255u) == 0u) { if (xb_ld(&(bar)[XB_TMO])) break; if (_sp > XB_SPIN_CAP) { atomicAdd(&(bar)[XB_TMO], 1u); break; } } } } while (0)
DI int lane_id() { int l = (int)__builtin_amdgcn_mbcnt_hi(~0u, __builtin_amdgcn_mbcnt_lo(~0u, 0u)); asm volatile("" : "+v"(l)); return l; }
struct XcdBarrier { unsigned* bar; unsigned x; volatile LAS unsigned* st; int wave; };
DI XcdBarrier xcd_barrier_post(unsigned* bar, volatile LAS unsigned* st, int wave) {
    XcdBarrier b; b.bar = bar; b.x = xb_xcc_id(); b.st = st; b.wave = wave;
    if (wave == 0 && lane_id() == 0) (void)xb_add(&bar[XB_XCNT(b.x)], 1u);
    return b;
}
DI void xcd_barrier_complete(unsigned* bar, unsigned x, unsigned& nloc, unsigned& nx) {
    const unsigned G = gridDim.x * gridDim.y * gridDim.z;
    unsigned sum, cnt, mine, sp = 0u;
    for (;;) {
        sum = 0u; cnt = 0u; mine = 0u;
#pragma unroll
        for (unsigned j = 0; j < 16; ++j) { const unsigned c = xb_ld(&bar[XB_XCNT(j)]); sum += c; cnt += (c > 0u) ? 1u : 0u; mine = (j == x) ? c : mine; }
        if (sum == G) break;
        __builtin_amdgcn_s_sleep(1);
        if ((++sp & 255u) == 0u) { if (xb_ld(&bar[XB_TMO])) break; if (sp > XB_SPIN_CAP) { atomicAdd(&bar[XB_TMO], 1u); break; } }
    }
    nloc = mine > 0u ? mine : 1u; nx = cnt > 0u ? cnt : 1u;
}
DI void xcd_barrier(const XcdBarrier& b) {
    asm volatile("s_waitcnt vmcnt(0)" ::: "memory");
    __syncthreads();
    if (b.wave == 0 && lane_id() == 0) {
        unsigned* bar = b.bar;
        __builtin_amdgcn_s_waitcnt(0);
        unsigned nloc = b.st[0], nx = b.st[1];
        if (nloc == 0u) { xcd_barrier_complete(bar, b.x, nloc, nx); b.st[0] = nloc; b.st[1] = nx; }
        const unsigned old = xb_add(&bar[XB_XSUB(b.x)], 1u);
        const unsigned gen = old / nloc;
        if (old + 1u == (gen + 1u) * nloc) {
            __builtin_amdgcn_fence(__ATOMIC_RELEASE, "agent");
            asm volatile("s_waitcnt vmcnt(0)" ::: "memory");
            const unsigned og = xb_add(&bar[XB_TOP], 1u);
            const unsigned tg = og / nx;
            if (og + 1u == (tg + 1u) * nx) xb_add(&bar[XB_TOPGEN], 1u);
            else XB_SPIN(xb_ld(&bar[XB_TOPGEN]) == tg, bar);
            __builtin_amdgcn_fence(__ATOMIC_ACQUIRE, "agent");
            xb_add(&bar[XB_XGEN(b.x)], 1u);
            asm volatile("s_waitcnt vmcnt(0)" ::: "memory");
        } else {
            XB_SPIN(xb_ld(&bar[XB_XGEN(b.x)]) == gen, bar);
            __builtin_amdgcn_fence(__ATOMIC_ACQUIRE, "agent");
            asm volatile("s_waitcnt vmcnt(0)" ::: "memory");
        }
    }
    __syncthreads();
}

struct Args { const float* in[31]; float* out; unsigned char* ws; int ph_lo, ph_hi; };
template <int I> DI const float* in_ptr() { const void* kp = (const void*)__builtin_amdgcn_kernarg_segment_ptr(); unsigned long long r;
    asm volatile("s_load_dwordx2 %0, %1, %2\n\ts_waitcnt lgkmcnt(0)" : "=s"(r) : "s"(kp), "i"(I * 8)); return (const float*)(const GAS float*)r; }
struct InTab { int dummy; };
struct Frame {
    LAS unsigned char* lds; int wave, vcu, G;
    InTab in; float* out; unsigned char* ws;
    DI int lane_() const { return lane_id(); }
    DI int tid_() const { return wave * 64 + lane_id(); }
};
#define FTID (F.tid_())
#define FLANE (F.lane_())
#define IN_X 0
#define IN_C 1
#define IN_RELB 2
#define IN_WADA 3
#define IN_BADA 4
#define IN_LN1G 5
#define IN_WIN 6
#define IN_QG 7
#define IN_KG 8
#define IN_LRE 9
#define IN_LIM 10
#define IN_LDT 11
#define IN_BRE 12
#define IN_BIM 13
#define IN_CRE 14
#define IN_CIM 15
#define IN_SSMD 16
#define IN_WGLU 17
#define IN_BGLU 18
#define IN_WUPA 19
#define IN_WUPS 20
#define IN_WOUT 21
#define IN_LN2G 22
#define IN_WROUTER 23
#define IN_RBIAS 24
#define IN_WEG 25
#define IN_WEU 26
#define IN_WED 27
#define IN_WSG 28
#define IN_WSU 29
#define IN_WSD 30

DI float wave_sum(float v) {
#pragma unroll
    for (int o = 1; o < 64; o <<= 1) v += __shfl_xor(v, o);
    return v;
}

template <class RowMap>
DI void tr_item(const float* W, int N, bf16_t* WT, int ldt, int k0, int n0, int lane, RowMap rm) {
    f32x4 v[32];
    const f32x4* src = (const f32x4*)(W + (size_t)k0 * N + n0) + lane;
#pragma unroll
    for (int i = 0; i < 32; ++i) v[i] = src[(size_t)i * (N / 4)];
#pragma unroll
    for (int c = 0; c < 4; ++c) {
        bf16_t* dst = WT + (size_t)rm(n0 + 4 * lane + c) * ldt + k0;
#pragma unroll
        for (int j = 0; j < 4; ++j) { u32x4 o; o.x = pk2(v[8 * j][c], v[8 * j + 1][c]); o.y = pk2(v[8 * j + 2][c], v[8 * j + 3][c]); o.z = pk2(v[8 * j + 4][c], v[8 * j + 5][c]); o.w = pk2(v[8 * j + 6][c], v[8 * j + 7][c]);
            *(u32x4*)(dst + 8 * j) = o; } }
}
struct RmGen { int kind, base; DI int operator()(int n) const { if (kind == 0) return base + n;
    if (kind == 1) { if (n >= 1024) return n; const int tile = n >> 8, w = n & 255, hh = w >> 6, bj = (w >> 5) & 1, i = w & 31; return tile * 256 + 128 * bj + 32 * hh + i; }
    return base + 256 * (n >> 7) + (n & 127); } };
constexpr int I_WIN = 32 * 16, I_GLU = 16 * 2, I_UPA = 16 * 4, I_UPS = 16 * 4, I_OUT = 32 * 4, I_RT = 32, I_SG = 32, I_SU = 32, I_SD = 8 * 4;
constexpr int I_SMALL = I_WIN + I_GLU + I_UPA + I_UPS + I_OUT + I_RT + I_SG + I_SU + I_SD;
constexpr int I_EG = 256 * 32, I_EU = 256 * 32, I_EDN = 256 * 32;
constexpr int NITEMS = I_SMALL + I_EG + I_EU + I_EDN;
DI void conv_items(Frame& F, int lo, int hi) {
    const int gw = F.vcu * 8 + F.wave, NGW = F.G * 8, lane = FLANE;
    unsigned char* ws = F.ws;
#pragma unroll 1
    for (int it = lo + gw; it < hi; it += NGW) {
        int r = it; const float* W; int N, ldt, k0, n0; bf16_t* WT; RmGen rm{0, 0};
        if (r < I_WIN) { W = in_ptr<IN_WIN>(); N = INW; WT = (bf16_t*)(ws + WS_WIN); ldt = DM; k0 = 32 * (r / 16); n0 = 256 * (r % 16); rm.kind = 1; }
        else if ((r -= I_WIN) < I_GLU) { W = in_ptr<IN_WGLU>(); N = SW; WT = (bf16_t*)(ws + WS_WGLU); ldt = SW; k0 = 32 * (r / 2); n0 = 256 * (r % 2); }
        else if ((r -= I_GLU) < I_UPA) { W = in_ptr<IN_WUPA>(); N = DM; WT = (bf16_t*)(ws + WS_WUPA); ldt = AW; k0 = 32 * (r / 4); n0 = 256 * (r % 4); }
        else if ((r -= I_UPA) < I_UPS) { W = in_ptr<IN_WUPS>(); N = DM; WT = (bf16_t*)(ws + WS_WUPS); ldt = SW; k0 = 32 * (r / 4); n0 = 256 * (r % 4); }
        else if ((r -= I_UPS) < I_OUT) { W = in_ptr<IN_WOUT>(); N = DM; WT = (bf16_t*)(ws + WS_WOUT); ldt = DM; k0 = 32 * (r / 4); n0 = 256 * (r % 4); }
        else if ((r -= I_OUT) < I_RT) { W = in_ptr<IN_WROUTER>(); N = NE; WT = (bf16_t*)(ws + WS_WRSH); ldt = DM; k0 = 32 * r; n0 = 0; }
        else if ((r -= I_RT) < I_SG) { W = in_ptr<IN_WSG>(); N = ED; WT = (bf16_t*)(ws + WS_WRSH); ldt = DM; k0 = 32 * r; n0 = 0; rm.kind = 2; rm.base = 256; }
        else if ((r -= I_SG) < I_SU) { W = in_ptr<IN_WSU>(); N = ED; WT = (bf16_t*)(ws + WS_WRSH); ldt = DM; k0 = 32 * r; n0 = 0; rm.kind = 2; rm.base = 256 + 128; }
        else if ((r -= I_SU) < I_SD) { W = in_ptr<IN_WSD>(); N = DM; WT = (bf16_t*)(ws + WS_WSHD); ldt = ED; k0 = 32 * (r / 4); n0 = 256 * (r % 4); }
        else if ((r -= I_SD) < I_EG) { const int e = r / 32, q = r % 32; W = in_ptr<IN_WEG>() + (size_t)e * DM * ED; N = ED; WT = (bf16_t*)(ws + WS_WEGU) + (size_t)e * 512 * DM; ldt = DM; k0 = 32 * q; n0 = 0; rm.kind = 2; }
        else if ((r -= I_EG) < I_EU) { const int e = r / 32, q = r % 32; W = in_ptr<IN_WEU>() + (size_t)e * DM * ED; N = ED; WT = (bf16_t*)(ws + WS_WEGU) + (size_t)e * 512 * DM; ldt = DM; k0 = 32 * q; n0 = 0; rm.kind = 2; rm.base = 128; }
        else { r -= I_EU; const int e = r / 32, q = r % 32; W = in_ptr<IN_WED>() + (size_t)e * ED * DM; N = DM; WT = (bf16_t*)(ws + WS_WED) + (size_t)e * DM * ED; ldt = ED; k0 = 32 * (q / 4); n0 = 256 * (q % 4); }
        tr_item(W, N, WT, ldt, k0, n0, lane, rm);
    }
}
DI void p0_adaln(Frame& F, int cb) {
    LAS float* sc = (LAS float*)F.lds;
    LAS float* red = (LAS float*)(F.lds + 16384);
    for (int i = FTID; i < 4096; i += 512) sc[i] = siluf_(in_ptr<IN_C>()[i]);
    __syncthreads();
    const int j = cb * 64 + FLANE; const float* w = in_ptr<IN_WADA>() + j;
    float a0 = 0.f, a1 = 0.f, a2 = 0.f, a3 = 0.f;
    const int kb = F.wave * 128;
#pragma unroll 32
    for (int k = 0; k < 128; ++k) { const float wv = w[(size_t)(kb + k) * 6144]; a0 += sc[kb + k] * wv; a1 += sc[1024 + kb + k] * wv; a2 += sc[2048 + kb + k] * wv; a3 += sc[3072 + kb + k] * wv; }
    red[(F.wave * 4 + 0) * 64 + FLANE] = a0; red[(F.wave * 4 + 1) * 64 + FLANE] = a1; red[(F.wave * 4 + 2) * 64 + FLANE] = a2; red[(F.wave * 4 + 3) * 64 + FLANE] = a3;
    __syncthreads();
    if (FTID < 256) { const int b = FTID >> 6, l = FTID & 63; float s = in_ptr<IN_BADA>()[cb * 64 + l];
#pragma unroll
        for (int w8 = 0; w8 < 8; ++w8) s += red[(w8 * 4 + b) * 64 + l];
        ((float*)(F.ws + WS_SMALL))[b * 6144 + cb * 64 + l] = s; }
    __syncthreads();
}
DI void p0_ssm(Frame& F, int g, int q) {
    LAS float* apow = (LAS float*)F.lds;
    LAS float* bb = apow + 17 * 64 * 2;
    LAS float* cc = bb + 64 * 16 * 2;
    LAS float* km = cc + 16 * 64 * 2;
    const int tid = FTID;
    if (tid < 64) {
        const int p = tid;
        const float lre = fminf(in_ptr<IN_LRE>()[g * 64 + p], -1e-4f), lim = in_ptr<IN_LIM>()[g * 64 + p], dt = expf(in_ptr<IN_LDT>()[g]);
        const float mag = expf(lre * dt); float sn, cs; sincosf(lim * dt, &sn, &cs);
        const float are = mag * cs, aim = mag * sn, den = lre * lre + lim * lim, nr = are - 1.0f;
        const float cre = (nr * lre + aim * lim) / den, cim = (aim * lre - nr * lim) / den;
        for (int tau = 0; tau <= 16; ++tau) { const float mg = expf(lre * dt * (float)tau); float s2, c2; sincosf(lim * dt * (float)tau, &s2, &c2); apow[(tau * 64 + p) * 2] = mg * c2; apow[(tau * 64 + p) * 2 + 1] = mg * s2; }
        for (int c = 0; c < 16; ++c) { const float br = in_ptr<IN_BRE>()[(g * 64 + p) * 16 + c], bi = in_ptr<IN_BIM>()[(g * 64 + p) * 16 + c];
            bb[(p * 16 + c) * 2] = cre * br - cim * bi; bb[(p * 16 + c) * 2 + 1] = cre * bi + cim * br; }
        if (q == 0) { float* a16 = (float*)(F.ws + WS_SMALL + 128 * 1024);
            a16[(g * 64 + p) * 2] = apow[(16 * 64 + p) * 2]; a16[(g * 64 + p) * 2 + 1] = apow[(16 * 64 + p) * 2 + 1]; }
    }
    for (int i = tid; i < 1024; i += 512) { cc[i * 2] = in_ptr<IN_CRE>()[g * 1024 + i]; cc[i * 2 + 1] = in_ptr<IN_CIM>()[g * 1024 + i]; }
    __syncthreads();
    for (int e = tid; e < 4096; e += 512) { const int tau = e >> 8, c = (e >> 4) & 15, c2 = e & 15; float s = 0.f;
        if (tau <= 4 * q + 3) {
            for (int p = 0; p < 64; ++p) { const float cr = cc[(c * 64 + p) * 2], ci = cc[(c * 64 + p) * 2 + 1], ar = apow[(tau * 64 + p) * 2], ai = apow[(tau * 64 + p) * 2 + 1], br = bb[(p * 16 + c2) * 2], bi = bb[(p * 16 + c2) * 2 + 1];
                const float tr = cr * ar - ci * ai, ti = cr * ai + ci * ar; s += tr * br - ti * bi; } }
        km[e] = s; }
    __syncthreads();
    unsigned* TF = (unsigned*)((bf16_t*)(F.ws + WS_TF) + ((size_t)g * 256 + 64 * q) * 384);
    for (int e = tid; e < 64 * 192; e += 512) { const int nl = e / 192, k = 2 * (e % 192), n = 64 * q + nl, s = n >> 4, c = n & 15; float v[2];
#pragma unroll
        for (int j = 0; j < 2; ++j) { const int kk = k + j;
            if (kk < 256) { const int s2 = kk >> 4, c2 = kk & 15; v[j] = (s >= s2) ? km[((s - s2) * 16 + c) * 16 + c2] : 0.f; }
            else { const int p = (kk - 256) & 63; const float cr = cc[(c * 64 + p) * 2], ci = cc[(c * 64 + p) * 2 + 1], ar = apow[((s + 1) * 64 + p) * 2], ai = apow[((s + 1) * 64 + p) * 2 + 1];
                v[j] = (kk < 320) ? (cr * ar - ci * ai) : -(cr * ai + ci * ar); } }
        TF[e] = pk2(v[0], v[1]); }
    unsigned* ET = (unsigned*)((bf16_t*)(F.ws + WS_ET) + ((size_t)g * 256 + 64 * q) * 256);
    for (int e = tid; e < 64 * 128; e += 512) { const int nl = e >> 7, k = 2 * (e & 127), n = 64 * q + nl; float v[2] = {0.f, 0.f};
        if (n < 128) { const int p = n & 63;
#pragma unroll
            for (int j = 0; j < 2; ++j) { const int kk = k + j, s2 = kk >> 4, c2 = kk & 15; const float ar = apow[((15 - s2) * 64 + p) * 2], ai = apow[((15 - s2) * 64 + p) * 2 + 1], br = bb[(p * 16 + c2) * 2], bi = bb[(p * 16 + c2) * 2 + 1];
                v[j] = (n < 64) ? (ar * br - ai * bi) : (ar * bi + ai * br); } }
        ET[e] = pk2(v[0], v[1]); }
    __syncthreads();
}

DI void norm_mod_rows(Frame& F, const float* x, const float* gvec, int sh_off, int sc_off, bf16_t* outp) {
    const float* mod = (const float*)(F.ws + WS_SMALL);
    const int gw = F.vcu * 8 + F.wave, NGW = F.G * 8;
    for (int m = gw; m < M; m += NGW) {
        const int b = m / SEQ;
        const f32x4* xr = (const f32x4*)(x + (size_t)m * DM) + FLANE;
        f32x4 v[4]; float s = 0.f;
#pragma unroll
        for (int j = 0; j < 4; ++j) { v[j] = xr[64 * j]; s += (v[j].x * v[j].x + v[j].y * v[j].y) + (v[j].z * v[j].z + v[j].w * v[j].w); }
        const float rstd = 1.0f / sqrtf(wave_sum(s) * (1.0f / DM) + EPSF);
        u32x2* o8 = (u32x2*)(outp + (size_t)m * DM) + FLANE;
#pragma unroll
        for (int j = 0; j < 4; ++j) { const int col = 4 * FLANE + 256 * j;
            const f32x4 gv = *(const f32x4*)(gvec + col), scv = *(const f32x4*)(mod + b * 6144 + sc_off + col), shv = *(const f32x4*)(mod + b * 6144 + sh_off + col);
            const f32x4 y = v[j] * rstd * gv * (scv + 1.0f) + shv;
            u32x2 w; w.x = pk2(y.x, y.y); w.y = pk2(y.z, y.w); o8[64 * j] = w; }
    }
}

struct DenseSched {
    pg8::StaticOrder so; const char* A; const char* B; size_t astep, bstep;
    DI void init(int Mr, int N, int G, int c, const void* A_, int lda, const void* B_, int ldb) { so.init(Mr, N, G, c); A = (const char*)A_; B = (const char*)B_; astep = (size_t)256 * lda * 2; bstep = (size_t)256 * ldb * 2; }
    DI bool next(int i, Unit& u) const { int pm, pn; if (!so.next(i, pm, pn)) return false; u.pm = pm; u.pn = pn; u.aux = 0; u.half = 0; u.rowtab = nullptr; u.A = A + (size_t)pm * astep; u.B = B + (size_t)pn * bstep; return true; }
};

struct EpiInProj {
    static constexpr bool PERM = true;
    bf16_t *Q, *Kb, *V, *Assm, *sga, *sgs; float* kmean; const float *qg, *kg;
    DI void operator()(const AccT& acc, const Unit& u, int wr, int wc, int fr, int fq) const {
        const int pn = u.pn, pm = u.pm;
        const int row0 = pm * 256 + wr * 64 + fr;
        if (pn < 4) {
            const bool isk = pn >= 2; const int hg = (pn & 1) * 4 + wc;
            const float* gp = (isk ? kg : qg) + 8 * fq; const float scl = isk ? 1.0f : QC2;
            f32x4 gv[2][2];
#pragma unroll
            for (int bj = 0; bj < 2; ++bj)
#pragma unroll
                for (int n = 0; n < 2; ++n) gv[bj][n] = *(const f32x4*)(gp + 32 * bj + 4 * n) * scl;
            f32x4 ks[2][2];
#pragma unroll
            for (int bj = 0; bj < 2; ++bj)
#pragma unroll
                for (int n = 0; n < 2; ++n) ks[bj][n] = (f32x4){0.f, 0.f, 0.f, 0.f};
            bf16_t* dst = (isk ? Kb : Q) + hg * 64 + 8 * fq;
#pragma unroll
            for (int ai = 0; ai < 2; ++ai)
#pragma unroll
                for (int m = 0; m < 4; ++m) {
                    float ss = 0.f;
#pragma unroll
                    for (int bj = 0; bj < 2; ++bj)
#pragma unroll
                        for (int n = 0; n < 2; ++n) { const f32x4 a = acc[ai][bj][m][n]; ss += (a.x * a.x + a.y * a.y) + (a.z * a.z + a.w * a.w); }
                    ss += __shfl_xor(ss, 16); ss += __shfl_xor(ss, 32);
                    const float rstd = 1.0f / sqrtf(ss * (1.0f / 64.0f) + EPSF);
                    const size_t row = (size_t)(row0 + ai * 128 + m * 16);
#pragma unroll
                    for (int bj = 0; bj < 2; ++bj) {
                        const f32x4 v0 = acc[ai][bj][m][0] * rstd * gv[bj][0], v1 = acc[ai][bj][m][1] * rstd * gv[bj][1];
                        if (isk) { ks[bj][0] += v0; ks[bj][1] += v1; }
                        u32x4 w; w.x = pk2(v0.x, v0.y); w.y = pk2(v0.z, v0.w); w.z = pk2(v1.x, v1.y); w.w = pk2(v1.z, v1.w);
                        *(u32x4*)(dst + row * 512 + 32 * bj) = w; }
                }
            if (isk) {
                const int b = pm >> 4, blk = pm & 15;
                float* kmp = kmean + ((size_t)((b * 8 + hg) * 16 + blk)) * 64 + 8 * fq;
#pragma unroll
                for (int bj = 0; bj < 2; ++bj)
#pragma unroll
                    for (int n = 0; n < 2; ++n)
#pragma unroll
                        for (int j = 0; j < 4; ++j) { float s = ks[bj][n][j]; s += __shfl_xor(s, 1); s += __shfl_xor(s, 2); s += __shfl_xor(s, 4); s += __shfl_xor(s, 8);
                            if (fr == 0) kmp[wr * 32768 + 32 * bj + 4 * n + j] = s * (1.0f / 256.0f); }
            }
        } else if (pn < 6) {
            bf16_t* dst = V + (pn - 4) * 256 + wc * 32 + 8 * fq;
#pragma unroll
            for (int ai = 0; ai < 2; ++ai)
#pragma unroll
                for (int m = 0; m < 4; ++m) { const size_t row = (size_t)(row0 + ai * 128 + m * 16);
#pragma unroll
                    for (int bj = 0; bj < 2; ++bj) { const f32x4 v0 = acc[ai][bj][m][0], v1 = acc[ai][bj][m][1];
                        u32x4 w; w.x = pk2(v0.x, v0.y); w.y = pk2(v0.z, v0.w); w.z = pk2(v1.x, v1.y); w.w = pk2(v1.z, v1.w);
                        *(u32x4*)(dst + row * 512 + 128 * bj) = w; } }
        } else if (pn < 8) {
            const int b = pm >> 4;
#pragma unroll
            for (int ai = 0; ai < 2; ++ai)
#pragma unroll
                for (int m = 0; m < 4; ++m) { const int t = (pm & 15) * 256 + ai * 128 + wr * 64 + m * 16 + fr;
#pragma unroll
                    for (int bj = 0; bj < 2; ++bj) { const int c = (pn - 6) * 256 + 128 * bj + 32 * wc + 8 * fq, g = c >> 4, c2 = c & 15;
                        const f32x4 v0 = acc[ai][bj][m][0], v1 = acc[ai][bj][m][1];
                        u32x4 w; w.x = pk2(v0.x, v0.y); w.y = pk2(v0.z, v0.w); w.z = pk2(v1.x, v1.y); w.w = pk2(v1.z, v1.w);
                        *(u32x4*)(Assm + ((size_t)g * 1024 + b * 256 + (t >> 4)) * 384 + (t & 15) * 16 + c2) = w; } }
        } else {
            bf16_t* dst = (pn < 12 ? sga + (pn - 8) * 256 : sgs + (pn - 12) * 256) + wc * 32 + 8 * fq;
#pragma unroll
            for (int ai = 0; ai < 2; ++ai)
#pragma unroll
                for (int m = 0; m < 4; ++m) { const size_t row = (size_t)(row0 + ai * 128 + m * 16);
#pragma unroll
                    for (int bj = 0; bj < 2; ++bj) { const f32x4 v0 = acc[ai][bj][m][0], v1 = acc[ai][bj][m][1];
                        u32x4 w; w.x = pk2(sigmoidf_(v0.x), sigmoidf_(v0.y)); w.y = pk2(sigmoidf_(v0.z), sigmoidf_(v0.w)); w.z = pk2(sigmoidf_(v1.x), sigmoidf_(v1.y)); w.w = pk2(sigmoidf_(v1.z), sigmoidf_(v1.w));
                        *(u32x4*)(dst + row * 1024 + 128 * bj) = w; } }
        }
    }
};

struct EpiS1 {
    static constexpr bool PERM = false;
    float* Hloc;
    DI void operator()(const AccT& acc, const Unit& u, int wr, int wc, int fr, int fq) const {
        float* base = Hloc + (size_t)u.pm * 256 * 128 + wc * 32 + 4 * fq;
#pragma unroll
        for (int ai = 0; ai < 2; ++ai)
#pragma unroll
            for (int m = 0; m < 4; ++m) { const int r = ai * 128 + wr * 64 + m * 16 + fr;
#pragma unroll
                for (int n = 0; n < 2; ++n) *(f32x4*)(base + (size_t)r * 128 + 16 * n) = acc[ai][0][m][n]; }
    }
};
struct SsmSched {
    int G, c; const char* A; const char* B; size_t bstep;
    DI bool next(int i, Unit& u) const { const int L = i * G + c; if (L >= 128) return false; u.pm = L; u.pn = 0; u.aux = 0; u.half = 0; u.rowtab = nullptr;
        u.A = A + (size_t)L * 256 * 384 * 2; u.B = B + (size_t)(L >> 2) * bstep; return true; }
};
struct EpiS2 {
    static constexpr bool PERM = true;
    const bf16_t* Assm; const float* dskip; bf16_t* gbuf;
    DI void operator()(const AccT& acc, const Unit& u, int wr, int wc, int fr, int fq) const {
        const int g = u.pm >> 2, b = u.pm & 3;
#pragma unroll
        for (int ai = 0; ai < 2; ++ai)
#pragma unroll
            for (int m = 0; m < 4; ++m) { const int r = ai * 128 + wr * 64 + m * 16 + fr;
#pragma unroll
                for (int bj = 0; bj < 2; ++bj) { const int c = 128 * bj + 32 * wc + 8 * fq, s = c >> 4, c2 = c & 15;
                    const int t = 16 * r + s;
                    size_t uo = ((size_t)u.pm * 256 + r) * 384 + c, oo = ((size_t)b * SEQ + t) * 512 + g * 16 + c2;
                    asm volatile("" : "+v"(uo), "+v"(oo));
                    const u32x2* up = (const u32x2*)(Assm + uo);
                    u32x2* op = (u32x2*)(gbuf + oo);
#pragma unroll
                    for (int n = 0; n < 2; ++n) {
                        const u32x2 uu = up[n]; const f32x4 d0 = *(const f32x4*)(dskip + g * 16 + c2 + 4 * n); const f32x4 a0 = acc[ai][bj][m][n];
                        const float y0 = a0.x + d0.x * bflo(uu.x), y1 = a0.y + d0.y * bfhi(uu.x), y2 = a0.z + d0.z * bflo(uu.y), y3 = a0.w + d0.w * bfhi(uu.y);
                        u32x2 w; w.x = pk2(gelu_tanh(y0), gelu_tanh(y1)); w.y = pk2(gelu_tanh(y2), gelu_tanh(y3));
                        op[n] = w; asm volatile("" ::: "memory"); } } }
    }
};
struct EpiGluUp {
    static constexpr bool PERM = true;
    const bf16_t* gbuf; const float* bglu; bf16_t* sout; const bf16_t* sga; bf16_t* P1;
    DI void operator()(const AccT& acc, const Unit& u, int wr, int wc, int fr, int fq) const {
        const int row0 = u.pm * 256 + wr * 64 + fr, col0 = u.pn * 256 + wc * 32 + 8 * fq;
#pragma unroll
        for (int ai = 0; ai < 2; ++ai)
#pragma unroll
            for (int m = 0; m < 4; ++m) { const size_t row = (size_t)(row0 + ai * 128 + m * 16);
#pragma unroll
                for (int bj = 0; bj < 2; ++bj) { const int col = col0 + 128 * bj; const f32x4 a0 = acc[ai][bj][m][0], a1 = acc[ai][bj][m][1]; u32x4 w;
                    if (u.aux == 0) { const u32x4 gg = *(const u32x4*)(gbuf + row * 512 + col); const f32x4 b0 = *(const f32x4*)(bglu + col), b1 = *(const f32x4*)(bglu + col + 4);
                        w.x = pk2(bflo(gg.x) * sigmoidf_(a0.x + b0.x), bfhi(gg.x) * sigmoidf_(a0.y + b0.y)); w.y = pk2(bflo(gg.y) * sigmoidf_(a0.z + b0.z), bfhi(gg.y) * sigmoidf_(a0.w + b0.w));
                        w.z = pk2(bflo(gg.z) * sigmoidf_(a1.x + b1.x), bfhi(gg.z) * sigmoidf_(a1.y + b1.y)); w.w = pk2(bflo(gg.w) * sigmoidf_(a1.z + b1.z), bfhi(gg.w) * sigmoidf_(a1.w + b1.w));
                        *(u32x4*)(sout + row * 512 + col) = w;
                    } else { const u32x4 gg = *(const u32x4*)(sga + row * 1024 + col);
                        w.x = pk2(bflo(gg.x) * a0.x, bfhi(gg.x) * a0.y); w.y = pk2(bflo(gg.y) * a0.z, bfhi(gg.y) * a0.w); w.z = pk2(bflo(gg.z) * a1.x, bfhi(gg.z) * a1.y); w.w = pk2(bflo(gg.w) * a1.z, bfhi(gg.w) * a1.w);
                        *(u32x4*)(P1 + row * 1024 + col) = w; } } }
    }
};
struct GluUpSched {
    int G, c; const char *Ag, *Bg, *Au, *Bu;
    DI bool next(int i, Unit& u) const { const int L = i * G + c; if (L >= 384) return false; u.rowtab = nullptr; u.half = 0;
        if (L < 128) { u.aux = 0; u.pm = L >> 1; u.pn = L & 1; u.A = Ag + (size_t)u.pm * 256 * 512 * 2; u.B = Bg + (size_t)u.pn * 256 * 512 * 2; }
        else { const int l2 = L - 128; u.aux = 1; u.pm = l2 >> 2; u.pn = l2 & 3; u.A = Au + (size_t)u.pm * 256 * 512 * 2; u.B = Bu + (size_t)u.pn * 256 * 512 * 2; }
        return true; }
};
struct EpiUp2 {
    static constexpr bool PERM = true;
    const bf16_t* P1; const bf16_t* sgs; bf16_t* mix;
    DI void operator()(const AccT& acc, const Unit& u, int wr, int wc, int fr, int fq) const {
        const int row0 = u.pm * 256 + wr * 64 + fr, col0 = u.pn * 256 + wc * 32 + 8 * fq;
#pragma unroll
        for (int ai = 0; ai < 2; ++ai)
#pragma unroll
            for (int m = 0; m < 4; ++m) { const size_t row = (size_t)(row0 + ai * 128 + m * 16);
#pragma unroll
                for (int bj = 0; bj < 2; ++bj) { const size_t o = row * 1024 + col0 + 128 * bj; const f32x4 a0 = acc[ai][bj][m][0], a1 = acc[ai][bj][m][1];
                    const u32x4 gg = *(const u32x4*)(sgs + o), pp = *(const u32x4*)(P1 + o); u32x4 w;
                    w.x = pk2(bflo(pp.x) + bflo(gg.x) * a0.x, bfhi(pp.x) + bfhi(gg.x) * a0.y); w.y = pk2(bflo(pp.y) + bflo(gg.y) * a0.z, bfhi(pp.y) + bfhi(gg.y) * a0.w);
                    w.z = pk2(bflo(pp.z) + bflo(gg.z) * a1.x, bfhi(pp.z) + bfhi(gg.z) * a1.y); w.w = pk2(bflo(pp.w) + bflo(gg.w) * a1.z, bfhi(pp.w) + bfhi(gg.w) * a1.w);
                    *(u32x4*)(mix + o) = w; } }
    }
};
struct EpiOut {
    static constexpr bool PERM = true;
    const float* x; const float* mod; float* out;
    DI void operator()(const AccT& acc, const Unit& u, int wr, int wc, int fr, int fq) const {
        const int row0 = u.pm * 256 + wr * 64 + fr, col0 = u.pn * 256 + wc * 32 + 8 * fq, b = u.pm >> 4;
#pragma unroll
        for (int bj = 0; bj < 2; ++bj) { const int col = col0 + 128 * bj;
            const f32x4 g0 = *(const f32x4*)(mod + b * 6144 + 2048 + col), g1 = *(const f32x4*)(mod + b * 6144 + 2048 + col + 4);
#pragma unroll
            for (int ai = 0; ai < 2; ++ai)
#pragma unroll
                for (int m = 0; m < 4; ++m) { const size_t o = (size_t)(row0 + ai * 128 + m * 16) * 1024 + col;
                    const f32x4 x0 = *(const f32x4*)(x + o), x1 = *(const f32x4*)(x + o + 4);
                    *(f32x4*)(out + o) = x0 + g0 * acc[ai][bj][m][0]; *(f32x4*)(out + o + 4) = x1 + g1 * acc[ai][bj][m][1]; } }
    }
};
struct EpiRsh {
    static constexpr bool PERM = true;
    float* scores; bf16_t* hs;
    DI void operator()(const AccT& acc, const Unit& u, int wr, int wc, int fr, int fq) const {
        const int row0 = u.pm * 256 + wr * 64 + fr;
        if (u.pn == 0) {
#pragma unroll
            for (int ai = 0; ai < 2; ++ai)
#pragma unroll
                for (int m = 0; m < 4; ++m) { const size_t row = (size_t)(row0 + ai * 128 + m * 16);
#pragma unroll
                    for (int bj = 0; bj < 2; ++bj) { float* d = scores + row * 256 + 128 * bj + 32 * wc + 8 * fq; const f32x4 a0 = acc[ai][bj][m][0], a1 = acc[ai][bj][m][1];
                        *(f32x4*)d = (f32x4){sigmoidf_(a0.x), sigmoidf_(a0.y), sigmoidf_(a0.z), sigmoidf_(a0.w)}; *(f32x4*)(d + 4) = (f32x4){sigmoidf_(a1.x), sigmoidf_(a1.y), sigmoidf_(a1.z), sigmoidf_(a1.w)}; } }
        } else {
#pragma unroll
            for (int ai = 0; ai < 2; ++ai)
#pragma unroll
                for (int m = 0; m < 4; ++m) { const size_t row = (size_t)(row0 + ai * 128 + m * 16);
                    const f32x4 g0 = acc[ai][0][m][0], g1 = acc[ai][0][m][1], u0 = acc[ai][1][m][0], u1 = acc[ai][1][m][1]; u32x4 w;
                    w.x = pk2(siluf_(g0.x) * u0.x, siluf_(g0.y) * u0.y); w.y = pk2(siluf_(g0.z) * u0.z, siluf_(g0.w) * u0.w); w.z = pk2(siluf_(g1.x) * u1.x, siluf_(g1.y) * u1.y); w.w = pk2(siluf_(g1.z) * u1.z, siluf_(g1.w) * u1.w);
                    *(u32x4*)(hs + row * 256 + 128 * (u.pn - 1) + 32 * wc + 8 * fq) = w; }
        }
    }
};
struct EpiBf16 {
    static constexpr bool PERM = true;
    bf16_t* O; int ldc;
    DI void operator()(const AccT& acc, const Unit& u, int wr, int wc, int fr, int fq) const {
        const int row0 = u.pm * 256 + wr * 64 + fr, col0 = u.pn * 256 + wc * 32 + 8 * fq;
#pragma unroll
        for (int ai = 0; ai < 2; ++ai)
#pragma unroll
            for (int m = 0; m < 4; ++m) { const size_t row = (size_t)(row0 + ai * 128 + m * 16);
#pragma unroll
                for (int bj = 0; bj < 2; ++bj) { const f32x4 v0 = acc[ai][bj][m][0], v1 = acc[ai][bj][m][1];
                    u32x4 w; w.x = pk2(v0.x, v0.y); w.y = pk2(v0.z, v0.w); w.z = pk2(v1.x, v1.y); w.w = pk2(v1.z, v1.w);
                    *(u32x4*)(O + row * ldc + col0 + 128 * bj) = w; } asm volatile("" ::: "memory"); }
    }
};
struct EpiMoe1 {
    static constexpr bool PERM = true;
    bf16_t* Hs;
    DI void operator()(const AccT& acc, const Unit& u, int wr, int wc, int fr, int fq) const {
        const int row0 = u.pm * 256 + wr * 64 + fr;
#pragma unroll
        for (int ai = 0; ai < 2; ++ai)
#pragma unroll
            for (int m = 0; m < 4; ++m) { const size_t row = (size_t)(row0 + ai * 128 + m * 16);
                const f32x4 g0 = acc[ai][0][m][0], g1 = acc[ai][0][m][1], u0 = acc[ai][1][m][0], u1 = acc[ai][1][m][1]; u32x4 w;
                w.x = pk2(siluf_(g0.x) * u0.x, siluf_(g0.y) * u0.y); w.y = pk2(siluf_(g0.z) * u0.z, siluf_(g0.w) * u0.w); w.z = pk2(siluf_(g1.x) * u1.x, siluf_(g1.y) * u1.y); w.w = pk2(siluf_(g1.z) * u1.z, siluf_(g1.w) * u1.w);
                *(u32x4*)(Hs + row * 256 + 128 * u.pn + 32 * wc + 8 * fq) = w; }
    }
};
struct EpiMoe2 {
    static constexpr bool PERM = true;
    const int* dest; const float* roww; bf16_t* Y;
    DI void operator()(const AccT& acc, const Unit& u, int wr, int wc, int fr, int fq) const {
        const int row0 = u.pm * 256 + wr * 64 + fr, col0 = u.pn * 256 + wc * 32 + 8 * fq;
        int dd[2][4]; float ww[2][4];
#pragma unroll
        for (int ai = 0; ai < 2; ++ai)
#pragma unroll
            for (int m = 0; m < 4; ++m) { const int row = row0 + ai * 128 + m * 16; dd[ai][m] = dest[row]; ww[ai][m] = roww[row]; }
#pragma unroll
        for (int ai = 0; ai < 2; ++ai)
#pragma unroll
            for (int m = 0; m < 4; ++m) { const int d = dd[ai][m]; const float wt = ww[ai][m];
                if (d >= 0) {
#pragma unroll
                    for (int bj = 0; bj < 2; ++bj) { const f32x4 v0 = acc[ai][bj][m][0] * wt, v1 = acc[ai][bj][m][1] * wt;
                        u32x4 w; w.x = pk2(v0.x, v0.y); w.y = pk2(v0.z, v0.w); w.z = pk2(v1.x, v1.y); w.w = pk2(v1.z, v1.w);
                        *(u32x4*)(Y + (size_t)d * 1024 + col0 + 128 * bj) = w; } } }
    }
};
struct MoeSched {
    int G, c, npn, ntiles; const LAS unsigned short* tile_e; const char* A; const char* B; size_t astep, bestep, bnstep; const int* rowtab;
    DI bool next(int i, Unit& u) const { const int L = i * G + c; if (L >= ntiles * npn) return false; const int tile = L / npn, pn = L % npn; const int e = tile_e[tile];
        u.pm = tile; u.pn = pn; u.aux = e; u.half = (tile_e[MAXTILES + tile] <= 128) ? 1 : 0; u.rowtab = rowtab + tile * 256; u.A = A + (size_t)tile * astep; u.B = B + (size_t)e * bestep + (size_t)pn * bnstep; return true; }
};

namespace att {
constexpr int DMA_ = 512;
constexpr int NW = 8, QBLK = 32, QB = 256, KVBLK = 64;
DI int crow(int r, int hi) { return (r & 3) + 8 * (r >> 2) + 4 * hi; }
#define SBAR() __builtin_amdgcn_sched_barrier(0)
DI void cmask(f32x16& p0, f32x16& p1, int jb, int qrel, int hi) {
    const float NEG = -INFINITY; int kb = 64 * jb + 4 * hi;
#pragma unroll
    for (int r = 0; r < 16; ++r) { int kv = kb + (r & 3) + 8 * (r >> 2); if (kv > qrel) p0[r] = NEG; if (kv + 32 > qrel) p1[r] = NEG; }
}
constexpr int NSLOT = 3, SLOTB = 8192;
constexpr int LDS_K = 0, LDS_V = NSLOT * SLOTB, LDS_WS = 2 * NSLOT * SLOTB, LDS_OST = LDS_WS + NW * 64 * 4, LDS_KM = LDS_OST + NW * 4096, LDS_BT = LDS_KM + 4096, LDS_END = LDS_BT + 576 * 4;
static_assert(LDS_END <= RING_BYTES, "attention LDS");
DI void glds16(const void* sbase, unsigned voff, unsigned lds_dst) { unsigned keep;
    asm volatile("s_nop 4\n\ts_mov_b32 %0, m0\n\ts_mov_b32 m0, %2\n\ts_nop 0\n\tglobal_load_lds_dwordx4 %1, %3\n\ts_mov_b32 m0, %0" : "=&s"(keep) : "v"(voff), "s"(lds_dst), "s"(sbase) : "memory"); }
DI float max3f(float a, float b, float c) { float r; asm("v_max3_f32 %0, %1, %2, %3" : "=v"(r) : "v"(a), "v"(b), "v"(c)); return r; }
DI float max2f(float a, float b) { float r; asm("v_max_f32_e32 %0, %1, %2" : "=v"(r) : "v"(a), "v"(b)); return r; }
DI float fadd_s(float a, float b) { float r; asm("v_add_f32_e32 %0, %1, %2" : "=v"(r) : "v"(a), "v"(b)); return r; }
DI float fsub_s(float a, float b) { float r; asm("v_sub_f32_e32 %0, %1, %2" : "=v"(r) : "v"(a), "v"(b)); return r; }
DI unsigned cvtpk_s(float lo, float hi) { return pk2(lo, hi); }
#define WAIT_BAR(N) asm volatile("s_waitcnt vmcnt(" #N ") lgkmcnt(0)\n\ts_barrier" ::: "memory")
DI void qkt(f32x16& p0, f32x16& p1, const char* Kslot, const bf16x8* qr, const f32x16& negm, int r32, int hi) {
    const char* kb = Kslot + hi * 1024 + r32 * 16;
#pragma unroll
    for (int d0 = 0; d0 < 4; ++d0) {
        const bf16x8 b0 = *reinterpret_cast<const bf16x8*>(kb + d0 * 2048);
        const bf16x8 b1 = *reinterpret_cast<const bf16x8*>(kb + d0 * 2048 + 512);
        if (d0 == 0) { p0 = __builtin_amdgcn_mfma_f32_32x32x16_bf16(b0, qr[0], negm, 0, 0, 0); p1 = __builtin_amdgcn_mfma_f32_32x32x16_bf16(b1, qr[0], negm, 0, 0, 0); }
        else { p0 = __builtin_amdgcn_mfma_f32_32x32x16_bf16(b0, qr[d0], p0, 0, 0, 0); p1 = __builtin_amdgcn_mfma_f32_32x32x16_bf16(b1, qr[d0], p1, 0, 0, 0); } }
}
typedef LAS const char* lds_cptr;
typedef short v4i16_t __attribute__((ext_vector_type(4)));
DI void kload8(bf16x8* kf, lds_cptr kp) {
    kf[0] = *(const LAS bf16x8*)(kp);        kf[1] = *(const LAS bf16x8*)(kp + 512);
    kf[2] = *(const LAS bf16x8*)(kp + 2048); kf[3] = *(const LAS bf16x8*)(kp + 2560);
    kf[4] = *(const LAS bf16x8*)(kp + 4096); kf[5] = *(const LAS bf16x8*)(kp + 4608);
    kf[6] = *(const LAS bf16x8*)(kp + 6144); kf[7] = *(const LAS bf16x8*)(kp + 6656);
}
DI void kload2(bf16x8* kf, lds_cptr kp, int j) { kf[2 * j] = *(const LAS bf16x8*)(kp + j * 2048); kf[2 * j + 1] = *(const LAS bf16x8*)(kp + j * 2048 + 512); }
DI s16x4 vtr(lds_cptr p) { return __builtin_bit_cast(s16x4, __builtin_amdgcn_ds_read_tr16_b64_v4i16((LAS v4i16_t*)p)); }
DI float rowmax(const f32x16& p0, const f32x16& p1) {
    float a = max3f(p0[0], p0[1], p1[0]), b = max3f(p0[2], p0[3], p1[1]); a = max3f(a, p1[2], p1[3]);
#pragma unroll
    for (int r = 4; r < 16; r += 4) { a = max3f(a, p0[r], p0[r + 1]); b = max3f(b, p0[r + 2], p0[r + 3]); a = max3f(a, p1[r], p1[r + 1]); b = max3f(b, p1[r + 2], p1[r + 3]); }
    const float m = max2f(a, b);
    auto rr = __builtin_amdgcn_permlane32_swap(__float_as_uint(m), __float_as_uint(m), false, false);
    return max2f(__uint_as_float(rr[0]), __uint_as_float(rr[1]));
}
DI void pv(f32x16* o, int vb, bf16x8 pa0, bf16x8 pa1, bf16x8 pa2, bf16x8 pa3) {
#pragma unroll
    for (int d0 = 0; d0 < 2; ++d0) { s16x4 lo[4], hi[4];
#pragma unroll
        for (int ks = 0; ks < 4; ++ks) {
            asm volatile("ds_read_b64_tr_b16 %0,%1 offset:%c2" : "=&v"(lo[ks]) : "v"(vb), "i"(d0 * 4096 + ks * 1024) : "memory");
            asm volatile("ds_read_b64_tr_b16 %0,%1 offset:%c2" : "=&v"(hi[ks]) : "v"(vb), "i"(d0 * 4096 + ks * 1024 + 512) : "memory"); }
        asm volatile("s_waitcnt lgkmcnt(0)" ::: "memory"); SBAR();
#define PK(k) (bf16x8){lo[k][0], lo[k][1], lo[k][2], lo[k][3], hi[k][0], hi[k][1], hi[k][2], hi[k][3]}
        o[d0] = __builtin_amdgcn_mfma_f32_32x32x16_bf16(pa0, PK(0), o[d0], 0, 0, 0);
        o[d0] = __builtin_amdgcn_mfma_f32_32x32x16_bf16(pa1, PK(1), o[d0], 0, 0, 0);
        o[d0] = __builtin_amdgcn_mfma_f32_32x32x16_bf16(pa2, PK(2), o[d0], 0, 0, 0);
        o[d0] = __builtin_amdgcn_mfma_f32_32x32x16_bf16(pa3, PK(3), o[d0], 0, 0, 0);
#undef PK
    }
}
DI int t5_bucket(int n) { if (n < 16) return n; int v = 16 + (int)(logf((float)n * (1.0f / 16.0f)) * (16.0f / 2.0794415416798357f)); return v > 31 ? 31 : v; }

template <int THRL> DI void attn_unit(int wid, int b, int h, int qb, const bf16_t* Q, const bf16_t* __restrict__ K, const bf16_t* __restrict__ V, bf16_t* O, char* shm, const float* kmean, const float* relb) {
    int lane = lane_id(); asm volatile("" : "+v"(lane));
    const int tid = wid * 64 + lane, r32 = lane & 31, hi = lane >> 5;
    const long rowbase = (long)b * SEQ; const int q0 = qb * QB;
    const bf16_t* Qw = Q + (rowbase + q0 + wid * QBLK) * DMA_ + h * 64;
    const bf16_t* Kh = K + rowbase * DMA_ + h * 64, *Vh = V + rowbase * DMA_ + h * 64;
    const unsigned lds0 = (unsigned)(uintptr_t)shm;
    LAS float* wsf = (LAS float*)((LAS char*)shm + LDS_WS) + wid * 64;
    LAS float* kms = (LAS float*)((LAS char*)shm + LDS_KM); LAS float* bt = (LAS float*)((LAS char*)shm + LDS_BT);
    if (tid < 256) *(LAS f32x4*)(kms + 4 * tid) = *(const f32x4*)(kmean + (size_t)(b * 8 + h) * 1024 + 4 * tid) + *(const f32x4*)(kmean + 32768 + (size_t)(b * 8 + h) * 1024 + 4 * tid);
    for (int i = tid; i < 576; i += 512) { const int n = i - 256; float v = 0.f; if (n >= 0 && n < 128) v = (relb[t5_bucket(n) * 8 + h] - relb[31 * 8 + h]) * LOG2E; bt[i] = exp2f(v); }
    asm volatile("s_waitcnt vmcnt(0) lgkmcnt(0)\n\ts_barrier" ::: "memory");
    unsigned selmask = 0;
    {
        float gsc[8];
#pragma unroll
        for (int j = 0; j < 8; ++j) gsc[j] = 0.f;
#pragma unroll
        for (int c8 = 0; c8 < 8; ++c8) { const u32x4 qq = *(const u32x4*)(Qw + (long)r32 * DMA_ + c8 * 8);
            float qv[8] = {bflo(qq.x), bfhi(qq.x), bflo(qq.y), bfhi(qq.y), bflo(qq.z), bfhi(qq.z), bflo(qq.w), bfhi(qq.w)};
#pragma unroll
            for (int j = 0; j < 8; ++j) { const LAS float* kp = kms + (8 * hi + j) * 64 + c8 * 8; const f32x4 k0 = *(const LAS f32x4*)kp, k1 = *(const LAS f32x4*)(kp + 4);
                gsc[j] += qv[0] * k0.x + qv[1] * k0.y + qv[2] * k0.z + qv[3] * k0.w + qv[4] * k1.x + qv[5] * k1.y + qv[6] * k1.z + qv[7] * k1.w; } }
        float ga[16];
#pragma unroll
        for (int j = 0; j < 8; ++j) { const float o = __shfl_xor(gsc[j], 32); ga[j] = hi ? o : gsc[j]; ga[8 + j] = hi ? gsc[j] : o; }
#pragma unroll
        for (int j = 0; j < 16; ++j) if (j >= qb) ga[j] = -INFINITY;
#pragma unroll
        for (int k = 0; k < 3; ++k) { float bv = -INFINITY; int bi = -1;
#pragma unroll
            for (int j = 0; j < 16; ++j) if (ga[j] > bv) { bv = ga[j]; bi = j; }
            if (bi >= 0) { selmask |= 1u << bi;
#pragma unroll
                for (int j = 0; j < 16; ++j) if (j == bi) ga[j] = -INFINITY; } }
        selmask |= 0xffff0000u | (1u << qb);
    }
    const unsigned kvo = (unsigned)(lane * DMA_ * 2);
    const unsigned vvo = (unsigned)(((lane >> 2) * DMA_ + (lane & 3) * 8) * 2);
    const bf16_t* kub = Kh + wid * 8; const bf16_t* vub = Vh + (long)(16 * (wid & 3)) * DMA_ + (wid >> 2) * 32;
    const unsigned kdst = lds0 + LDS_K + wid * 1024, vdst = lds0 + LDS_V + wid * 1024;
#define DMA_K(t, slot) glds16(kub + (long)(t) * KVBLK * DMA_, kvo, (unsigned)__builtin_amdgcn_readfirstlane(kdst + (slot)))
#define DMA_V(t, slot) glds16(vub + (long)(t) * KVBLK * DMA_, vvo, (unsigned)__builtin_amdgcn_readfirstlane(vdst + (slot)))
    const int vb0 = (int)(lds0 + LDS_V) + ((lane >> 4) & 1) * 32 + (lane & 3) * 8 + (4 * hi + ((lane & 15) >> 2)) * 64;
    const char* Kbase = shm + LDS_K; bf16x8 kf[8];
    const lds_cptr shm3 = (lds_cptr)shm; const lds_cptr kp0 = shm3 + LDS_K + hi * 1024 + r32 * 16; const lds_cptr vp0 = shm3 + LDS_V + ((lane >> 4) & 1) * 32 + (lane & 3) * 8 + (4 * hi + ((lane & 15) >> 2)) * 64;
    const int NT = (q0 + QB) / KVBLK;
    DMA_K(0, 0); DMA_V(0, 0); DMA_K(1, SLOTB);
    bf16x8 qr[4];
#pragma unroll
    for (int d0 = 0; d0 < 4; ++d0) qr[d0] = *reinterpret_cast<const bf16x8*>(&Qw[(long)r32 * DMA_ + d0 * 16 + hi * 8]);
    float mhat = 0.f, l_reg = 0.f; f32x16 o[2]; o[0] = f32x16{}; o[1] = f32x16{}; f32x16 negm;
#pragma unroll
    for (int r = 0; r < 16; ++r) negm[r] = (selmask & 1u) ? 0.f : -1e30f;
    asm volatile("" : "+v"(negm));
    const int qrel = wid * QBLK + r32;
#define MASKS(P0, P1, t) do { int jb_ = (t) - (NT - 4); if (jb_ >= 0) cmask(P0, P1, jb_, qrel, hi); } while (0)
#define BIASM(P0, P1, t) do { if ((t) >= NT - 9 && q0 + wid * QBLK - (64 * (t) + 63) < 128) { const LAS float* bp_ = bt + (q0 + qrel - 64 * (t) + 256 - 63 - 4 * hi); \
        _Pragma("unroll") for (int r4 = 0; r4 < 16; r4 += 4) { _Pragma("unroll") for (int r = r4; r < r4 + 4; ++r) { const volatile LAS float* vb_ = bp_; P0[r] *= vb_[63 - crow(r, 0)]; P1[r] *= vb_[31 - crow(r, 0)]; } SBAR(); } } } while (0)
#define MOFF(t) (((selmask >> ((t) >> 2)) & 1u) ? 0.f : -1e30f)
#define UPD(t) do { if (((t) & 3) == 0) { const float nv_ = MOFF(t) - mhat; \
        _Pragma("unroll") for (int r = 0; r < 16; ++r) negm[r] = nv_; asm volatile("" : "+v"(negm)); } } while (0)
    bool resc = false;
#define START(P0, P1) do { const float rm = rowmax(P0, P1); resc = false; \
    { const float dl = __builtin_fmaxf(rm, 0.f); mhat = fadd_s(mhat, dl); \
      _Pragma("unroll") for (int r = 0; r < 16; ++r) { P0[r] = fsub_s(P0[r], dl); P1[r] = fsub_s(P1[r], dl); } \
      const float nv_ = MOFF(0) - mhat; _Pragma("unroll") for (int r = 0; r < 16; ++r) negm[r] = nv_; asm volatile("" : "+v"(negm)); } \
    _Pragma("unroll") for (int r = 0; r < 16; ++r) P0[r] = __builtin_amdgcn_exp2f(P0[r]); } while (0)
#define RESC() do { if (resc) { asm volatile("s_waitcnt lgkmcnt(0)" ::: "memory"); \
      _Pragma("unroll") for (int d_ = 0; d_ < 2; ++d_) _Pragma("unroll") for (int r = 0; r < 16; ++r) o[d_][r] *= wsf[crow(r, hi)]; } } while (0)
    f32x16 pA0, pA1, pB0, pB1;
    int sl_prev = 0, sl_cur = 0, sl_next = SLOTB;
#define ROT() do { sl_prev = sl_cur; sl_cur = sl_next; sl_next = (sl_next == (NSLOT - 1) * SLOTB) ? 0 : sl_next + SLOTB; } while (0)
    DMA_K(2, 2 * SLOTB);
    WAIT_BAR(3);
    qkt(pA0, pA1, Kbase, qr, negm, r32, hi); asm volatile("s_nop 15\n\ts_nop 7" : "+v"(pA0), "+v"(pA1)); MASKS(pA0, pA1, 0);
    START(pA0, pA1);
    _Pragma("unroll") for (int r = 0; r < 16; ++r) pA1[r] = __builtin_amdgcn_exp2f(pA1[r]);
    WAIT_BAR(0);
    DMA_K(3, 0); DMA_V(1, SLOTB);
    ROT();
    kload8(kf, kp0 + sl_cur);
    WAIT_BAR(2);
    BIASM(pA0, pA1, 0);
    s16x4 vlo[8], vhi[8]; u32x4 pw0, pw1, pw2, pw3;
#define PKW(P, B) cvtpk_s(P[B], P[B + 1])
#define PAF(k) __builtin_bit_cast(bf16x8, pw##k)
#define VFR(i) (bf16x8){vlo[i][0], vlo[i][1], vlo[i][2], vlo[i][3], vhi[i][0], vhi[i][1], vhi[i][2], vhi[i][3]}
#define PIN(x) asm volatile("" : "+v"(x))
#define MX3(a, b, c) __builtin_fmaxf(__builtin_fmaxf((a), (b)), (c))
#define GAPA(MF, A0, A1, A2, A3, W0, W1, PW) do { MF; sacc += A0; sacc += A1; sacc += A2; sacc += A3; PIN(sacc); W0; W1; PIN(PW); SBAR(); } while (0)
#define EX(v) __builtin_amdgcn_exp2f(v)
#define GAPB(MF, X, B) do { MF; X[B] = EX(X[B]); X[B + 1] = EX(X[B + 1]); X[B + 2] = EX(X[B + 2]); X[B + 3] = EX(X[B + 3]); PIN(X); SBAR(); } while (0)
#define VRD(i) do { vlo[i] = vtr(vp_ + (((i) >> 2) * 4096 + ((i) & 3) * 1024)); vhi[i] = vtr(vp_ + (((i) >> 2) * 4096 + ((i) & 3) * 1024 + 512)); } while (0)
#define KRD(G, j) do { if (G) { kload2(kf, kp0 + sl_next, j); SBAR(); } } while (0)
#define STEP(C0, C1, P0, P1, t, GK, GV, GL, MSK) do { SBAR(); \
    const lds_cptr vp_ = vp0 + sl_prev; \
    VRD(0); SBAR(); float sacc = (P0[0] + P0[1]); \
    GAPA(C0 = __builtin_amdgcn_mfma_f32_32x32x16_bf16(kf[0], qr[0], negm, 0, 0, 0), P0[2], P0[3], P0[4], P0[5],     pw0[0] = PKW(P0, 0), pw0[1] = PKW(P0, 2), pw0); \
    VRD(4); SBAR(); GAPA(C1 = __builtin_amdgcn_mfma_f32_32x32x16_bf16(kf[1], qr[0], negm, 0, 0, 0), P0[6], P0[7], P0[8], P0[9],     pw0[2] = PKW(P0, 4), pw0[3] = PKW(P0, 6), pw0); \
    VRD(1); SBAR(); GAPA(C0 = __builtin_amdgcn_mfma_f32_32x32x16_bf16(kf[2], qr[1], C0, 0, 0, 0),   P0[10], P0[11], P0[12], P0[13], pw1[0] = PKW(P0, 8), pw1[1] = PKW(P0, 10), pw1); \
    VRD(5); SBAR(); GAPA(C1 = __builtin_amdgcn_mfma_f32_32x32x16_bf16(kf[3], qr[1], C1, 0, 0, 0),   P0[14], P0[15], P1[0], P1[1],   pw1[2] = PKW(P0, 12), pw1[3] = PKW(P0, 14), pw1); \
    VRD(2); SBAR(); GAPA(C0 = __builtin_amdgcn_mfma_f32_32x32x16_bf16(kf[4], qr[2], C0, 0, 0, 0),   P1[2], P1[3], P1[4], P1[5],     pw2[0] = PKW(P1, 0), pw2[1] = PKW(P1, 2), pw2); \
    VRD(6); SBAR(); GAPA(C1 = __builtin_amdgcn_mfma_f32_32x32x16_bf16(kf[5], qr[2], C1, 0, 0, 0),   P1[6], P1[7], P1[8], P1[9],     pw2[2] = PKW(P1, 4), pw2[3] = PKW(P1, 6), pw2); \
    VRD(3); SBAR(); GAPA(C0 = __builtin_amdgcn_mfma_f32_32x32x16_bf16(kf[6], qr[3], C0, 0, 0, 0),   P1[10], P1[11], P1[12], P1[13], pw3[0] = PKW(P1, 8), pw3[1] = PKW(P1, 10), pw3); \
    asm volatile("s_waitcnt lgkmcnt(13)" ::: "memory"); VRD(7); SBAR(); GAPA(C1 = __builtin_amdgcn_mfma_f32_32x32x16_bf16(kf[7], qr[3], C1, 0, 0, 0),   P1[14], P1[15], 0.f, 0.f,       pw3[2] = PKW(P1, 12), pw3[3] = PKW(P1, 14), pw3); \
    l_reg += sacc; \
    if (GK) { DMA_K((t) + 3, sl_cur); } if (GV) { DMA_V((t) + 1, sl_next); } \
    if (MSK) { MASKS(C0, C1, t); } \
    { float a = MX3(C0[0], C0[1], C1[0]), b = MX3(C0[2], C0[3], C1[1]); a = MX3(a, C1[2], C1[3]); \
      _Pragma("unroll") for (int r = 4; r < 16; r += 4) { a = MX3(a, C0[r], C0[r + 1]); b = MX3(b, C0[r + 2], C0[r + 3]); a = MX3(a, C1[r], C1[r + 1]); b = MX3(b, C1[r + 2], C1[r + 3]); } \
      float rm = __builtin_fmaxf(a, b); { auto rr = __builtin_amdgcn_permlane32_swap(__float_as_uint(rm), __float_as_uint(rm), false, false); rm = __builtin_fmaxf(__uint_as_float(rr[0]), __uint_as_float(rr[1])); } \
      resc = false; \
      if (__builtin_expect(__any(rm > (float)THRL), 0)) { const float dl = __builtin_fmaxf(rm, 0.f); mhat += dl; \
        _Pragma("unroll") for (int r = 0; r < 16; ++r) { C0[r] -= dl; C1[r] -= dl; } \
        const float nv_ = MOFF(t) - mhat; _Pragma("unroll") for (int r = 0; r < 16; ++r) negm[r] = nv_; asm volatile("" : "+v"(negm)); \
        const float f = __builtin_amdgcn_exp2f(-dl); l_reg *= f; { const int l2_ = lane_id(); if (l2_ < 32) wsf[l2_] = f; } resc = true; } } \
    SBAR(); \
    GAPB(o[0] = __builtin_amdgcn_mfma_f32_32x32x16_bf16(PAF(0), VFR(0), o[0], 0, 0, 0), C0, 0); \
    GAPB(o[1] = __builtin_amdgcn_mfma_f32_32x32x16_bf16(PAF(0), VFR(4), o[1], 0, 0, 0), C0, 4); \
    KRD(GL, 0); GAPB(o[0] = __builtin_amdgcn_mfma_f32_32x32x16_bf16(PAF(1), VFR(1), o[0], 0, 0, 0), C0, 8); \
    KRD(GL, 1); GAPB(o[1] = __builtin_amdgcn_mfma_f32_32x32x16_bf16(PAF(1), VFR(5), o[1], 0, 0, 0), C0, 12); \
    KRD(GL, 2); GAPB(o[0] = __builtin_amdgcn_mfma_f32_32x32x16_bf16(PAF(2), VFR(2), o[0], 0, 0, 0), C1, 0); \
    KRD(GL, 3); GAPB(o[1] = __builtin_amdgcn_mfma_f32_32x32x16_bf16(PAF(2), VFR(6), o[1], 0, 0, 0), C1, 4); \
    GAPB(o[0] = __builtin_amdgcn_mfma_f32_32x32x16_bf16(PAF(3), VFR(3), o[0], 0, 0, 0), C1, 8); \
    GAPB(o[1] = __builtin_amdgcn_mfma_f32_32x32x16_bf16(PAF(3), VFR(7), o[1], 0, 0, 0), C1, 12); \
    } while (0)
    int t = 1;
    const int tb = (NT - 9 > 1) ? NT - 9 : 1;
    for (; t < tb; t += 2) {
        STEP(pB0, pB1, pA0, pA1, t, true, true, true, false);         WAIT_BAR(2); RESC(); ROT();
        UPD(t + 1);
        STEP(pA0, pA1, pB0, pB1, t + 1, true, true, true, false);     WAIT_BAR(2); RESC(); ROT();
    }
#define ENDW(tt) do { if ((tt) + 3 < NT) { WAIT_BAR(2); } else if ((tt) + 2 < NT) { WAIT_BAR(1); } else { WAIT_BAR(0); } } while (0)
    for (; t + 1 < NT; t += 2) {
        STEP(pB0, pB1, pA0, pA1, t, (t + 3 < NT), (t + 1 < NT), (t + 1 < NT), true);         ENDW(t);     RESC(); BIASM(pB0, pB1, t); ROT();
        UPD(t + 1);
        STEP(pA0, pA1, pB0, pB1, t + 1, (t + 4 < NT), (t + 2 < NT), (t + 2 < NT), true);     ENDW(t + 1); RESC(); BIASM(pA0, pA1, t + 1); ROT();
    }
    STEP(pB0, pB1, pA0, pA1, NT - 1, false, false, false, true); RESC(); asm volatile("s_waitcnt lgkmcnt(0)" ::: "memory"); BIASM(pB0, pB1, NT - 1);
    { float sacc = pB0[0] + pB0[1]; _Pragma("unroll") for (int r = 2; r < 16; ++r) sacc += pB0[r]; _Pragma("unroll") for (int r = 0; r < 16; ++r) sacc += pB1[r]; l_reg += sacc;
      pw0 = (u32x4){PKW(pB0, 0), PKW(pB0, 2), PKW(pB0, 4), PKW(pB0, 6)}; pw1 = (u32x4){PKW(pB0, 8), PKW(pB0, 10), PKW(pB0, 12), PKW(pB0, 14)}; pw2 = (u32x4){PKW(pB1, 0), PKW(pB1, 2), PKW(pB1, 4), PKW(pB1, 6)}; pw3 = (u32x4){PKW(pB1, 8), PKW(pB1, 10), PKW(pB1, 12), PKW(pB1, 14)};
      SBAR(); pv(o, vb0 + sl_cur, PAF(0), PAF(1), PAF(2), PAF(3)); }
#undef PKW
#undef PAF
#undef VFR
#undef PIN
#undef MX3
#undef GAPA
#undef GAPB
#undef EX
#undef VRD
#undef KRD
#undef STEP
#undef ENDW
    { auto rr = __builtin_amdgcn_permlane32_swap(__float_as_uint(l_reg), __float_as_uint(l_reg), false, false); l_reg = __uint_as_float(rr[0]) + __uint_as_float(rr[1]); }
    if (hi == 0) wsf[32 + r32] = l_reg; asm volatile("s_waitcnt lgkmcnt(0)" ::: "memory");
    float rli[16];
#pragma unroll
    for (int r = 0; r < 16; ++r) rli[r] = __builtin_amdgcn_rcpf(wsf[32 + crow(r, hi)]);
    bf16_t* Ow = O + (rowbase + q0 + wid * QBLK) * DMA_ + h * 64;
    { LAS bf16_t* stg = (LAS bf16_t*)((LAS char*)shm + LDS_OST) + wid * 2048;
#pragma unroll
        for (int r = 0; r < 16; ++r) { const int orow = crow(r, hi);
#pragma unroll
            for (int d0 = 0; d0 < 2; ++d0) stg[orow * 64 + d0 * 32 + r32] = (bf16_t)(pk2(o[d0][r] * rli[r], 0.f) & 0xffffu); }
        asm volatile("s_waitcnt lgkmcnt(0)" ::: "memory");
#pragma unroll
        for (int i = 0; i < 4; ++i) { const int row = i * 8 + (lane >> 3), ch = lane & 7; const u32x4 v = *(const LAS u32x4*)(stg + row * 64 + ch * 8); *(u32x4*)(Ow + (long)row * DMA_ + ch * 8) = v; } }
    asm volatile("s_waitcnt lgkmcnt(0)\n\ts_barrier" ::: "memory");
#undef DMA_K
#undef DMA_V
#undef MASKS
#undef BIASM
#undef UPD
#undef MOFF
#undef START
#undef RESC
#undef ROT
}
#undef SBAR
#undef WAIT_BAR
}

DI void ssm_scan(Frame& F) {
    const float* Hloc = (const float*)(F.ws + WS_HLOC); bf16_t* Assm = (bf16_t*)(F.ws + WS_ASSM); const float* a16 = (const float*)(F.ws + WS_SMALL + 128 * 1024);
    const int gw = F.vcu * 8 + F.wave, NGW = F.G * 8, p = FLANE;
    for (int task = gw; task < 128; task += NGW) {
        const int g = task >> 2, b = task & 3;
        const float ar = a16[(g * 64 + p) * 2], ai = a16[(g * 64 + p) * 2 + 1];
        float sr = 0.f, si = 0.f;
        const float* hl = Hloc + ((size_t)g * 1024 + b * 256) * 128; bf16_t* ao = Assm + ((size_t)g * 1024 + b * 256) * 384 + 256;
        for (int c0 = 0; c0 < 256; c0 += 8) {
            float lr[8], li[8];
#pragma unroll
            for (int j = 0; j < 8; ++j) { lr[j] = hl[(size_t)(c0 + j) * 128 + p]; li[j] = hl[(size_t)(c0 + j) * 128 + 64 + p]; }
#pragma unroll
            for (int j = 0; j < 8; ++j) {
                ao[(size_t)(c0 + j) * 384 + p] = (bf16_t)(pk2(sr, 0.f) & 0xffffu); ao[(size_t)(c0 + j) * 384 + 64 + p] = (bf16_t)(pk2(si, 0.f) & 0xffffu);
                const float nr = ar * sr - ai * si + lr[j], ni = ar * si + ai * sr + li[j]; sr = nr; si = ni; }
        }
    }
}

DI void topk_tokens(Frame& F) {
    const float* scores = (const float*)(F.ws + WS_SCORES); const float* rbias = in_ptr<IN_RBIAS>();
    int* top_idx = (int*)(F.ws + WS_ROUTE); float* top_w = (float*)(F.ws + WS_ROUTE + 512 * 1024); int* rank = (int*)(F.ws + WS_ROUTE + 1024 * 1024);
    unsigned* cnt = (unsigned*)(F.ws + WS_CTL) + CW_CNT;
    LAS unsigned* lcnt = (LAS unsigned*)F.lds;
    LAS int* le = (LAS int*)(F.lds + 1024);
    LAS unsigned* lr = (LAS unsigned*)(F.lds + 3072);
    LAS float* lw = (LAS float*)(F.lds + 5120);
    const int l = FLANE, tid = FTID;
    const f32x4 rb = *(const f32x4*)(rbias + 4 * l);
    for (int blk = F.vcu; blk < M / 64; blk += F.G) {
        __syncthreads();
        if (tid < 256) lcnt[tid] = 0u;
        __syncthreads();
#pragma unroll 1
        for (int tt = 0; tt < 8; ++tt) {
            const int tl = F.wave * 8 + tt, t = blk * 64 + tl;
            const f32x4 sc = *(const f32x4*)(scores + (size_t)t * 256 + 4 * l);
            float v[4] = {sc.x + rb.x, sc.y + rb.y, sc.z + rb.z, sc.w + rb.w};
            float m1 = fmaxf(v[0], v[1]), m2 = fminf(v[0], v[1]);
            { const float a = fmaxf(v[2], v[3]), c = fminf(v[2], v[3]); const float n1 = fmaxf(m1, a), n2 = fmaxf(fminf(m1, a), fmaxf(m2, c)); m1 = n1; m2 = n2; }
#pragma unroll
            for (int o = 1; o < 8; o <<= 1) { const float o1 = __shfl_xor(m1, o), o2 = __shfl_xor(m2, o); const float n1 = fmaxf(m1, o1), n2 = fmaxf(fminf(m1, o1), fmaxf(m2, o2)); m1 = n1; m2 = n2; }
            const float gs = m1 + m2; const int myg = l >> 3; int higher = 0;
#pragma unroll
            for (int j = 0; j < 8; ++j) { const float og = __shfl(gs, 8 * j); higher += (og > gs || (og == gs && j < myg)) ? 1 : 0; }
            if (higher >= 4) { v[0] = -1e30f; v[1] = -1e30f; v[2] = -1e30f; v[3] = -1e30f; }
            int my_e = 0; float my_s = 0.f, tot = 0.f;
#pragma unroll
            for (int k = 0; k < 8; ++k) {
                float bv = v[0]; int bi = 4 * l;
                if (v[1] > bv) { bv = v[1]; bi = 4 * l + 1; } if (v[2] > bv) { bv = v[2]; bi = 4 * l + 2; } if (v[3] > bv) { bv = v[3]; bi = 4 * l + 3; }
#pragma unroll
                for (int o = 1; o < 64; o <<= 1) { const float ov = __shfl_xor(bv, o); const int oi = __shfl_xor(bi, o); if (ov > bv || (ov == bv && oi < bi)) { bv = ov; bi = oi; } }
                const float mys = (bi == 4 * l) ? sc.x : (bi == 4 * l + 1) ? sc.y : (bi == 4 * l + 2) ? sc.z : sc.w;
                const float ssel = __shfl(mys, bi >> 2);
                if (bi == 4 * l) v[0] = -3e38f; if (bi == 4 * l + 1) v[1] = -3e38f; if (bi == 4 * l + 2) v[2] = -3e38f; if (bi == 4 * l + 3) v[3] = -3e38f;
                tot += ssel; if (l == k) { my_e = bi; my_s = ssel; }
            }
            if (l < 8) { le[tl * 8 + l] = my_e; lw[tl * 8 + l] = my_s / tot * 2.5f; lr[tl * 8 + l] = __hip_atomic_fetch_add(lcnt + my_e, 1u, __ATOMIC_RELAXED, __HIP_MEMORY_SCOPE_WORKGROUP); }
        }
        __syncthreads();
        if (tid < 256) { const unsigned c = lcnt[tid]; unsigned base = 0u; if (c) base = atomicAdd(cnt + tid, c); lcnt[tid] = base; }
        __syncthreads();
        { const int e = le[tid]; const size_t gi = (size_t)blk * 512 + tid; top_idx[gi] = e; top_w[gi] = lw[tid]; rank[gi] = (int)(lr[tid] + lcnt[e]); }
    }
    __syncthreads();
}
DI int build_tiles(Frame& F) {
    const unsigned* cnt = (const unsigned*)(F.ws + WS_CTL) + CW_CNT;
    LAS unsigned* sa = (LAS unsigned*)(F.lds + SCAN_OFF); LAS unsigned* sb = sa + 256; LAS unsigned short* tile_e = (LAS unsigned short*)(F.lds + TILEE_OFF);
    LAS unsigned* misc = (LAS unsigned*)(F.lds + MISC_OFF);
    const int tid = FTID; unsigned nt = 0, cn = 0;
    __syncthreads();
    if (tid < 256) { cn = __hip_atomic_load(cnt + tid, __ATOMIC_RELAXED, __HIP_MEMORY_SCOPE_AGENT); nt = (cn + 255u) >> 8; sa[tid] = nt; }
    __syncthreads();
    LAS unsigned* src = sa; LAS unsigned* dst = sb;
    for (int o = 1; o < 256; o <<= 1) { if (tid < 256) { unsigned v = src[tid]; if (tid >= o) v += src[tid - o]; dst[tid] = v; } __syncthreads(); LAS unsigned* tmp = src; src = dst; dst = tmp; }
    if (tid < 256) { const unsigned incl = src[tid], first = incl - nt; for (unsigned k = 0; k < nt; ++k) if (first + k < MAXTILES) { tile_e[first + k] = (unsigned short)tid; const unsigned rem = cn - 256u * k; tile_e[MAXTILES + first + k] = (unsigned short)(rem > 256u ? 256u : rem); } dst[tid] = first; if (tid == 255) misc[16] = incl; }
    __syncthreads();
    if (tid < 256) sa[tid] = dst[tid];
    __syncthreads();
    int ntl = (int)misc[16]; if (ntl > MAXTILES) ntl = MAXTILES; return ntl;
}
DI void route_scatter(Frame& F) {
    const int* top_idx = (const int*)(F.ws + WS_ROUTE); const float* top_w = (const float*)(F.ws + WS_ROUTE + 512 * 1024); const int* rank = (const int*)(F.ws + WS_ROUTE + 1024 * 1024);
    int* rowoff = (int*)(F.ws + WS_ROUTE + 2 * MiB); float* roww = (float*)(F.ws + WS_ROUTE + 3 * MiB); int* dest = (int*)(F.ws + WS_ROUTE + 4 * MiB);
    (void)build_tiles(F);
    LAS unsigned* first = (LAS unsigned*)(F.lds + SCAN_OFF);
    const int gt = F.vcu * 512 + FTID, NT = F.G * 512;
    for (int i = gt; i < M * 8; i += NT) { const int e = top_idx[i]; const int pos = (int)first[e] * 256 + rank[i];
        if (pos < MAXROWS) { rowoff[pos] = (i >> 3) * (DM * 2); roww[pos] = top_w[i]; dest[pos] = i; } }
}
DI void route_clear(Frame& F) {
    int* rowoff = (int*)(F.ws + WS_ROUTE + 2 * MiB); float* roww = (float*)(F.ws + WS_ROUTE + 3 * MiB); int* dest = (int*)(F.ws + WS_ROUTE + 4 * MiB);
    const int gt = F.vcu * 512 + FTID, NT = F.G * 512;
    for (int i = gt; i < MAXROWS; i += NT) { rowoff[i] = 0; roww[i] = 0.f; dest[i] = -1; }
}
DI void combine(Frame& F) {
    const float* mod = (const float*)(F.ws + WS_SMALL); const bf16_t* ysh = (const bf16_t*)(F.ws + WS_YSH); const bf16_t* Y = (const bf16_t*)(F.ws + WS_Y);
    const int gw = F.vcu * 8 + F.wave, NGW = F.G * 8;
    for (int t = gw; t < M; t += NGW) { const int b = t / SEQ;
#pragma unroll
        for (int hf = 0; hf < 2; ++hf) { const int col = hf * 512 + FLANE * 8;
            const u32x4 s = *(const u32x4*)(ysh + (size_t)t * 1024 + col);
            float a[8] = {bflo(s.x), bfhi(s.x), bflo(s.y), bfhi(s.y), bflo(s.z), bfhi(s.z), bflo(s.w), bfhi(s.w)};
            u32x4 yv[8];
#pragma unroll
            for (int k = 0; k < 8; ++k) yv[k] = *(const u32x4*)(Y + ((size_t)t * 8 + k) * 1024 + col);
#pragma unroll
            for (int k = 0; k < 8; ++k) { a[0] += bflo(yv[k].x); a[1] += bfhi(yv[k].x); a[2] += bflo(yv[k].y); a[3] += bfhi(yv[k].y); a[4] += bflo(yv[k].z); a[5] += bfhi(yv[k].z); a[6] += bflo(yv[k].w); a[7] += bfhi(yv[k].w); }
            float* o = F.out + (size_t)t * 1024 + col; const float* g2 = mod + b * 6144 + 5120 + col;
            const f32x4 x0 = *(const f32x4*)o, x1 = *(const f32x4*)(o + 4), g0 = *(const f32x4*)g2, g1 = *(const f32x4*)(g2 + 4);
            *(f32x4*)o = x0 + g0 * (f32x4){a[0], a[1], a[2], a[3]}; *(f32x4*)(o + 4) = x1 + g1 * (f32x4){a[4], a[5], a[6], a[7]}; }
    }
}

constexpr int NPHASE = 17;
__global__ void __launch_bounds__(512, 2) mk_fwd(Args args) {
    extern __shared__ __attribute__((aligned(16))) unsigned char lds_raw[];
    Frame F;
    F.lds = (LAS unsigned char*)lds_raw; F.wave = __builtin_amdgcn_readfirstlane((int)threadIdx.x >> 6);
    F.G = gridDim.x; { const int bx = blockIdx.x; F.vcu = (F.G % 8 == 0) ? (bx % 8) * (F.G / 8) + bx / 8 : bx; }
    F.in.dummy = 0; F.out = args.out; F.ws = args.ws;
    unsigned char* ws = args.ws;
    volatile LAS unsigned* MISC = (volatile LAS unsigned*)(F.lds + MISC_OFF);
    LAS unsigned* gtab = (LAS unsigned*)(F.lds + GTAB_OFF);
    for (int u = FTID; u < 64; u += 512) MISC[u] = 0u;
    __syncthreads();
    unsigned* ctl = (unsigned*)(ws + WS_CTL);
    XcdBarrier bar; bar.bar = ctl + CW_BAR; bar.x = 0; bar.st = nullptr; bar.wave = F.wave;
    if (!MK_PER_PHASE) bar = xcd_barrier_post(ctl + CW_BAR, MISC + 8, F.wave);
    const int lo = args.ph_lo, hi = args.ph_hi;
#ifndef ONLY_PHASE
#define ONLY_PHASE -1
#endif
#define IN(k) ((ONLY_PHASE < 0 || ONLY_PHASE == (k)) && lo <= (k) && (k) < hi)
#ifndef PROBE_PHASE
#define PROBE_PHASE -1
#endif
#ifndef PROBE_AMP
#define PROBE_AMP 4
#endif
    unsigned long long pr_t0 = 0, pr_dt = 0;
#define SEAM(k) do { if (IN(k) && IN((k) + 1)) xcd_barrier(bar); \
    if (PROBE_PHASE >= 0) { if ((k) + 1 == PROBE_PHASE) pr_t0 = __builtin_amdgcn_s_memrealtime(); if ((k) == PROBE_PHASE) pr_dt = __builtin_amdgcn_s_memrealtime() - pr_t0; } } while (0)
    const int G = F.G, bx = (int)blockIdx.x;
    float* mod = (float*)(ws + WS_SMALL);

    if (PROBE_PHASE == 0) pr_t0 = __builtin_amdgcn_s_memrealtime();
    if (IN(0)) {
        if (bx < 96) p0_adaln(F, bx); else if (bx < 224) p0_ssm(F, (bx - 96) >> 2, (bx - 96) & 3);
        conv_items(F, 0, I_SMALL);
    }
    SEAM(0);
    if (IN(1)) norm_mod_rows(F, in_ptr<IN_X>(), in_ptr<IN_LN1G>(), 0, 1024, (bf16_t*)(ws + WS_H));
    SEAM(1);
    if (IN(2)) {
        pg8::Gemm g{DM, DM, DM}; DenseSched S; S.init(M, INW, G, bx, ws + WS_H, DM, ws + WS_WIN, DM);
        EpiInProj E{(bf16_t*)(ws + WS_Q), (bf16_t*)(ws + WS_K), (bf16_t*)(ws + WS_V), (bf16_t*)(ws + WS_ASSM), (bf16_t*)(ws + WS_SGA), (bf16_t*)(ws + WS_SGS), (float*)(ctl + CW_KMEAN), in_ptr<IN_QG>(), in_ptr<IN_KG>()};
        pg8::gemm_phase<EpiInProj, DenseSched, true, false>(F.lds, gtab, F.wave, g, S, E);
    }
    SEAM(2);
    if (IN(3)) {
#pragma unroll 1
        for (int ui = F.vcu * 2; ui < 512; ui += 2 * G) {
#pragma unroll 1
            for (int k2 = 0; k2 < 2; ++k2) { const int pi = ui >> 1, bh = pi >> 3, s = pi & 7, qb = k2 ? s : 15 - s;
                att::attn_unit<8>(F.wave, bh >> 3, bh & 7, qb, (const bf16_t*)(ws + WS_Q), (const bf16_t*)(ws + WS_K), (const bf16_t*)(ws + WS_V), (bf16_t*)(ws + WS_Q), (char*)lds_raw, (const float*)(ctl + CW_KMEAN), in_ptr<IN_RELB>()); } }
        __syncthreads();
        pg8::Gemm g{384, 256, 256}; SsmSched S{G, F.vcu, (const char*)(ws + WS_ASSM), (const char*)(ws + WS_ET), (size_t)256 * 256 * 2};
        EpiS1 E{(float*)(ws + WS_HLOC)};
        pg8::gemm_phase<EpiS1, SsmSched, true, false>(F.lds, gtab, F.wave, g, S, E);
    }
    SEAM(3);
    if (IN(4)) ssm_scan(F);
    SEAM(4);
    if (IN(5)) {
        pg8::Gemm g{384, 384, 384}; SsmSched S{G, F.vcu, (const char*)(ws + WS_ASSM), (const char*)(ws + WS_TF), (size_t)256 * 384 * 2};
        EpiS2 E{(const bf16_t*)(ws + WS_ASSM), in_ptr<IN_SSMD>(), (bf16_t*)(ws + WS_GBUF)};
        pg8::gemm_phase<EpiS2, SsmSched, true, false>(F.lds, gtab, F.wave, g, S, E);
    }
    SEAM(5);
    if (IN(6)) {
        pg8::Gemm g{512, 512, 512}; GluUpSched S{G, F.vcu, (const char*)(ws + WS_GBUF), (const char*)(ws + WS_WGLU), (const char*)(ws + WS_Q), (const char*)(ws + WS_WUPA)};
        EpiGluUp E{(const bf16_t*)(ws + WS_GBUF), in_ptr<IN_BGLU>(), (bf16_t*)(ws + WS_SOUT), (const bf16_t*)(ws + WS_SGA), (bf16_t*)(ws + WS_P1)};
        pg8::gemm_phase<EpiGluUp, GluUpSched, true, false>(F.lds, gtab, F.wave, g, S, E);
    }
    SEAM(6);
    if (IN(7)) {
        pg8::Gemm g{512, 512, 512}; DenseSched S; S.init(M, DM, G, bx, ws + WS_SOUT, 512, ws + WS_WUPS, 512);
        EpiUp2 E{(const bf16_t*)(ws + WS_P1), (const bf16_t*)(ws + WS_SGS), (bf16_t*)(ws + WS_MIX)};
        pg8::gemm_phase<EpiUp2, DenseSched, true, false>(F.lds, gtab, F.wave, g, S, E);
    }
    SEAM(7);
    if (IN(8)) {
        pg8::Gemm g{DM, DM, DM}; DenseSched S; S.init(M, DM, G, bx, ws + WS_MIX, DM, ws + WS_WOUT, DM);
        EpiOut E{in_ptr<IN_X>(), mod, F.out};
        pg8::gemm_phase<EpiOut, DenseSched, true, false>(F.lds, gtab, F.wave, g, S, E);
    }
    SEAM(8);
    if (IN(9)) norm_mod_rows(F, F.out, in_ptr<IN_LN2G>(), 3072, 4096, (bf16_t*)(ws + WS_H));
    SEAM(9);
    if (IN(10)) {
        pg8::Gemm g{DM, DM, DM}; DenseSched S; S.init(M, 768, G, bx, ws + WS_H, DM, ws + WS_WRSH, DM);
        EpiRsh E{(float*)(ws + WS_SCORES), (bf16_t*)(ws + WS_HS)};
        pg8::gemm_phase<EpiRsh, DenseSched, true, false>(F.lds, gtab, F.wave, g, S, E);
    }
    SEAM(10);
    if (IN(11)) {
        route_clear(F);
        topk_tokens(F);
        __syncthreads();
        pg8::Gemm g{ED, ED, ED}; DenseSched S; S.init(M, DM, G, bx, ws + WS_HS, ED, ws + WS_WSHD, ED);
        EpiBf16 E{(bf16_t*)(ws + WS_YSH), 1024};
        pg8::gemm_phase<EpiBf16, DenseSched, true, false>(F.lds, gtab, F.wave, g, S, E);
    }
    SEAM(11);
    if (IN(12)) { route_scatter(F); conv_items(F, I_SMALL, I_SMALL + I_EG + I_EU); }
    SEAM(12);
    if (IN(13)) {
        const int ntl = build_tiles(F);
        pg8::Gemm g{DM, DM, DM};
        MoeSched S{G, F.vcu, 2, ntl, (const LAS unsigned short*)(F.lds + TILEE_OFF), (const char*)(ws + WS_H), (const char*)(ws + WS_WEGU), 0, (size_t)512 * DM * 2, (size_t)256 * DM * 2, (const int*)(ws + WS_ROUTE + 2 * MiB)};
        EpiMoe1 E{(bf16_t*)(ws + WS_HSORT)};
        pg8::gemm_phase<EpiMoe1, MoeSched, true, true>(F.lds, gtab, F.wave, g, S, E);
        conv_items(F, I_SMALL + I_EG + I_EU, NITEMS);
    }
    SEAM(13);
    if (IN(14)) {
        const int ntl = build_tiles(F);
        pg8::Gemm g{ED, ED, ED};
        MoeSched S{G, F.vcu, 4, ntl, (const LAS unsigned short*)(F.lds + TILEE_OFF), (const char*)(ws + WS_HSORT), (const char*)(ws + WS_WED), (size_t)256 * ED * 2, (size_t)DM * ED * 2, (size_t)256 * ED * 2, nullptr};
        EpiMoe2 E{(const int*)(ws + WS_ROUTE + 4 * MiB), (const float*)(ws + WS_ROUTE + 3 * MiB), (bf16_t*)(ws + WS_Y)};
        pg8::gemm_phase<EpiMoe2, MoeSched, true, false>(F.lds, gtab, F.wave, g, S, E);
    }
    SEAM(14);
    if (IN(15)) combine(F);
    if (PROBE_PHASE >= 0) { if (PROBE_PHASE == 15) { asm volatile("s_waitcnt vmcnt(0)" ::: "memory"); pr_dt = __builtin_amdgcn_s_memrealtime() - pr_t0; }
        if (blockIdx.x == 0) { const unsigned long long te = __builtin_amdgcn_s_memrealtime(); while (__builtin_amdgcn_s_memrealtime() - te < (unsigned long long)PROBE_AMP * pr_dt) __builtin_amdgcn_s_sleep(8); } }
#undef IN
#undef SEAM
}

extern "C" void kernel_launch(void* const* d_in, const int* in_sizes, int n_in, void* d_out, int out_size, void* d_ws, size_t ws_size, hipStream_t stream) {
    static int grid = 0;
    if (grid == 0) {
        if (n_in != 31 || out_size != M * DM || ws_size < WS_END) { fprintf(stderr, "kernel_launch: unexpected shapes (n_in %d out %d ws %zu)\n", n_in, out_size, ws_size); grid = -1; return; }
        int dev = 0, cus = 0;
        if (hipGetDevice(&dev) != hipSuccess || hipDeviceGetAttribute(&cus, hipDeviceAttributeMultiprocessorCount, dev) != hipSuccess) { grid = -1; return; }
        if (hipFuncSetAttribute((const void*)mk_fwd, hipFuncAttributeMaxDynamicSharedMemorySize, LDS_BYTES) != hipSuccess) { fprintf(stderr, "kernel_launch: hipFuncSetAttribute failed\n"); grid = -1; return; }
        int per_cu = 0;
        if (hipOccupancyMaxActiveBlocksPerMultiprocessor(&per_cu, (const void*)mk_fwd, 512, LDS_BYTES) != hipSuccess || per_cu < 1) fprintf(stderr, "kernel_launch: occupancy query says %d\n", per_cu);
        (void)hipGetLastError();
        grid = cus;
    }
    if (grid < 0) return;
    (void)hipMemsetAsync((char*)d_ws + WS_CTL, 0, CTL_ZERO_BYTES, stream);
    Args a{};
    for (int i = 0; i < 31; ++i) a.in[i] = (const float*)d_in[i];
    a.out = (float*)d_out; a.ws = (unsigned char*)d_ws;
#if MK_PER_PHASE
    for (int p = 0; p < NPHASE; ++p) { a.ph_lo = p; a.ph_hi = p + 1; hipLaunchKernelGGL(mk_fwd, dim3(grid), dim3(512), LDS_BYTES, stream, a); }
#else
    a.ph_lo = 0; a.ph_hi = NPHASE;
    hipLaunchKernelGGL(mk_fwd, dim3(grid), dim3(512), LDS_BYTES, stream, a);
#endif
}
```

```cpp
#include <hip/hip_runtime.h>
#include <cstdio>
#include <cstdint>

#ifndef MK_PER_PHASE
#define MK_PER_PHASE 0
#endif

#define LAS __attribute__((address_space(3)))
#define GAS __attribute__((address_space(1)))
typedef unsigned short bf16_t;
typedef short bf16x8 __attribute__((ext_vector_type(8)));
typedef short s16x4 __attribute__((ext_vector_type(4)));
typedef float f32x2 __attribute__((ext_vector_type(2)));
typedef float f32x4 __attribute__((ext_vector_type(4)));
typedef float f32x16 __attribute__((ext_vector_type(16)));
typedef unsigned u32x2 __attribute__((ext_vector_type(2)));
typedef unsigned u32x4 __attribute__((ext_vector_type(4)));
typedef __bf16 bf16x2_t __attribute__((ext_vector_type(2)));

#define DI __device__ __forceinline__
DI unsigned pk2(float lo, float hi) { f32x2 v = {lo, hi}; bf16x2_t b = __builtin_convertvector(v, bf16x2_t); return __builtin_bit_cast(unsigned, b); }
DI float bflo(unsigned w) { return __uint_as_float(w << 16); }
DI float bfhi(unsigned w) { return __uint_as_float(w & 0xffff0000u); }
DI float sigmoidf_(float x) { return 1.0f / (1.0f + __expf(-x)); }
DI float siluf_(float x) { return x / (1.0f + __expf(-x)); }
DI float gelu_tanh(float y) { const float z = 0.7978845608028654f * (y + 0.044715f * y * y * y); const float t = 1.0f - 2.0f / (__expf(2.0f * z) + 1.0f); return 0.5f * y * (1.0f + t); }

constexpr int NB = 4, SEQ = 4096, DM = 1024, M = NB * SEQ;
constexpr int NH = 8, HD = 64, AW = 512, SW = 512, INW = 4096;
constexpr int NE = 256, ED = 256, TOPK = 8;
constexpr int NG = 32, GC = 16, NS = 64, CH = 16, NCH = SEQ / CH;
constexpr int MAXTILES = 768, MAXROWS = MAXTILES * 256;
constexpr float EPSF = 1e-6f;
constexpr float LOG2E = 1.4426950408889634f;
constexpr float QC2 = 0.125f * LOG2E;

constexpr size_t MiB = 1u << 20;
constexpr size_t WS_CTL = 0, CTL_ZERO_BYTES = 1 * MiB;
constexpr size_t WS_SMALL = 1 * MiB;
constexpr size_t WS_WIN = 4 * MiB, WS_WGLU = 12 * MiB, WS_WUPA = 13 * MiB, WS_WUPS = 14 * MiB, WS_WOUT = 15 * MiB, WS_WRSH = 17 * MiB, WS_WSHD = 19 * MiB;
constexpr size_t WS_TF = 20 * MiB, WS_ET = 26 * MiB;
constexpr size_t WS_WEGU = 32 * MiB, WS_WED = 288 * MiB;
constexpr size_t WS_H = 416 * MiB;
constexpr size_t WS_Q = 448 * MiB, WS_K = 464 * MiB, WS_V = 480 * MiB;
constexpr size_t WS_ASSM = 496 * MiB, WS_HLOC = 520 * MiB;
constexpr size_t WS_GBUF = 536 * MiB, WS_SOUT = 552 * MiB;
constexpr size_t WS_SGA = 568 * MiB, WS_SGS = 600 * MiB;
constexpr size_t WS_P1 = 632 * MiB, WS_MIX = 664 * MiB;
constexpr size_t WS_SCORES = 696 * MiB, WS_HS = 712 * MiB, WS_YSH = 720 * MiB;
constexpr size_t WS_ROUTE = 752 * MiB;
constexpr size_t WS_HSORT = 760 * MiB;
constexpr size_t WS_Y = 416 * MiB;
constexpr size_t WS_END = 856 * MiB;
constexpr int CW_BAR = 4096;
constexpr int CW_CNT = 16384, CNT_STRIDE = 32;
constexpr int CW_KMEAN = 32768;

constexpr int RING_BYTES = 131072;
constexpr int GTAB_OFF = RING_BYTES;
constexpr int TILEE_OFF = GTAB_OFF + 2048;
constexpr int SCAN_OFF = TILEE_OFF + 3072;
constexpr int MISC_OFF = SCAN_OFF + 2048;
constexpr int LDS_BYTES = 147456;
static_assert(MISC_OFF + 256 <= LDS_BYTES, "LDS map");

namespace pg8 {
constexpr int BM = 256, BK = 64, HALF = 128, HTB = HALF * BK * 2, STAGE_BYTES = 8 * HTB, NXCD = 8, WGM = 8;
__host__ __device__ __forceinline__ int lds_byte(int r, int c) { const int st = (r >> 4) * 2 + (c >> 5), rr = r & 15, cc = c & 31, ob = rr * 64 + cc * 2; return st * 1024 + (ob ^ (((ob >> 9) & 1) << 5)); }
__host__ __device__ __forceinline__ void stage_rc(int b, int& R, int& C) { const int st = b / 1024, sb = b % 1024, swz = sb ^ (((sb >> 9) & 1) << 5); R = (st >> 1) * 16 + swz / 64; C = (st & 1) * 32 + (swz % 64) / 2; }
__host__ __device__ __forceinline__ int perm32(int rho) { const int n = rho >> 4, i = rho & 15; return 8 * (i >> 2) + 4 * n + (i & 3); }

struct Unit { const char* A; const char* B; const int* rowtab; int pm, pn, aux, half; };
struct Gemm { int lda, ldb, K; };

struct StaticOrder {
    int nM, nN, nwg, G, c;
    __device__ void init(int M_, int N_, int G_, int c_) { nM = M_ / BM; nN = N_ / BM; nwg = nM * nN; G = G_; c = c_; }
    __device__ bool next(int i, int& pm, int& pn) const {
        const long L = (long)i * G + c; if (L >= nwg) return false;
        int wgid = (int)L; { const int q = nwg / NXCD, r = nwg % NXCD, xcd = wgid % NXCD, off = wgid / NXCD; wgid = (xcd < r ? xcd * (q + 1) : r * (q + 1) + (xcd - r) * q) + off; }
        const int nig = WGM * nN, gid = wgid / nig, fm = gid * WGM, gsz = (nM - fm) < WGM ? (nM - fm) : WGM;
        pm = fm + ((wgid % nig) % gsz); pn = (wgid % nig) / gsz; return true;
    }
};

template <class Epi, class Sched, bool ALIGN_EPI, bool GATHER>
__device__ __forceinline__ void gemm_phase(LAS unsigned char* lds, LAS unsigned* gtab, const int wid, const Gemm g, const Sched& S, const Epi& E) {
    const int lane = (int)__builtin_amdgcn_mbcnt_hi(~0u, __builtin_amdgcn_mbcnt_lo(~0u, 0u)), tid = wid * 64 + lane, wr = wid >> 2, wc = wid & 3, fr = lane & 15, fq = lane >> 4;
    const int K = g.K, nt = K / BK;
    unsigned voffA[2], voffB[2]; int gR[2];
#pragma unroll
    for (int i = 0; i < 2; ++i) { int R, C; stage_rc(tid * 16 + i * 8192, R, C); const int Rb = Epi::PERM ? ((R & ~31) + perm32(R & 31)) : R;
        voffA[i] = GATHER ? (unsigned)(C * 2) : (unsigned)(R * g.lda + C) * 2u; voffB[i] = (unsigned)(Rb * g.ldb + C) * 2u; gR[i] = R; }
    const size_t kstep = (size_t)(BK * 2);
    const size_t hstepA = (size_t)HALF * g.lda * 2, hstepB = (size_t)HALF * g.ldb * 2;
    const unsigned ldsw = (unsigned)wid * 1024u;
    const int aoff = lds_byte(wr * 64 + fr, fq * 8), boff = lds_byte(wc * 32 + fr, fq * 8);
#define PG8_SA(b, h) (((b) * 2 + (h)) * HTB)
#define PG8_SB(b, h) ((4 + (b) * 2 + (h)) * HTB)
#define PG8_STAGEB(bufoff, gbase) do { _Pragma("unroll") for (int _i = 0; _i < 2; ++_i) \
        __builtin_amdgcn_global_load_lds((const unsigned*)((const char*)(gbase) + voffB[_i]), (LAS unsigned*)(lds + (bufoff) + ldsw + _i * 8192), 16, 0, 0); } while (0)
#define PG8_STAGEA(bufoff, gbase, par, half) do { _Pragma("unroll") for (int _i = 0; _i < 2; ++_i) { \
        const char* _src = GATHER ? ((const char*)(gbase) + gtab[(par) * 256 + (half) * 128 + gR[_i]] + voffA[_i]) : ((const char*)(gbase) + (size_t)(half) * hstepA + voffA[_i]); \
        __builtin_amdgcn_global_load_lds((const unsigned*)_src, (LAS unsigned*)(lds + (bufoff) + ldsw + _i * 8192), 16, 0, 0); } } while (0)
#define PG8_TABLOAD(par, un) do { __builtin_amdgcn_global_load_lds((const unsigned*)((un).rowtab + 64 * (wid & 3) + lane), (LAS unsigned*)(gtab + (par) * 256 + 64 * (wid & 3)), 4, 0, 0); } while (0)
#define PG8_LDA(dst, b, h) do { _Pragma("unroll") for (int m = 0; m < 4; ++m) _Pragma("unroll") for (int k = 0; k < 2; ++k) dst[m][k] = *(const LAS bf16x8*)(lds + PG8_SA(b, h) + aoff + m * 2048 + k * 1024); } while (0)
#define PG8_LDB(dst, b, h) do { _Pragma("unroll") for (int n = 0; n < 2; ++n) _Pragma("unroll") for (int k = 0; k < 2; ++k) dst[n][k] = *(const LAS bf16x8*)(lds + PG8_SB(b, h) + boff + n * 2048 + k * 1024); } while (0)
#define PG8_MMA(ai, bj, At, Bt) do { __builtin_amdgcn_s_setprio(1); _Pragma("unroll") for (int m = 0; m < 4; ++m) _Pragma("unroll") for (int n = 0; n < 2; ++n) _Pragma("unroll") for (int k = 0; k < 2; ++k) \
        acc[ai][bj][m][n] = __builtin_amdgcn_mfma_f32_16x16x32_bf16(Bt[n][k], At[m][k], acc[ai][bj][m][n], 0, 0, 0); __builtin_amdgcn_s_setprio(0); } while (0)
#define PG8_WAIT_V(n) asm volatile("s_waitcnt vmcnt(" #n ")" ::: "memory")
#define PG8_WAIT_L(n) asm volatile("s_waitcnt lgkmcnt(" #n ")" ::: "memory")
#define PG8_BAR __builtin_amdgcn_s_barrier()
#define PG8_SCHED __builtin_amdgcn_sched_barrier(0)
    Unit cur, nxt; int ui = 0;
    if (!S.next(0, cur)) return;
    f32x4 acc[2][2][4][2];
#pragma unroll
    for (int a = 0; a < 2; ++a)
#pragma unroll
        for (int b = 0; b < 2; ++b)
#pragma unroll
            for (int m = 0; m < 4; ++m)
#pragma unroll
                for (int n = 0; n < 2; ++n) acc[a][b][m][n] = (f32x4){0.f, 0.f, 0.f, 0.f};
    bf16x8 At[4][2], B0[2][2], B1[2][2];
    const char* cA = cur.A; const char* cB = cur.B;
    if constexpr (GATHER) { PG8_TABLOAD(0, cur); PG8_WAIT_V(0); PG8_BAR; }
    PG8_STAGEB(PG8_SB(0, 0), cB); PG8_STAGEB(PG8_SB(0, 1), cB + hstepB); PG8_STAGEA(PG8_SA(0, 0), cA, 0, 0); PG8_STAGEA(PG8_SA(0, 1), cA, 0, 1);
    if (wr == 1) PG8_BAR;
    PG8_WAIT_V(2); PG8_BAR;
    PG8_STAGEB(PG8_SB(1, 0), cB + kstep); PG8_STAGEA(PG8_SA(1, 0), cA + kstep, 0, 0); PG8_STAGEB(PG8_SB(1, 1), cB + hstepB + kstep);
    PG8_WAIT_V(6); PG8_BAR;
    for (;;) {
        const bool has_next = S.next(ui + 1, nxt);
        const char* nA = has_next ? nxt.A : cA; const char* nB = has_next ? nxt.B : cB;
        const int pc = ui & 1, pnx = has_next ? (pc ^ 1) : pc;
        if constexpr (GATHER) { if (has_next) PG8_TABLOAD(pc ^ 1, nxt); }
#pragma unroll 1
        for (int t = 0; t < nt; t += 2) {
            const bool last = (t == nt - 2);
            const char* a1 = cA + (size_t)(t + 1) * kstep;
            const char* a2 = last ? nA : cA + (size_t)(t + 2) * kstep; const char* b2 = last ? nB : cB + (size_t)(t + 2) * kstep;
            const char* a3 = a2 + kstep; const char* b3 = b2 + kstep;
            const int p2 = last ? pnx : pc;
            PG8_LDB(B0, 0, 0); PG8_LDB(B1, 0, 1); PG8_SCHED; PG8_LDA(At, 0, 0); PG8_STAGEA(PG8_SA(1, 1), a1, pc, 1);
            PG8_WAIT_V(8); PG8_WAIT_L(0); PG8_BAR; PG8_MMA(0, 0, At, B0); PG8_MMA(0, 1, At, B1); PG8_BAR; PG8_SCHED;
            PG8_LDA(At, 0, 1); PG8_STAGEB(PG8_SB(0, 0), b2); PG8_STAGEB(PG8_SB(0, 1), b2 + hstepB); PG8_STAGEA(PG8_SA(0, 0), a2, p2, 0);
            PG8_WAIT_V(8); PG8_WAIT_L(0); PG8_BAR; if (!cur.half) { PG8_MMA(1, 0, At, B0); PG8_MMA(1, 1, At, B1); } PG8_BAR; PG8_SCHED;
            PG8_LDB(B0, 1, 0); PG8_LDB(B1, 1, 1); PG8_SCHED; PG8_LDA(At, 1, 0); PG8_STAGEA(PG8_SA(0, 1), a2, p2, 1);
            PG8_WAIT_V(8); PG8_WAIT_L(0); PG8_BAR; PG8_MMA(0, 0, At, B0); PG8_MMA(0, 1, At, B1); PG8_BAR; PG8_SCHED;
            PG8_LDA(At, 1, 1); PG8_STAGEB(PG8_SB(1, 0), b3); PG8_STAGEB(PG8_SB(1, 1), b3 + hstepB); PG8_STAGEA(PG8_SA(1, 0), a3, p2, 0);
            PG8_WAIT_V(8); PG8_WAIT_L(0); PG8_BAR; if (!cur.half) { PG8_MMA(1, 0, At, B0); PG8_MMA(1, 1, At, B1); } PG8_BAR; PG8_SCHED;
        }
        if constexpr (ALIGN_EPI) { if (wr == 0) PG8_BAR; }
        { int fr_ = fr, fq_ = fq; asm volatile("" : "+v"(fr_), "+v"(fq_)); E(acc, cur, wr, wc, fr_, fq_); }
        if (!has_next) break;
#pragma unroll
        for (int a = 0; a < 2; ++a)
#pragma unroll
            for (int b = 0; b < 2; ++b)
#pragma unroll
                for (int m = 0; m < 4; ++m)
#pragma unroll
                    for (int n = 0; n < 2; ++n) acc[a][b][m][n] = (f32x4){0.f, 0.f, 0.f, 0.f};
        cur = nxt; cA = nA; cB = nB; ++ui;
        if constexpr (ALIGN_EPI) { if (wr == 1) PG8_BAR; }
    }
    PG8_WAIT_V(0);
    if constexpr (!ALIGN_EPI) { if (wr == 0) PG8_BAR; }
    PG8_BAR;
#undef PG8_SA
#undef PG8_SB
#undef PG8_STAGEA
#undef PG8_STAGEB
#undef PG8_TABLOAD
#undef PG8_LDA
#undef PG8_LDB
#undef PG8_MMA
#undef PG8_WAIT_V
#undef PG8_WAIT_L
#undef PG8_BAR
#undef PG8_SCHED
}
}

typedef f32x4 AccT[2][2][4][2];
using pg8::Unit;

typedef GAS unsigned gu32;
#define XB_TMO      128
#define XB_XCNT(j)  (256  + 64 * (j))
#define XB_XSUB(j)  (1280 + 64 * (j))
#define XB_XGEN(j)  (2304 + 64 * (j))
#define XB_TOP      3328
#define XB_TOPGEN   3392
#define XCD_BAR_WORDS 3456
#define XB_SPIN_CAP (1u << 20)
DI unsigned xb_ld(unsigned* p)              { return __hip_atomic_load(p, __ATOMIC_RELAXED, __HIP_MEMORY_SCOPE_AGENT); }
DI unsigned xb_add(unsigned* p, unsigned v) { return __hip_atomic_fetch_add(p, v, __ATOMIC_RELAXED, __HIP_MEMORY_SCOPE_AGENT); }
DI unsigned xb_xcc_id() { return (unsigned)__builtin_amdgcn_s_getreg((3 << 11) | 20) & 0xFu; }
#define XB_SPIN(cond, bar) do { unsigned _sp = 0; while (cond) { __builtin_amdgcn_s_sleep(1); \
    if ((++_sp & 255u) == 0u) { if (xb_ld(&(bar)[XB_TMO])) break; if (_sp > XB_SPIN_CAP) { atomicAdd(&(bar)[XB_TMO], 1u); break; } } } } while (0)
DI int lane_id() { int l = (int)__builtin_amdgcn_mbcnt_hi(~0u, __builtin_amdgcn_mbcnt_lo(~0u, 0u)); asm volatile("" : "+v"(l)); return l; }
struct XcdBarrier { unsigned* bar; unsigned x; volatile LAS unsigned* st; int wave; };
DI XcdBarrier xcd_barrier_post(unsigned* bar, volatile LAS unsigned* st, int wave) {
    XcdBarrier b; b.bar = bar; b.x = xb_xcc_id(); b.st = st; b.wave = wave;
    if (wave == 0 && lane_id() == 0) (void)xb_add(&bar[XB_XCNT(b.x)], 1u);
    return b;
}
DI void xcd_barrier_complete(unsigned* bar, unsigned x, unsigned& nloc, unsigned& nx) {
    const unsigned G = gridDim.x * gridDim.y * gridDim.z;
    unsigned sum, cnt, mine, sp = 0u;
    for (;;) {
        sum = 0u; cnt = 0u; mine = 0u;
#pragma unroll
        for (unsigned j = 0; j < 16; ++j) { const unsigned c = xb_ld(&bar[XB_XCNT(j)]); sum += c; cnt += (c > 0u) ? 1u : 0u; mine = (j == x) ? c : mine; }
        if (sum == G) break;
        __builtin_amdgcn_s_sleep(1);
        if ((++sp & 255u) == 0u) { if (xb_ld(&bar[XB_TMO])) break; if (sp > XB_SPIN_CAP) { atomicAdd(&bar[XB_TMO], 1u); break; } }
    }
    nloc = mine > 0u ? mine : 1u; nx = cnt > 0u ? cnt : 1u;
}
DI void xcd_barrier(const XcdBarrier& b) {
    asm volatile("s_waitcnt vmcnt(0)" ::: "memory");
    __syncthreads();
    if (b.wave == 0 && lane_id() == 0) {
        unsigned* bar = b.bar;
        __builtin_amdgcn_s_waitcnt(0);
        unsigned nloc = b.st[0], nx = b.st[1];
        if (nloc == 0u) { xcd_barrier_complete(bar, b.x, nloc, nx); b.st[0] = nloc; b.st[1] = nx; }
        const unsigned old = xb_add(&bar[XB_XSUB(b.x)], 1u);
        const unsigned gen = old / nloc;
        if (old + 1u == (gen + 1u) * nloc) {
            __builtin_amdgcn_fence(__ATOMIC_RELEASE, "agent");
            asm volatile("s_waitcnt vmcnt(0)" ::: "memory");
            const unsigned og = xb_add(&bar[XB_TOP], 1u);
            const unsigned tg = og / nx;
            if (og + 1u == (tg + 1u) * nx) xb_add(&bar[XB_TOPGEN], 1u);
            else XB_SPIN(xb_ld(&bar[XB_TOPGEN]) == tg, bar);
            __builtin_amdgcn_fence(__ATOMIC_ACQUIRE, "agent");
            xb_add(&bar[XB_XGEN(b.x)], 1u);
            asm volatile("s_waitcnt vmcnt(0)" ::: "memory");
        } else {
            XB_SPIN(xb_ld(&bar[XB_XGEN(b.x)]) == gen, bar);
            __builtin_amdgcn_fence(__ATOMIC_ACQUIRE, "agent");
            asm volatile("s_waitcnt vmcnt(0)" ::: "memory");
        }
    }
    __syncthreads();
}

struct Args { const float* in[31]; float* out; unsigned char* ws; int ph_lo, ph_hi; };
template <int I> DI const float* in_ptr() { const void* kp = (const void*)__builtin_amdgcn_kernarg_segment_ptr(); unsigned long long r;
    asm volatile("s_load_dwordx2 %0, %1, %2\n\ts_waitcnt lgkmcnt(0)" : "=s"(r) : "s"(kp), "i"(I * 8)); return (const float*)(const GAS float*)r; }
struct InTab { int dummy; };
struct Frame {
    LAS unsigned char* lds; int wave, vcu, G;
    InTab in; float* out; unsigned char* ws;
    DI int lane_() const { return lane_id(); }
    DI int tid_() const { return wave * 64 + lane_id(); }
};
#define FTID (F.tid_())
#define FLANE (F.lane_())
#define IN_X 0
#define IN_C 1
#define IN_RELB 2
#define IN_WADA 3
#define IN_BADA 4
#define IN_LN1G 5
#define IN_WIN 6
#define IN_QG 7
#define IN_KG 8
#define IN_LRE 9
#define IN_LIM 10
#define IN_LDT 11
#define IN_BRE 12
#define IN_BIM 13
#define IN_CRE 14
#define IN_CIM 15
#define IN_SSMD 16
#define IN_WGLU 17
#define IN_BGLU 18
#define IN_WUPA 19
#define IN_WUPS 20
#define IN_WOUT 21
#define IN_LN2G 22
#define IN_WROUTER 23
#define IN_RBIAS 24
#define IN_WEG 25
#define IN_WEU 26
#define IN_WED 27
#define IN_WSG 28
#define IN_WSU 29
#define IN_WSD 30

DI float wave_sum(float v) {
#pragma unroll
    for (int o = 1; o < 64; o <<= 1) v += __shfl_xor(v, o);
    return v;
}

template <class RowMap>
DI void tr_item(const float* W, int N, bf16_t* WT, int ldt, int k0, int n0, int lane, RowMap rm) {
    f32x4 v[32];
    const f32x4* src = (const f32x4*)(W + (size_t)k0 * N + n0) + lane;
#pragma unroll
    for (int i = 0; i < 32; ++i) v[i] = src[(size_t)i * (N / 4)];
#pragma unroll
    for (int c = 0; c < 4; ++c) {
        bf16_t* dst = WT + (size_t)rm(n0 + 4 * lane + c) * ldt + k0;
#pragma unroll
        for (int j = 0; j < 4; ++j) { u32x4 o; o.x = pk2(v[8 * j][c], v[8 * j + 1][c]); o.y = pk2(v[8 * j + 2][c], v[8 * j + 3][c]); o.z = pk2(v[8 * j + 4][c], v[8 * j + 5][c]); o.w = pk2(v[8 * j + 6][c], v[8 * j + 7][c]);
            *(u32x4*)(dst + 8 * j) = o; } }
}
struct RmGen { int kind, base; DI int operator()(int n) const { if (kind == 0) return base + n;
    if (kind == 1) { if (n >= 1024) return n; const int tile = n >> 8, w = n & 255, hh = w >> 6, bj = (w >> 5) & 1, i = w & 31; return tile * 256 + 128 * bj + 32 * hh + i; }
    return base + 256 * (n >> 7) + (n & 127); } };
constexpr int I_WIN = 32 * 16, I_GLU = 16 * 2, I_UPA = 16 * 4, I_UPS = 16 * 4, I_OUT = 32 * 4, I_RT = 32, I_SG = 32, I_SU = 32, I_SD = 8 * 4;
constexpr int I_SMALL = I_WIN + I_GLU + I_UPA + I_UPS + I_OUT + I_RT + I_SG + I_SU + I_SD;
constexpr int I_EG = 256 * 32, I_EU = 256 * 32, I_EDN = 256 * 32;
constexpr int NITEMS = I_SMALL + I_EG + I_EU + I_EDN;
DI void conv_items(Frame& F, int lo, int hi) {
    const int gw = F.vcu * 8 + F.wave, NGW = F.G * 8, lane = FLANE;
    unsigned char* ws = F.ws;
#pragma unroll 1
    for (int it = lo + gw; it < hi; it += NGW) {
        int r = it; const float* W; int N, ldt, k0, n0; bf16_t* WT; RmGen rm{0, 0};
        if (r < I_WIN) { W = in_ptr<IN_WIN>(); N = INW; WT = (bf16_t*)(ws + WS_WIN); ldt = DM; k0 = 32 * (r / 16); n0 = 256 * (r % 16); rm.kind = 1; }
        else if ((r -= I_WIN) < I_GLU) { W = in_ptr<IN_WGLU>(); N = SW; WT = (bf16_t*)(ws + WS_WGLU); ldt = SW; k0 = 32 * (r / 2); n0 = 256 * (r % 2); }
        else if ((r -= I_GLU) < I_UPA) { W = in_ptr<IN_WUPA>(); N = DM; WT = (bf16_t*)(ws + WS_WUPA); ldt = AW; k0 = 32 * (r / 4); n0 = 256 * (r % 4); }
        else if ((r -= I_UPA) < I_UPS) { W = in_ptr<IN_WUPS>(); N = DM; WT = (bf16_t*)(ws + WS_WUPS); ldt = SW; k0 = 32 * (r / 4); n0 = 256 * (r % 4); }
        else if ((r -= I_UPS) < I_OUT) { W = in_ptr<IN_WOUT>(); N = DM; WT = (bf16_t*)(ws + WS_WOUT); ldt = DM; k0 = 32 * (r / 4); n0 = 256 * (r % 4); }
        else if ((r -= I_OUT) < I_RT) { W = in_ptr<IN_WROUTER>(); N = NE; WT = (bf16_t*)(ws + WS_WRSH); ldt = DM; k0 = 32 * r; n0 = 0; }
        else if ((r -= I_RT) < I_SG) { W = in_ptr<IN_WSG>(); N = ED; WT = (bf16_t*)(ws + WS_WRSH); ldt = DM; k0 = 32 * r; n0 = 0; rm.kind = 2; rm.base = 256; }
        else if ((r -= I_SG) < I_SU) { W = in_ptr<IN_WSU>(); N = ED; WT = (bf16_t*)(ws + WS_WRSH); ldt = DM; k0 = 32 * r; n0 = 0; rm.kind = 2; rm.base = 256 + 128; }
        else if ((r -= I_SU) < I_SD) { W = in_ptr<IN_WSD>(); N = DM; WT = (bf16_t*)(ws + WS_WSHD); ldt = ED; k0 = 32 * (r / 4); n0 = 256 * (r % 4); }
        else if ((r -= I_SD) < I_EG) { const int e = r / 32, q = r % 32; W = in_ptr<IN_WEG>() + (size_t)e * DM * ED; N = ED; WT = (bf16_t*)(ws + WS_WEGU) + (size_t)e * 512 * DM; ldt = DM; k0 = 32 * q; n0 = 0; rm.kind = 2; }
        else if ((r -= I_EG) < I_EU) { const int e = r / 32, q = r % 32; W = in_ptr<IN_WEU>() + (size_t)e * DM * ED; N = ED; WT = (bf16_t*)(ws + WS_WEGU) + (size_t)e * 512 * DM; ldt = DM; k0 = 32 * q; n0 = 0; rm.kind = 2; rm.base = 128; }
        else { r -= I_EU; const int e = r / 32, q = r % 32; W = in_ptr<IN_WED>() + (size_t)e * ED * DM; N = DM; WT = (bf16_t*)(ws + WS_WED) + (size_t)e * DM * ED; ldt = ED; k0 = 32 * (q / 4); n0 = 256 * (q % 4); }
        tr_item(W, N, WT, ldt, k0, n0, lane, rm);
    }
}
DI void p0_adaln(Frame& F, int cb) {
    LAS float* sc = (LAS float*)F.lds;
    LAS float* red = (LAS float*)(F.lds + 16384);
    for (int i = FTID; i < 4096; i += 512) sc[i] = siluf_(in_ptr<IN_C>()[i]);
    __syncthreads();
    const int j = cb * 64 + FLANE; const float* w = in_ptr<IN_WADA>() + j;
    float a0 = 0.f, a1 = 0.f, a2 = 0.f, a3 = 0.f;
    const int kb = F.wave * 128;
#pragma unroll 32
    for (int k = 0; k < 128; ++k) { const float wv = w[(size_t)(kb + k) * 6144]; a0 += sc[kb + k] * wv; a1 += sc[1024 + kb + k] * wv; a2 += sc[2048 + kb + k] * wv; a3 += sc[3072 + kb + k] * wv; }
    red[(F.wave * 4 + 0) * 64 + FLANE] = a0; red[(F.wave * 4 + 1) * 64 + FLANE] = a1; red[(F.wave * 4 + 2) * 64 + FLANE] = a2; red[(F.wave * 4 + 3) * 64 + FLANE] = a3;
    __syncthreads();
    if (FTID < 256) { const int b = FTID >> 6, l = FTID & 63; float s = in_ptr<IN_BADA>()[cb * 64 + l];
#pragma unroll
        for (int w8 = 0; w8 < 8; ++w8) s += red[(w8 * 4 + b) * 64 + l];
        ((float*)(F.ws + WS_SMALL))[b * 6144 + cb * 64 + l] = s; }
    __syncthreads();
}
DI void p0_ssm(Frame& F, int g, int q) {
    LAS float* apow = (LAS float*)F.lds;
    LAS float* bb = apow + 17 * 64 * 2;
    LAS float* cc = bb + 64 * 16 * 2;
    LAS float* km = cc + 16 * 64 * 2;
    const int tid = FTID;
    if (tid < 64) {
        const int p = tid;
        const float lre = fminf(in_ptr<IN_LRE>()[g * 64 + p], -1e-4f), lim = in_ptr<IN_LIM>()[g * 64 + p], dt = expf(in_ptr<IN_LDT>()[g]);
        const float mag = expf(lre * dt); float sn, cs; sincosf(lim * dt, &sn, &cs);
        const float are = mag * cs, aim = mag * sn, den = lre * lre + lim * lim, nr = are - 1.0f;
        const float cre = (nr * lre + aim * lim) / den, cim = (aim * lre - nr * lim) / den;
        for (int tau = 0; tau <= 16; ++tau) { const float mg = expf(lre * dt * (float)tau); float s2, c2; sincosf(lim * dt * (float)tau, &s2, &c2); apow[(tau * 64 + p) * 2] = mg * c2; apow[(tau * 64 + p) * 2 + 1] = mg * s2; }
        for (int c = 0; c < 16; ++c) { const float br = in_ptr<IN_BRE>()[(g * 64 + p) * 16 + c], bi = in_ptr<IN_BIM>()[(g * 64 + p) * 16 + c];
            bb[(p * 16 + c) * 2] = cre * br - cim * bi; bb[(p * 16 + c) * 2 + 1] = cre * bi + cim * br; }
        if (q == 0) { float* a16 = (float*)(F.ws + WS_SMALL + 128 * 1024);
            a16[(g * 64 + p) * 2] = apow[(16 * 64 + p) * 2]; a16[(g * 64 + p) * 2 + 1] = apow[(16 * 64 + p) * 2 + 1]; }
    }
    for (int i = tid; i < 1024; i += 512) { cc[i * 2] = in_ptr<IN_CRE>()[g * 1024 + i]; cc[i * 2 + 1] = in_ptr<IN_CIM>()[g * 1024 + i]; }
    __syncthreads();
    for (int e = tid; e < 4096; e += 512) { const int tau = e >> 8, c = (e >> 4) & 15, c2 = e & 15; float s = 0.f;
        if (tau <= 4 * q + 3) {
            for (int p = 0; p < 64; ++p) { const float cr = cc[(c * 64 + p) * 2], ci = cc[(c * 64 + p) * 2 + 1], ar = apow[(tau * 64 + p) * 2], ai = apow[(tau * 64 + p) * 2 + 1], br = bb[(p * 16 + c2) * 2], bi = bb[(p * 16 + c2) * 2 + 1];
                const float tr = cr * ar - ci * ai, ti = cr * ai + ci * ar; s += tr * br - ti * bi; } }
        km[e] = s; }
    __syncthreads();
    unsigned* TF = (unsigned*)((bf16_t*)(F.ws + WS_TF) + ((size_t)g * 256 + 64 * q) * 384);
    for (int e = tid; e < 64 * 192; e += 512) { const int nl = e / 192, k = 2 * (e % 192), n = 64 * q + nl, s = n >> 4, c = n & 15; float v[2];
#pragma unroll
        for (int j = 0; j < 2; ++j) { const int kk = k + j;
            if (kk < 256) { const int s2 = kk >> 4, c2 = kk & 15; v[j] = (s >= s2) ? km[((s - s2) * 16 + c) * 16 + c2] : 0.f; }
            else { const int p = (kk - 256) & 63; const float cr = cc[(c * 64 + p) * 2], ci = cc[(c * 64 + p) * 2 + 1], ar = apow[((s + 1) * 64 + p) * 2], ai = apow[((s + 1) * 64 + p) * 2 + 1];
                v[j] = (kk < 320) ? (cr * ar - ci * ai) : -(cr * ai + ci * ar); } }
        TF[e] = pk2(v[0], v[1]); }
    unsigned* ET = (unsigned*)((bf16_t*)(F.ws + WS_ET) + ((size_t)g * 256 + 64 * q) * 256);
    for (int e = tid; e < 64 * 128; e += 512) { const int nl = e >> 7, k = 2 * (e & 127), n = 64 * q + nl; float v[2] = {0.f, 0.f};
        if (n < 128) { const int p = n & 63;
#pragma unroll
            for (int j = 0; j < 2; ++j) { const int kk = k + j, s2 = kk >> 4, c2 = kk & 15; const float ar = apow[((15 - s2) * 64 + p) * 2], ai = apow[((15 - s2) * 64 + p) * 2 + 1], br = bb[(p * 16 + c2) * 2], bi = bb[(p * 16 + c2) * 2 + 1];
                v[j] = (n < 64) ? (ar * br - ai * bi) : (ar * bi + ai * br); } }
        ET[e] = pk2(v[0], v[1]); }
    __syncthreads();
}

DI void norm_mod_rows(Frame& F, const float* x, const float* gvec, int sh_off, int sc_off, bf16_t* outp) {
    const float* mod = (const float*)(F.ws + WS_SMALL);
    const int gw = F.vcu * 8 + F.wave, NGW = F.G * 8;
    for (int m = gw; m < M; m += NGW) {
        const int b = m / SEQ;
        const f32x4* xr = (const f32x4*)(x + (size_t)m * DM) + FLANE;
        f32x4 v[4]; float s = 0.f;
#pragma unroll
        for (int j = 0; j < 4; ++j) { v[j] = xr[64 * j]; s += (v[j].x * v[j].x + v[j].y * v[j].y) + (v[j].z * v[j].z + v[j].w * v[j].w); }
        const float rstd = 1.0f / sqrtf(wave_sum(s) * (1.0f / DM) + EPSF);
        u32x2* o8 = (u32x2*)(outp + (size_t)m * DM) + FLANE;
#pragma unroll
        for (int j = 0; j < 4; ++j) { const int col = 4 * FLANE + 256 * j;
            const f32x4 gv = *(const f32x4*)(gvec + col), scv = *(const f32x4*)(mod + b * 6144 + sc_off + col), shv = *(const f32x4*)(mod + b * 6144 + sh_off + col);
            const f32x4 y = v[j] * rstd * gv * (scv + 1.0f) + shv;
            u32x2 w; w.x = pk2(y.x, y.y); w.y = pk2(y.z, y.w); o8[64 * j] = w; }
    }
}

struct DenseSched {
    pg8::StaticOrder so; const char* A; const char* B; size_t astep, bstep;
    DI void init(int Mr, int N, int G, int c, const void* A_, int lda, const void* B_, int ldb) { so.init(Mr, N, G, c); A = (const char*)A_; B = (const char*)B_; astep = (size_t)256 * lda * 2; bstep = (size_t)256 * ldb * 2; }
    DI bool next(int i, Unit& u) const { int pm, pn; if (!so.next(i, pm, pn)) return false; u.pm = pm; u.pn = pn; u.aux = 0; u.half = 0; u.rowtab = nullptr; u.A = A + (size_t)pm * astep; u.B = B + (size_t)pn * bstep; return true; }
};

struct EpiInProj {
    static constexpr bool PERM = true;
    bf16_t *Q, *Kb, *V, *Assm, *sga, *sgs; float* kmean; const float *qg, *kg;
    DI void operator()(const AccT& acc, const Unit& u, int wr, int wc, int fr, int fq) const {
        const int pn = u.pn, pm = u.pm;
        const int row0 = pm * 256 + wr * 64 + fr;
        if (pn < 4) {
            const bool isk = pn >= 2; const int hg = (pn & 1) * 4 + wc;
            const float* gp = (isk ? kg : qg) + 8 * fq; const float scl = isk ? 1.0f : QC2;
            f32x4 gv[2][2];
#pragma unroll
            for (int bj = 0; bj < 2; ++bj)
#pragma unroll
                for (int n = 0; n < 2; ++n) gv[bj][n] = *(const f32x4*)(gp + 32 * bj + 4 * n) * scl;
            f32x4 ks[2][2];
#pragma unroll
            for (int bj = 0; bj < 2; ++bj)
#pragma unroll
                for (int n = 0; n < 2; ++n) ks[bj][n] = (f32x4){0.f, 0.f, 0.f, 0.f};
            bf16_t* dst = (isk ? Kb : Q) + hg * 64 + 8 * fq;
#pragma unroll
            for (int ai = 0; ai < 2; ++ai)
#pragma unroll
                for (int m = 0; m < 4; ++m) {
                    float ss = 0.f;
#pragma unroll
                    for (int bj = 0; bj < 2; ++bj)
#pragma unroll
                        for (int n = 0; n < 2; ++n) { const f32x4 a = acc[ai][bj][m][n]; ss += (a.x * a.x + a.y * a.y) + (a.z * a.z + a.w * a.w); }
                    ss += __shfl_xor(ss, 16); ss += __shfl_xor(ss, 32);
                    const float rstd = 1.0f / sqrtf(ss * (1.0f / 64.0f) + EPSF);
                    const size_t row = (size_t)(row0 + ai * 128 + m * 16);
#pragma unroll
                    for (int bj = 0; bj < 2; ++bj) {
                        const f32x4 v0 = acc[ai][bj][m][0] * rstd * gv[bj][0], v1 = acc[ai][bj][m][1] * rstd * gv[bj][1];
                        if (isk) { ks[bj][0] += v0; ks[bj][1] += v1; }
                        u32x4 w; w.x = pk2(v0.x, v0.y); w.y = pk2(v0.z, v0.w); w.z = pk2(v1.x, v1.y); w.w = pk2(v1.z, v1.w);
                        *(u32x4*)(dst + row * 512 + 32 * bj) = w; }
                }
            if (isk) {
                const int b = pm >> 4, blk = pm & 15;
                float* kmp = kmean + ((size_t)((b * 8 + hg) * 16 + blk)) * 64 + 8 * fq;
#pragma unroll
                for (int bj = 0; bj < 2; ++bj)
#pragma unroll
                    for (int n = 0; n < 2; ++n)
#pragma unroll
                        for (int j = 0; j < 4; ++j) { float s = ks[bj][n][j]; s += __shfl_xor(s, 1); s += __shfl_xor(s, 2); s += __shfl_xor(s, 4); s += __shfl_xor(s, 8);
                            if (fr == 0) kmp[wr * 32768 + 32 * bj + 4 * n + j] = s * (1.0f / 256.0f); }
            }
        } else if (pn < 6) {
            bf16_t* dst = V + (pn - 4) * 256 + wc * 32 + 8 * fq;
#pragma unroll
            for (int ai = 0; ai < 2; ++ai)
#pragma unroll
                for (int m = 0; m < 4; ++m) { const size_t row = (size_t)(row0 + ai * 128 + m * 16);
#pragma unroll
                    for (int bj = 0; bj < 2; ++bj) { const f32x4 v0 = acc[ai][bj][m][0], v1 = acc[ai][bj][m][1];
                        u32x4 w; w.x = pk2(v0.x, v0.y); w.y = pk2(v0.z, v0.w); w.z = pk2(v1.x, v1.y); w.w = pk2(v1.z, v1.w);
                        *(u32x4*)(dst + row * 512 + 128 * bj) = w; } }
        } else if (pn < 8) {
            const int b = pm >> 4;
#pragma unroll
            for (int ai = 0; ai < 2; ++ai)
#pragma unroll
                for (int m = 0; m < 4; ++m) { const int t = (pm & 15) * 256 + ai * 128 + wr * 64 + m * 16 + fr;
#pragma unroll
                    for (int bj = 0; bj < 2; ++bj) { const int c = (pn - 6) * 256 + 128 * bj + 32 * wc + 8 * fq, g = c >> 4, c2 = c & 15;
                        const f32x4 v0 = acc[ai][bj][m][0], v1 = acc[ai][bj][m][1];
                        u32x4 w; w.x = pk2(v0.x, v0.y); w.y = pk2(v0.z, v0.w); w.z = pk2(v1.x, v1.y); w.w = pk2(v1.z, v1.w);
                        *(u32x4*)(Assm + ((size_t)g * 1024 + b * 256 + (t >> 4)) * 384 + (t & 15) * 16 + c2) = w; } }
        } else {
            bf16_t* dst = (pn < 12 ? sga + (pn - 8) * 256 : sgs + (pn - 12) * 256) + wc * 32 + 8 * fq;
#pragma unroll
            for (int ai = 0; ai < 2; ++ai)
#pragma unroll
                for (int m = 0; m < 4; ++m) { const size_t row = (size_t)(row0 + ai * 128 + m * 16);
#pragma unroll
                    for (int bj = 0; bj < 2; ++bj) { const f32x4 v0 = acc[ai][bj][m][0], v1 = acc[ai][bj][m][1];
                        u32x4 w; w.x = pk2(sigmoidf_(v0.x), sigmoidf_(v0.y)); w.y = pk2(sigmoidf_(v0.z), sigmoidf_(v0.w)); w.z = pk2(sigmoidf_(v1.x), sigmoidf_(v1.y)); w.w = pk2(sigmoidf_(v1.z), sigmoidf_(v1.w));
                        *(u32x4*)(dst + row * 1024 + 128 * bj) = w; } }
        }
    }
};

struct EpiS1 {
    static constexpr bool PERM = false;
    float* Hloc;
    DI void operator()(const AccT& acc, const Unit& u, int wr, int wc, int fr, int fq) const {
        float* base = Hloc + (size_t)u.pm * 256 * 128 + wc * 32 + 4 * fq;
#pragma unroll
        for (int ai = 0; ai < 2; ++ai)
#pragma unroll
            for (int m = 0; m < 4; ++m) { const int r = ai * 128 + wr * 64 + m * 16 + fr;
#pragma unroll
                for (int n = 0; n < 2; ++n) *(f32x4*)(base + (size_t)r * 128 + 16 * n) = acc[ai][0][m][n]; }
    }
};
struct SsmSched {
    int G, c; const char* A; const char* B; size_t bstep;
    DI bool next(int i, Unit& u) const { const int L = i * G + c; if (L >= 128) return false; u.pm = L; u.pn = 0; u.aux = 0; u.half = 0; u.rowtab = nullptr;
        u.A = A + (size_t)L * 256 * 384 * 2; u.B = B + (size_t)(L >> 2) * bstep; return true; }
};
struct EpiS2 {
    static constexpr bool PERM = true;
    const bf16_t* Assm; const float* dskip; bf16_t* gbuf;
    DI void operator()(const AccT& acc, const Unit& u, int wr, int wc, int fr, int fq) const {
        const int g = u.pm >> 2, b = u.pm & 3;
#pragma unroll
        for (int ai = 0; ai < 2; ++ai)
#pragma unroll
            for (int m = 0; m < 4; ++m) { const int r = ai * 128 + wr * 64 + m * 16 + fr;
#pragma unroll
                for (int bj = 0; bj < 2; ++bj) { const int c = 128 * bj + 32 * wc + 8 * fq, s = c >> 4, c2 = c & 15;
                    const int t = 16 * r + s;
                    size_t uo = ((size_t)u.pm * 256 + r) * 384 + c, oo = ((size_t)b * SEQ + t) * 512 + g * 16 + c2;
                    asm volatile("" : "+v"(uo), "+v"(oo));
                    const u32x2* up = (const u32x2*)(Assm + uo);
                    u32x2* op = (u32x2*)(gbuf + oo);
#pragma unroll
                    for (int n = 0; n < 2; ++n) {
                        const u32x2 uu = up[n]; const f32x4 d0 = *(const f32x4*)(dskip + g * 16 + c2 + 4 * n); const f32x4 a0 = acc[ai][bj][m][n];
                        const float y0 = a0.x + d0.x * bflo(uu.x), y1 = a0.y + d0.y * bfhi(uu.x), y2 = a0.z + d0.z * bflo(uu.y), y3 = a0.w + d0.w * bfhi(uu.y);
                        u32x2 w; w.x = pk2(gelu_tanh(y0), gelu_tanh(y1)); w.y = pk2(gelu_tanh(y2), gelu_tanh(y3));
                        op[n] = w; asm volatile("" ::: "memory"); } } }
    }
};
struct EpiGluUp {
    static constexpr bool PERM = true;
    const bf16_t* gbuf; const float* bglu; bf16_t* sout; const bf16_t* sga; bf16_t* P1;
    DI void operator()(const AccT& acc, const Unit& u, int wr, int wc, int fr, int fq) const {
        const int row0 = u.pm * 256 + wr * 64 + fr, col0 = u.pn * 256 + wc * 32 + 8 * fq;
#pragma unroll
        for (int ai = 0; ai < 2; ++ai)
#pragma unroll
            for (int m = 0; m < 4; ++m) { const size_t row = (size_t)(row0 + ai * 128 + m * 16);
#pragma unroll
                for (int bj = 0; bj < 2; ++bj) { const int col = col0 + 128 * bj; const f32x4 a0 = acc[ai][bj][m][0], a1 = acc[ai][bj][m][1]; u32x4 w;
                    if (u.aux == 0) { const u32x4 gg = *(const u32x4*)(gbuf + row * 512 + col); const f32x4 b0 = *(const f32x4*)(bglu + col), b1 = *(const f32x4*)(bglu + col + 4);
                        w.x = pk2(bflo(gg.x) * sigmoidf_(a0.x + b0.x), bfhi(gg.x) * sigmoidf_(a0.y + b0.y)); w.y = pk2(bflo(gg.y) * sigmoidf_(a0.z + b0.z), bfhi(gg.y) * sigmoidf_(a0.w + b0.w));
                        w.z = pk2(bflo(gg.z) * sigmoidf_(a1.x + b1.x), bfhi(gg.z) * sigmoidf_(a1.y + b1.y)); w.w = pk2(bflo(gg.w) * sigmoidf_(a1.z + b1.z), bfhi(gg.w) * sigmoidf_(a1.w + b1.w));
                        *(u32x4*)(sout + row * 512 + col) = w;
                    } else { const u32x4 gg = *(const u32x4*)(sga + row * 1024 + col);
                        w.x = pk2(bflo(gg.x) * a0.x, bfhi(gg.x) * a0.y); w.y = pk2(bflo(gg.y) * a0.z, bfhi(gg.y) * a0.w); w.z = pk2(bflo(gg.z) * a1.x, bfhi(gg.z) * a1.y); w.w = pk2(bflo(gg.w) * a1.z, bfhi(gg.w) * a1.w);
                        *(u32x4*)(P1 + row * 1024 + col) = w; } } }
    }
};
struct GluUpSched {
    int G, c; const char *Ag, *Bg, *Au, *Bu;
    DI bool next(int i, Unit& u) const { const int L = i * G + c; if (L >= 384) return false; u.rowtab = nullptr; u.half = 0;
        if (L < 128) { u.aux = 0; u.pm = L >> 1; u.pn = L & 1; u.A = Ag + (size_t)u.pm * 256 * 512 * 2; u.B = Bg + (size_t)u.pn * 256 * 512 * 2; }
        else { const int l2 = L - 128; u.aux = 1; u.pm = l2 >> 2; u.pn = l2 & 3; u.A = Au + (size_t)u.pm * 256 * 512 * 2; u.B = Bu + (size_t)u.pn * 256 * 512 * 2; }
        return true; }
};
struct EpiUp2 {
    static constexpr bool PERM = true;
    const bf16_t* P1; const bf16_t* sgs; bf16_t* mix;
    DI void operator()(const AccT& acc, const Unit& u, int wr, int wc, int fr, int fq) const {
        const int row0 = u.pm * 256 + wr * 64 + fr, col0 = u.pn * 256 + wc * 32 + 8 * fq;
#pragma unroll
        for (int ai = 0; ai < 2; ++ai)
#pragma unroll
            for (int m = 0; m < 4; ++m) { const size_t row = (size_t)(row0 + ai * 128 + m * 16);
#pragma unroll
                for (int bj = 0; bj < 2; ++bj) { const size_t o = row * 1024 + col0 + 128 * bj; const f32x4 a0 = acc[ai][bj][m][0], a1 = acc[ai][bj][m][1];
                    const u32x4 gg = *(const u32x4*)(sgs + o), pp = *(const u32x4*)(P1 + o); u32x4 w;
                    w.x = pk2(bflo(pp.x) + bflo(gg.x) * a0.x, bfhi(pp.x) + bfhi(gg.x) * a0.y); w.y = pk2(bflo(pp.y) + bflo(gg.y) * a0.z, bfhi(pp.y) + bfhi(gg.y) * a0.w);
                    w.z = pk2(bflo(pp.z) + bflo(gg.z) * a1.x, bfhi(pp.z) + bfhi(gg.z) * a1.y); w.w = pk2(bflo(pp.w) + bflo(gg.w) * a1.z, bfhi(pp.w) + bfhi(gg.w) * a1.w);
                    *(u32x4*)(mix + o) = w; } }
    }
};
struct EpiOut {
    static constexpr bool PERM = true;
    const float* x; const float* mod; float* out;
    DI void operator()(const AccT& acc, const Unit& u, int wr, int wc, int fr, int fq) const {
        const int row0 = u.pm * 256 + wr * 64 + fr, col0 = u.pn * 256 + wc * 32 + 8 * fq, b = u.pm >> 4;
#pragma unroll
        for (int bj = 0; bj < 2; ++bj) { const int col = col0 + 128 * bj;
            const f32x4 g0 = *(const f32x4*)(mod + b * 6144 + 2048 + col), g1 = *(const f32x4*)(mod + b * 6144 + 2048 + col + 4);
#pragma unroll
            for (int ai = 0; ai < 2; ++ai)
#pragma unroll
                for (int m = 0; m < 4; ++m) { const size_t o = (size_t)(row0 + ai * 128 + m * 16) * 1024 + col;
                    const f32x4 x0 = *(const f32x4*)(x + o), x1 = *(const f32x4*)(x + o + 4);
                    *(f32x4*)(out + o) = x0 + g0 * acc[ai][bj][m][0]; *(f32x4*)(out + o + 4) = x1 + g1 * acc[ai][bj][m][1]; } }
    }
};
struct EpiRsh {
    static constexpr bool PERM = true;
    float* scores; bf16_t* hs;
    DI void operator()(const AccT& acc, const Unit& u, int wr, int wc, int fr, int fq) const {
        const int row0 = u.pm * 256 + wr * 64 + fr;
        if (u.pn == 0) {
#pragma unroll
            for (int ai = 0; ai < 2; ++ai)
#pragma unroll
                for (int m = 0; m < 4; ++m) { const size_t row = (size_t)(row0 + ai * 128 + m * 16);
#pragma unroll
                    for (int bj = 0; bj < 2; ++bj) { float* d = scores + row * 256 + 128 * bj + 32 * wc + 8 * fq; const f32x4 a0 = acc[ai][bj][m][0], a1 = acc[ai][bj][m][1];
                        *(f32x4*)d = (f32x4){sigmoidf_(a0.x), sigmoidf_(a0.y), sigmoidf_(a0.z), sigmoidf_(a0.w)}; *(f32x4*)(d + 4) = (f32x4){sigmoidf_(a1.x), sigmoidf_(a1.y), sigmoidf_(a1.z), sigmoidf_(a1.w)}; } }
        } else {
#pragma unroll
            for (int ai = 0; ai < 2; ++ai)
#pragma unroll
                for (int m = 0; m < 4; ++m) { const size_t row = (size_t)(row0 + ai * 128 + m * 16);
                    const f32x4 g0 = acc[ai][0][m][0], g1 = acc[ai][0][m][1], u0 = acc[ai][1][m][0], u1 = acc[ai][1][m][1]; u32x4 w;
                    w.x = pk2(siluf_(g0.x) * u0.x, siluf_(g0.y) * u0.y); w.y = pk2(siluf_(g0.z) * u0.z, siluf_(g0.w) * u0.w); w.z = pk2(siluf_(g1.x) * u1.x, siluf_(g1.y) * u1.y); w.w = pk2(siluf_(g1.z) * u1.z, siluf_(g1.w) * u1.w);
                    *(u32x4*)(hs + row * 256 + 128 * (u.pn - 1) + 32 * wc + 8 * fq) = w; }
        }
    }
};
struct EpiBf16 {
    static constexpr bool PERM = true;
    bf16_t* O; int ldc;
    DI void operator()(const AccT& acc, const Unit& u, int wr, int wc, int fr, int fq) const {
        const int row0 = u.pm * 256 + wr * 64 + fr, col0 = u.pn * 256 + wc * 32 + 8 * fq;
#pragma unroll
        for (int ai = 0; ai < 2; ++ai)
#pragma unroll
            for (int m = 0; m < 4; ++m) { const size_t row = (size_t)(row0 + ai * 128 + m * 16);
#pragma unroll
                for (int bj = 0; bj < 2; ++bj) { const f32x4 v0 = acc[ai][bj][m][0], v1 = acc[ai][bj][m][1];
                    u32x4 w; w.x = pk2(v0.x, v0.y); w.y = pk2(v0.z, v0.w); w.z = pk2(v1.x, v1.y); w.w = pk2(v1.z, v1.w);
                    *(u32x4*)(O + row * ldc + col0 + 128 * bj) = w; } asm volatile("" ::: "memory"); }
    }
};
struct EpiMoe1 {
    static constexpr bool PERM = true;
    bf16_t* Hs;
    DI void operator()(const AccT& acc, const Unit& u, int wr, int wc, int fr, int fq) const {
        const int row0 = u.pm * 256 + wr * 64 + fr;
#pragma unroll
        for (int ai = 0; ai < 2; ++ai)
#pragma unroll
            for (int m = 0; m < 4; ++m) { const size_t row = (size_t)(row0 + ai * 128 + m * 16);
                const f32x4 g0 = acc[ai][0][m][0], g1 = acc[ai][0][m][1], u0 = acc[ai][1][m][0], u1 = acc[ai][1][m][1]; u32x4 w;
                w.x = pk2(siluf_(g0.x) * u0.x, siluf_(g0.y) * u0.y); w.y = pk2(siluf_(g0.z) * u0.z, siluf_(g0.w) * u0.w); w.z = pk2(siluf_(g1.x) * u1.x, siluf_(g1.y) * u1.y); w.w = pk2(siluf_(g1.z) * u1.z, siluf_(g1.w) * u1.w);
                *(u32x4*)(Hs + row * 256 + 128 * u.pn + 32 * wc + 8 * fq) = w; }
    }
};
struct EpiMoe2 {
    static constexpr bool PERM = true;
    const int* dest; const float* roww; bf16_t* Y;
    DI void operator()(const AccT& acc, const Unit& u, int wr, int wc, int fr, int fq) const {
        const int row0 = u.pm * 256 + wr * 64 + fr, col0 = u.pn * 256 + wc * 32 + 8 * fq;
        int dd[2][4]; float ww[2][4];
#pragma unroll
        for (int ai = 0; ai < 2; ++ai)
#pragma unroll
            for (int m = 0; m < 4; ++m) { const int row = row0 + ai * 128 + m * 16; dd[ai][m] = dest[row]; ww[ai][m] = roww[row]; }
#pragma unroll
        for (int ai = 0; ai < 2; ++ai)
#pragma unroll
            for (int m = 0; m < 4; ++m) { const int d = dd[ai][m]; const float wt = ww[ai][m];
                if (d >= 0) {
#pragma unroll
                    for (int bj = 0; bj < 2; ++bj) { const f32x4 v0 = acc[ai][bj][m][0] * wt, v1 = acc[ai][bj][m][1] * wt;
                        u32x4 w; w.x = pk2(v0.x, v0.y); w.y = pk2(v0.z, v0.w); w.z = pk2(v1.x, v1.y); w.w = pk2(v1.z, v1.w);
                        *(u32x4*)(Y + (size_t)d * 1024 + col0 + 128 * bj) = w; } } }
    }
};
struct MoeSched {
    int G, c, npn, ntiles; const LAS unsigned short* tile_e; const char* A; const char* B; size_t astep, bestep, bnstep; const int* rowtab;
    DI bool next(int i, Unit& u) const { const int L = i * G + c; if (L >= ntiles * npn) return false; const int tile = L / npn, pn = L % npn; const int e = tile_e[tile];
        u.pm = tile; u.pn = pn; u.aux = e; u.half = (tile_e[MAXTILES + tile] <= 128) ? 1 : 0; u.rowtab = rowtab + tile * 256; u.A = A + (size_t)tile * astep; u.B = B + (size_t)e * bestep + (size_t)pn * bnstep; return true; }
};

namespace att {
constexpr int DMA_ = 512;
constexpr int NW = 8, QBLK = 32, QB = 256, KVBLK = 64;
DI int crow(int r, int hi) { return (r & 3) + 8 * (r >> 2) + 4 * hi; }
#define SBAR() __builtin_amdgcn_sched_barrier(0)
DI void cmask(f32x16& p0, f32x16& p1, int jb, int qrel, int hi) {
    const float NEG = -INFINITY; int kb = 64 * jb + 4 * hi;
#pragma unroll
    for (int r = 0; r < 16; ++r) { int kv = kb + (r & 3) + 8 * (r >> 2); if (kv > qrel) p0[r] = NEG; if (kv + 32 > qrel) p1[r] = NEG; }
}
constexpr int NSLOT = 3, SLOTB = 8192;
constexpr int LDS_K = 0, LDS_V = NSLOT * SLOTB, LDS_WS = 2 * NSLOT * SLOTB, LDS_OST = LDS_WS + NW * 64 * 4, LDS_KM = LDS_OST + NW * 4096, LDS_BT = LDS_KM + 4096, LDS_END = LDS_BT + 576 * 4;
static_assert(LDS_END <= RING_BYTES, "attention LDS");
DI void glds16(const void* sbase, unsigned voff, unsigned lds_dst) { unsigned keep;
    asm volatile("s_nop 4\n\ts_mov_b32 %0, m0\n\ts_mov_b32 m0, %2\n\ts_nop 0\n\tglobal_load_lds_dwordx4 %1, %3\n\ts_mov_b32 m0, %0" : "=&s"(keep) : "v"(voff), "s"(lds_dst), "s"(sbase) : "memory"); }
DI float max3f(float a, float b, float c) { float r; asm("v_max3_f32 %0, %1, %2, %3" : "=v"(r) : "v"(a), "v"(b), "v"(c)); return r; }
DI float max2f(float a, float b) { float r; asm("v_max_f32_e32 %0, %1, %2" : "=v"(r) : "v"(a), "v"(b)); return r; }
DI float fadd_s(float a, float b) { float r; asm("v_add_f32_e32 %0, %1, %2" : "=v"(r) : "v"(a), "v"(b)); return r; }
DI float fsub_s(float a, float b) { float r; asm("v_sub_f32_e32 %0, %1, %2" : "=v"(r) : "v"(a), "v"(b)); return r; }
DI unsigned cvtpk_s(float lo, float hi) { return pk2(lo, hi); }
#define WAIT_BAR(N) asm volatile("s_waitcnt vmcnt(" #N ") lgkmcnt(0)\n\ts_barrier" ::: "memory")
DI void qkt(f32x16& p0, f32x16& p1, const char* Kslot, const bf16x8* qr, const f32x16& negm, int r32, int hi) {
    const char* kb = Kslot + hi * 1024 + r32 * 16;
#pragma unroll
    for (int d0 = 0; d0 < 4; ++d0) {
        const bf16x8 b0 = *reinterpret_cast<const bf16x8*>(kb + d0 * 2048);
        const bf16x8 b1 = *reinterpret_cast<const bf16x8*>(kb + d0 * 2048 + 512);
        if (d0 == 0) { p0 = __builtin_amdgcn_mfma_f32_32x32x16_bf16(b0, qr[0], negm, 0, 0, 0); p1 = __builtin_amdgcn_mfma_f32_32x32x16_bf16(b1, qr[0], negm, 0, 0, 0); }
        else { p0 = __builtin_amdgcn_mfma_f32_32x32x16_bf16(b0, qr[d0], p0, 0, 0, 0); p1 = __builtin_amdgcn_mfma_f32_32x32x16_bf16(b1, qr[d0], p1, 0, 0, 0); } }
}
typedef LAS const char* lds_cptr;
typedef short v4i16_t __attribute__((ext_vector_type(4)));
DI void kload8(bf16x8* kf, lds_cptr kp) {
    kf[0] = *(const LAS bf16x8*)(kp);        kf[1] = *(const LAS bf16x8*)(kp + 512);
    kf[2] = *(const LAS bf16x8*)(kp + 2048); kf[3] = *(const LAS bf16x8*)(kp + 2560);
    kf[4] = *(const LAS bf16x8*)(kp + 4096); kf[5] = *(const LAS bf16x8*)(kp + 4608);
    kf[6] = *(const LAS bf16x8*)(kp + 6144); kf[7] = *(const LAS bf16x8*)(kp + 6656);
}
DI void kload2(bf16x8* kf, lds_cptr kp, int j) { kf[2 * j] = *(const LAS bf16x8*)(kp + j * 2048); kf[2 * j + 1] = *(const LAS bf16x8*)(kp + j * 2048 + 512); }
DI s16x4 vtr(lds_cptr p) { return __builtin_bit_cast(s16x4, __builtin_amdgcn_ds_read_tr16_b64_v4i16((LAS v4i16_t*)p)); }
DI float rowmax(const f32x16& p0, const f32x16& p1) {
    float a = max3f(p0[0], p0[1], p1[0]), b = max3f(p0[2], p0[3], p1[1]); a = max3f(a, p1[2], p1[3]);
#pragma unroll
    for (int r = 4; r < 16; r += 4) { a = max3f(a, p0[r], p0[r + 1]); b = max3f(b, p0[r + 2], p0[r + 3]); a = max3f(a, p1[r], p1[r + 1]); b = max3f(b, p1[r + 2], p1[r + 3]); }
    const float m = max2f(a, b);
    auto rr = __builtin_amdgcn_permlane32_swap(__float_as_uint(m), __float_as_uint(m), false, false);
    return max2f(__uint_as_float(rr[0]), __uint_as_float(rr[1]));
}
DI void pv(f32x16* o, int vb, bf16x8 pa0, bf16x8 pa1, bf16x8 pa2, bf16x8 pa3) {
#pragma unroll
    for (int d0 = 0; d0 < 2; ++d0) { s16x4 lo[4], hi[4];
#pragma unroll
        for (int ks = 0; ks < 4; ++ks) {
            asm volatile("ds_read_b64_tr_b16 %0,%1 offset:%c2" : "=&v"(lo[ks]) : "v"(vb), "i"(d0 * 4096 + ks * 1024) : "memory");
            asm volatile("ds_read_b64_tr_b16 %0,%1 offset:%c2" : "=&v"(hi[ks]) : "v"(vb), "i"(d0 * 4096 + ks * 1024 + 512) : "memory"); }
        asm volatile("s_waitcnt lgkmcnt(0)" ::: "memory"); SBAR();
#define PK(k) (bf16x8){lo[k][0], lo[k][1], lo[k][2], lo[k][3], hi[k][0], hi[k][1], hi[k][2], hi[k][3]}
        o[d0] = __builtin_amdgcn_mfma_f32_32x32x16_bf16(pa0, PK(0), o[d0], 0, 0, 0);
        o[d0] = __builtin_amdgcn_mfma_f32_32x32x16_bf16(pa1, PK(1), o[d0], 0, 0, 0);
        o[d0] = __builtin_amdgcn_mfma_f32_32x32x16_bf16(pa2, PK(2), o[d0], 0, 0, 0);
        o[d0] = __builtin_amdgcn_mfma_f32_32x32x16_bf16(pa3, PK(3), o[d0], 0, 0, 0);
#undef PK
    }
}
DI int t5_bucket(int n) { if (n < 16) return n; int v = 16 + (int)(logf((float)n * (1.0f / 16.0f)) * (16.0f / 2.0794415416798357f)); return v > 31 ? 31 : v; }

template <int THRL> DI void attn_unit(int wid, int b, int h, int qb, const bf16_t* Q, const bf16_t* __restrict__ K, const bf16_t* __restrict__ V, bf16_t* O, char* shm, const float* kmean, const float* relb) {
    int lane = lane_id(); asm volatile("" : "+v"(lane));
    const int tid = wid * 64 + lane, r32 = lane & 31, hi = lane >> 5;
    const long rowbase = (long)b * SEQ; const int q0 = qb * QB;
    const bf16_t* Qw = Q + (rowbase + q0 + wid * QBLK) * DMA_ + h * 64;
    const bf16_t* Kh = K + rowbase * DMA_ + h * 64, *Vh = V + rowbase * DMA_ + h * 64;
    const unsigned lds0 = (unsigned)(uintptr_t)shm;
    LAS float* wsf = (LAS float*)((LAS char*)shm + LDS_WS) + wid * 64;
    LAS float* kms = (LAS float*)((LAS char*)shm + LDS_KM); LAS float* bt = (LAS float*)((LAS char*)shm + LDS_BT);
    if (tid < 256) *(LAS f32x4*)(kms + 4 * tid) = *(const f32x4*)(kmean + (size_t)(b * 8 + h) * 1024 + 4 * tid) + *(const f32x4*)(kmean + 32768 + (size_t)(b * 8 + h) * 1024 + 4 * tid);
    for (int i = tid; i < 576; i += 512) { const int n = i - 256; float v = 0.f; if (n >= 0 && n < 128) v = (relb[t5_bucket(n) * 8 + h] - relb[31 * 8 + h]) * LOG2E; bt[i] = exp2f(v); }
    asm volatile("s_waitcnt vmcnt(0) lgkmcnt(0)\n\ts_barrier" ::: "memory");
    unsigned selmask = 0;
    {
        float gsc[8];
#pragma unroll
        for (int j = 0; j < 8; ++j) gsc[j] = 0.f;
#pragma unroll
        for (int c8 = 0; c8 < 8; ++c8) { const u32x4 qq = *(const u32x4*)(Qw + (long)r32 * DMA_ + c8 * 8);
            float qv[8] = {bflo(qq.x), bfhi(qq.x), bflo(qq.y), bfhi(qq.y), bflo(qq.z), bfhi(qq.z), bflo(qq.w), bfhi(qq.w)};
#pragma unroll
            for (int j = 0; j < 8; ++j) { const LAS float* kp = kms + (8 * hi + j) * 64 + c8 * 8; const f32x4 k0 = *(const LAS f32x4*)kp, k1 = *(const LAS f32x4*)(kp + 4);
                gsc[j] += qv[0] * k0.x + qv[1] * k0.y + qv[2] * k0.z + qv[3] * k0.w + qv[4] * k1.x + qv[5] * k1.y + qv[6] * k1.z + qv[7] * k1.w; } }
        float ga[16];
#pragma unroll
        for (int j = 0; j < 8; ++j) { const float o = __shfl_xor(gsc[j], 32); ga[j] = hi ? o : gsc[j]; ga[8 + j] = hi ? gsc[j] : o; }
#pragma unroll
        for (int j = 0; j < 16; ++j) if (j >= qb) ga[j] = -INFINITY;
#pragma unroll
        for (int k = 0; k < 3; ++k) { float bv = -INFINITY; int bi = -1;
#pragma unroll
            for (int j = 0; j < 16; ++j) if (ga[j] > bv) { bv = ga[j]; bi = j; }
            if (bi >= 0) { selmask |= 1u << bi;
#pragma unroll
                for (int j = 0; j < 16; ++j) if (j == bi) ga[j] = -INFINITY; } }
        selmask |= 0xffff0000u | (1u << qb);
    }
    const unsigned kvo = (unsigned)(lane * DMA_ * 2);
    const unsigned vvo = (unsigned)(((lane >> 2) * DMA_ + (lane & 3) * 8) * 2);
    const bf16_t* kub = Kh + wid * 8; const bf16_t* vub = Vh + (long)(16 * (wid & 3)) * DMA_ + (wid >> 2) * 32;
    const unsigned kdst = lds0 + LDS_K + wid * 1024, vdst = lds0 + LDS_V + wid * 1024;
#define DMA_K(t, slot) glds16(kub + (long)(t) * KVBLK * DMA_, kvo, (unsigned)__builtin_amdgcn_readfirstlane(kdst + (slot)))
#define DMA_V(t, slot) glds16(vub + (long)(t) * KVBLK * DMA_, vvo, (unsigned)__builtin_amdgcn_readfirstlane(vdst + (slot)))
    const int vb0 = (int)(lds0 + LDS_V) + ((lane >> 4) & 1) * 32 + (lane & 3) * 8 + (4 * hi + ((lane & 15) >> 2)) * 64;
    const char* Kbase = shm + LDS_K; bf16x8 kf[8];
    const lds_cptr shm3 = (lds_cptr)shm; const lds_cptr kp0 = shm3 + LDS_K + hi * 1024 + r32 * 16; const lds_cptr vp0 = shm3 + LDS_V + ((lane >> 4) & 1) * 32 + (lane & 3) * 8 + (4 * hi + ((lane & 15) >> 2)) * 64;
    const int NT = (q0 + QB) / KVBLK;
    DMA_K(0, 0); DMA_V(0, 0); DMA_K(1, SLOTB);
    bf16x8 qr[4];
#pragma unroll
    for (int d0 = 0; d0 < 4; ++d0) qr[d0] = *reinterpret_cast<const bf16x8*>(&Qw[(long)r32 * DMA_ + d0 * 16 + hi * 8]);
    float mhat = 0.f, l_reg = 0.f; f32x16 o[2]; o[0] = f32x16{}; o[1] = f32x16{}; f32x16 negm;
#pragma unroll
    for (int r = 0; r < 16; ++r) negm[r] = (selmask & 1u) ? 0.f : -1e30f;
    asm volatile("" : "+v"(negm));
    const int qrel = wid * QBLK + r32;
#define MASKS(P0, P1, t) do { int jb_ = (t) - (NT - 4); if (jb_ >= 0) cmask(P0, P1, jb_, qrel, hi); } while (0)
#define BIASM(P0, P1, t) do { if ((t) >= NT - 9 && q0 + wid * QBLK - (64 * (t) + 63) < 128) { const LAS float* bp_ = bt + (q0 + qrel - 64 * (t) + 256 - 63 - 4 * hi); \
        _Pragma("unroll") for (int r4 = 0; r4 < 16; r4 += 4) { _Pragma("unroll") for (int r = r4; r < r4 + 4; ++r) { const volatile LAS float* vb_ = bp_; P0[r] *= vb_[63 - crow(r, 0)]; P1[r] *= vb_[31 - crow(r, 0)]; } SBAR(); } } } while (0)
#define MOFF(t) (((selmask >> ((t) >> 2)) & 1u) ? 0.f : -1e30f)
#define UPD(t) do { if (((t) & 3) == 0) { const float nv_ = MOFF(t) - mhat; \
        _Pragma("unroll") for (int r = 0; r < 16; ++r) negm[r] = nv_; asm volatile("" : "+v"(negm)); } } while (0)
    bool resc = false;
#define START(P0, P1) do { const float rm = rowmax(P0, P1); resc = false; \
    { const float dl = __builtin_fmaxf(rm, 0.f); mhat = fadd_s(mhat, dl); \
      _Pragma("unroll") for (int r = 0; r < 16; ++r) { P0[r] = fsub_s(P0[r], dl); P1[r] = fsub_s(P1[r], dl); } \
      const float nv_ = MOFF(0) - mhat; _Pragma("unroll") for (int r = 0; r < 16; ++r) negm[r] = nv_; asm volatile("" : "+v"(negm)); } \
    _Pragma("unroll") for (int r = 0; r < 16; ++r) P0[r] = __builtin_amdgcn_exp2f(P0[r]); } while (0)
#define RESC() do { if (resc) { asm volatile("s_waitcnt lgkmcnt(0)" ::: "memory"); \
      _Pragma("unroll") for (int d_ = 0; d_ < 2; ++d_) _Pragma("unroll") for (int r = 0; r < 16; ++r) o[d_][r] *= wsf[crow(r, hi)]; } } while (0)
    f32x16 pA0, pA1, pB0, pB1;
    int sl_prev = 0, sl_cur = 0, sl_next = SLOTB;
#define ROT() do { sl_prev = sl_cur; sl_cur = sl_next; sl_next = (sl_next == (NSLOT - 1) * SLOTB) ? 0 : sl_next + SLOTB; } while (0)
    DMA_K(2, 2 * SLOTB);
    WAIT_BAR(3);
    qkt(pA0, pA1, Kbase, qr, negm, r32, hi); asm volatile("s_nop 15\n\ts_nop 7" : "+v"(pA0), "+v"(pA1)); MASKS(pA0, pA1, 0);
    START(pA0, pA1);
    _Pragma("unroll") for (int r = 0; r < 16; ++r) pA1[r] = __builtin_amdgcn_exp2f(pA1[r]);
    WAIT_BAR(0);
    DMA_K(3, 0); DMA_V(1, SLOTB);
    ROT();
    kload8(kf, kp0 + sl_cur);
    WAIT_BAR(2);
    BIASM(pA0, pA1, 0);
    s16x4 vlo[8], vhi[8]; u32x4 pw0, pw1, pw2, pw3;
#define PKW(P, B) cvtpk_s(P[B], P[B + 1])
#define PAF(k) __builtin_bit_cast(bf16x8, pw##k)
#define VFR(i) (bf16x8){vlo[i][0], vlo[i][1], vlo[i][2], vlo[i][3], vhi[i][0], vhi[i][1], vhi[i][2], vhi[i][3]}
#define PIN(x) asm volatile("" : "+v"(x))
#define MX3(a, b, c) __builtin_fmaxf(__builtin_fmaxf((a), (b)), (c))
#define GAPA(MF, A0, A1, A2, A3, W0, W1, PW) do { MF; sacc += A0; sacc += A1; sacc += A2; sacc += A3; PIN(sacc); W0; W1; PIN(PW); SBAR(); } while (0)
#define EX(v) __builtin_amdgcn_exp2f(v)
#define GAPB(MF, X, B) do { MF; X[B] = EX(X[B]); X[B + 1] = EX(X[B + 1]); X[B + 2] = EX(X[B + 2]); X[B + 3] = EX(X[B + 3]); PIN(X); SBAR(); } while (0)
#define VRD(i) do { vlo[i] = vtr(vp_ + (((i) >> 2) * 4096 + ((i) & 3) * 1024)); vhi[i] = vtr(vp_ + (((i) >> 2) * 4096 + ((i) & 3) * 1024 + 512)); } while (0)
#define KRD(G, j) do { if (G) { kload2(kf, kp0 + sl_next, j); SBAR(); } } while (0)
#define STEP(C0, C1, P0, P1, t, GK, GV, GL, MSK) do { SBAR(); \
    const lds_cptr vp_ = vp0 + sl_prev; \
    VRD(0); SBAR(); float sacc = (P0[0] + P0[1]); \
    GAPA(C0 = __builtin_amdgcn_mfma_f32_32x32x16_bf16(kf[0], qr[0], negm, 0, 0, 0), P0[2], P0[3], P0[4], P0[5],     pw0[0] = PKW(P0, 0), pw0[1] = PKW(P0, 2), pw0); \
    VRD(4); SBAR(); GAPA(C1 = __builtin_amdgcn_mfma_f32_32x32x16_bf16(kf[1], qr[0], negm, 0, 0, 0), P0[6], P0[7], P0[8], P0[9],     pw0[2] = PKW(P0, 4), pw0[3] = PKW(P0, 6), pw0); \
    VRD(1); SBAR(); GAPA(C0 = __builtin_amdgcn_mfma_f32_32x32x16_bf16(kf[2], qr[1], C0, 0, 0, 0),   P0[10], P0[11], P0[12], P0[13], pw1[0] = PKW(P0, 8), pw1[1] = PKW(P0, 10), pw1); \
    VRD(5); SBAR(); GAPA(C1 = __builtin_amdgcn_mfma_f32_32x32x16_bf16(kf[3], qr[1], C1, 0, 0, 0),   P0[14], P0[15], P1[0], P1[1],   pw1[2] = PKW(P0, 12), pw1[3] = PKW(P0, 14), pw1); \
    VRD(2); SBAR(); GAPA(C0 = __builtin_amdgcn_mfma_f32_32x32x16_bf16(kf[4], qr[2], C0, 0, 0, 0),   P1[2], P1[3], P1[4], P1[5],     pw2[0] = PKW(P1, 0), pw2[1] = PKW(P1, 2), pw2); \
    VRD(6); SBAR(); GAPA(C1 = __builtin_amdgcn_mfma_f32_32x32x16_bf16(kf[5], qr[2], C1, 0, 0, 0),   P1[6], P1[7], P1[8], P1[9],     pw2[2] = PKW(P1, 4), pw2[3] = PKW(P1, 6), pw2); \
    VRD(3); SBAR(); GAPA(C0 = __builtin_amdgcn_mfma_f32_32x32x16_bf16(kf[6], qr[3], C0, 0, 0, 0),   P1[10], P1[11], P1[12], P1[13], pw3[0] = PKW(P1, 8), pw3[1] = PKW(P1, 10), pw3); \
    asm volatile("s_waitcnt lgkmcnt(13)" ::: "memory"); VRD(7); SBAR(); GAPA(C1 = __builtin_amdgcn_mfma_f32_32x32x16_bf16(kf[7], qr[3], C1, 0, 0, 0),   P1[14], P1[15], 0.f, 0.f,       pw3[2] = PKW(P1, 12), pw3[3] = PKW(P1, 14), pw3); \
    l_reg += sacc; \
    if (GK) { DMA_K((t) + 3, sl_cur); } if (GV) { DMA_V((t) + 1, sl_next); } \
    if (MSK) { MASKS(C0, C1, t); } \
    { float a = MX3(C0[0], C0[1], C1[0]), b = MX3(C0[2], C0[3], C1[1]); a = MX3(a, C1[2], C1[3]); \
      _Pragma("unroll") for (int r = 4; r < 16; r += 4) { a = MX3(a, C0[r], C0[r + 1]); b = MX3(b, C0[r + 2], C0[r + 3]); a = MX3(a, C1[r], C1[r + 1]); b = MX3(b, C1[r + 2], C1[r + 3]); } \
      float rm = __builtin_fmaxf(a, b); { auto rr = __builtin_amdgcn_permlane32_swap(__float_as_uint(rm), __float_as_uint(rm), false, false); rm = __builtin_fmaxf(__uint_as_float(rr[0]), __uint_as_float(rr[1])); } \
      resc = false; \
      if (__builtin_expect(__any(rm > (float)THRL), 0)) { const float dl = __builtin_fmaxf(rm, 0.f); mhat += dl; \
        _Pragma("unroll") for (int r = 0; r < 16; ++r) { C0[r] -= dl; C1[r] -= dl; } \
        const float nv_ = MOFF(t) - mhat; _Pragma("unroll") for (int r = 0; r < 16; ++r) negm[r] = nv_; asm volatile("" : "+v"(negm)); \
        const float f = __builtin_amdgcn_exp2f(-dl); l_reg *= f; { const int l2_ = lane_id(); if (l2_ < 32) wsf[l2_] = f; } resc = true; } } \
    SBAR(); \
    GAPB(o[0] = __builtin_amdgcn_mfma_f32_32x32x16_bf16(PAF(0), VFR(0), o[0], 0, 0, 0), C0, 0); \
    GAPB(o[1] = __builtin_amdgcn_mfma_f32_32x32x16_bf16(PAF(0), VFR(4), o[1], 0, 0, 0), C0, 4); \
    KRD(GL, 0); GAPB(o[0] = __builtin_amdgcn_mfma_f32_32x32x16_bf16(PAF(1), VFR(1), o[0], 0, 0, 0), C0, 8); \
    KRD(GL, 1); GAPB(o[1] = __builtin_amdgcn_mfma_f32_32x32x16_bf16(PAF(1), VFR(5), o[1], 0, 0, 0), C0, 12); \
    KRD(GL, 2); GAPB(o[0] = __builtin_amdgcn_mfma_f32_32x32x16_bf16(PAF(2), VFR(2), o[0], 0, 0, 0), C1, 0); \
    KRD(GL, 3); GAPB(o[1] = __builtin_amdgcn_mfma_f32_32x32x16_bf16(PAF(2), VFR(6), o[1], 0, 0, 0), C1, 4); \
    GAPB(o[0] = __builtin_amdgcn_mfma_f32_32x32x16_bf16(PAF(3), VFR(3), o[0], 0, 0, 0), C1, 8); \
    GAPB(o[1] = __builtin_amdgcn_mfma_f32_32x32x16_bf16(PAF(3), VFR(7), o[1], 0, 0, 0), C1, 12); \
    } while (0)
    int t = 1;
    const int tb = (NT - 9 > 1) ? NT - 9 : 1;
    for (; t < tb; t += 2) {
        STEP(pB0, pB1, pA0, pA1, t, true, true, true, false);         WAIT_BAR(2); RESC(); ROT();
        UPD(t + 1);
        STEP(pA0, pA1, pB0, pB1, t + 1, true, true, true, false);     WAIT_BAR(2); RESC(); ROT();
    }
#define ENDW(tt) do { if ((tt) + 3 < NT) { WAIT_BAR(2); } else if ((tt) + 2 < NT) { WAIT_BAR(1); } else { WAIT_BAR(0); } } while (0)
    for (; t + 1 < NT; t += 2) {
        STEP(pB0, pB1, pA0, pA1, t, (t + 3 < NT), (t + 1 < NT), (t + 1 < NT), true);         ENDW(t);     RESC(); BIASM(pB0, pB1, t); ROT();
        UPD(t + 1);
        STEP(pA0, pA1, pB0, pB1, t + 1, (t + 4 < NT), (t + 2 < NT), (t + 2 < NT), true);     ENDW(t + 1); RESC(); BIASM(pA0, pA1, t + 1); ROT();
    }
    STEP(pB0, pB1, pA0, pA1, NT - 1, false, false, false, true); RESC(); asm volatile("s_waitcnt lgkmcnt(0)" ::: "memory"); BIASM(pB0, pB1, NT - 1);
    { float sacc = pB0[0] + pB0[1]; _Pragma("unroll") for (int r = 2; r < 16; ++r) sacc += pB0[r]; _Pragma("unroll") for (int r = 0; r < 16; ++r) sacc += pB1[r]; l_reg += sacc;
      pw0 = (u32x4){PKW(pB0, 0), PKW(pB0, 2), PKW(pB0, 4), PKW(pB0, 6)}; pw1 = (u32x4){PKW(pB0, 8), PKW(pB0, 10), PKW(pB0, 12), PKW(pB0, 14)}; pw2 = (u32x4){PKW(pB1, 0), PKW(pB1, 2), PKW(pB1, 4), PKW(pB1, 6)}; pw3 = (u32x4){PKW(pB1, 8), PKW(pB1, 10), PKW(pB1, 12), PKW(pB1, 14)};
      SBAR(); pv(o, vb0 + sl_cur, PAF(0), PAF(1), PAF(2), PAF(3)); }
#undef PKW
#undef PAF
#undef VFR
#undef PIN
#undef MX3
#undef GAPA
#undef GAPB
#undef EX
#undef VRD
#undef KRD
#undef STEP
#undef ENDW
    { auto rr = __builtin_amdgcn_permlane32_swap(__float_as_uint(l_reg), __float_as_uint(l_reg), false, false); l_reg = __uint_as_float(rr[0]) + __uint_as_float(rr[1]); }
    if (hi == 0) wsf[32 + r32] = l_reg; asm volatile("s_waitcnt lgkmcnt(0)" ::: "memory");
    float rli[16];
#pragma unroll
    for (int r = 0; r < 16; ++r) rli[r] = __builtin_amdgcn_rcpf(wsf[32 + crow(r, hi)]);
    bf16_t* Ow = O + (rowbase + q0 + wid * QBLK) * DMA_ + h * 64;
    { LAS bf16_t* stg = (LAS bf16_t*)((LAS char*)shm + LDS_OST) + wid * 2048;
#pragma unroll
        for (int r = 0; r < 16; ++r) { const int orow = crow(r, hi);
#pragma unroll
            for (int d0 = 0; d0 < 2; ++d0) stg[orow * 64 + d0 * 32 + r32] = (bf16_t)(pk2(o[d0][r] * rli[r], 0.f) & 0xffffu); }
        asm volatile("s_waitcnt lgkmcnt(0)" ::: "memory");
#pragma unroll
        for (int i = 0; i < 4; ++i) { const int row = i * 8 + (lane >> 3), ch = lane & 7; const u32x4 v = *(const LAS u32x4*)(stg + row * 64 + ch * 8); *(u32x4*)(Ow + (long)row * DMA_ + ch * 8) = v; } }
    asm volatile("s_waitcnt lgkmcnt(0)\n\ts_barrier" ::: "memory");
#undef DMA_K
#undef DMA_V
#undef MASKS
#undef BIASM
#undef UPD
#undef MOFF
#undef START
#undef RESC
#undef ROT
}
#undef SBAR
#undef WAIT_BAR
}

DI void ssm_scan(Frame& F) {
    const float* Hloc = (const float*)(F.ws + WS_HLOC); bf16_t* Assm = (bf16_t*)(F.ws + WS_ASSM); const float* a16 = (const float*)(F.ws + WS_SMALL + 128 * 1024);
    const int gw = F.vcu * 8 + F.wave, NGW = F.G * 8, p = FLANE;
    for (int task = gw; task < 128; task += NGW) {
        const int g = task >> 2, b = task & 3;
        const float ar = a16[(g * 64 + p) * 2], ai = a16[(g * 64 + p) * 2 + 1];
        float sr = 0.f, si = 0.f;
        const float* hl = Hloc + ((size_t)g * 1024 + b * 256) * 128; bf16_t* ao = Assm + ((size_t)g * 1024 + b * 256) * 384 + 256;
        for (int c0 = 0; c0 < 256; c0 += 8) {
            float lr[8], li[8];
#pragma unroll
            for (int j = 0; j < 8; ++j) { lr[j] = hl[(size_t)(c0 + j) * 128 + p]; li[j] = hl[(size_t)(c0 + j) * 128 + 64 + p]; }
#pragma unroll
            for (int j = 0; j < 8; ++j) {
                ao[(size_t)(c0 + j) * 384 + p] = (bf16_t)(pk2(sr, 0.f) & 0xffffu); ao[(size_t)(c0 + j) * 384 + 64 + p] = (bf16_t)(pk2(si, 0.f) & 0xffffu);
                const float nr = ar * sr - ai * si + lr[j], ni = ar * si + ai * sr + li[j]; sr = nr; si = ni; }
        }
    }
}

template <int CTRL, int RM> DI float dppf(float v) { return __int_as_float(__builtin_amdgcn_update_dpp(__float_as_int(v), __float_as_int(v), CTRL, RM, 0xf, false)); }
template <int CTRL, int RM> DI int dppi(int v) { return __builtin_amdgcn_update_dpp(v, v, CTRL, RM, 0xf, false); }
DI float wave_max_f(float v) { v = fmaxf(v, dppf<0xB1, 0xf>(v)); v = fmaxf(v, dppf<0x4E, 0xf>(v)); v = fmaxf(v, dppf<0x141, 0xf>(v)); v = fmaxf(v, dppf<0x140, 0xf>(v));
    v = fmaxf(v, dppf<0x142, 0xa>(v)); v = fmaxf(v, dppf<0x143, 0xc>(v)); return __int_as_float(__builtin_amdgcn_readlane(__float_as_int(v), 63)); }
DI int wave_min_i(int v) { v = min(v, dppi<0xB1, 0xf>(v)); v = min(v, dppi<0x4E, 0xf>(v)); v = min(v, dppi<0x141, 0xf>(v)); v = min(v, dppi<0x140, 0xf>(v));
    v = min(v, dppi<0x142, 0xa>(v)); v = min(v, dppi<0x143, 0xc>(v)); return __builtin_amdgcn_readlane(v, 63); }
DI void topk_tokens(Frame& F) {
    const float* scores = (const float*)(F.ws + WS_SCORES); const float* rbias = in_ptr<IN_RBIAS>();
    int* top_idx = (int*)(F.ws + WS_ROUTE); float* top_w = (float*)(F.ws + WS_ROUTE + 512 * 1024); int* rank = (int*)(F.ws + WS_ROUTE + 1024 * 1024);
    unsigned* cnt = (unsigned*)(F.ws + WS_CTL) + CW_CNT;
    LAS unsigned* lcnt = (LAS unsigned*)F.lds;
    LAS int* le = (LAS int*)(F.lds + 1024);
    LAS unsigned* lr = (LAS unsigned*)(F.lds + 3072);
    LAS float* lw = (LAS float*)(F.lds + 5120);
    const int l = FLANE, tid = FTID;
    const f32x4 rb = *(const f32x4*)(rbias + 4 * l);
    for (int blk = F.vcu; blk < M / 64; blk += F.G) {
        __syncthreads();
        if (tid < 256) lcnt[tid] = 0u;
        __syncthreads();
#pragma unroll 1
        for (int tt = 0; tt < 8; ++tt) {
            const int tl = F.wave * 8 + tt, t = blk * 64 + tl;
            const f32x4 sc = *(const f32x4*)(scores + (size_t)t * 256 + 4 * l);
            float v[4] = {sc.x + rb.x, sc.y + rb.y, sc.z + rb.z, sc.w + rb.w};
            float m1 = fmaxf(v[0], v[1]), m2 = fminf(v[0], v[1]);
            { const float a = fmaxf(v[2], v[3]), c = fminf(v[2], v[3]); const float n1 = fmaxf(m1, a), n2 = fmaxf(fminf(m1, a), fmaxf(m2, c)); m1 = n1; m2 = n2; }
            { float o1 = dppf<0xB1, 0xf>(m1), o2 = dppf<0xB1, 0xf>(m2); float n1 = fmaxf(m1, o1), n2 = fmaxf(fminf(m1, o1), fmaxf(m2, o2)); m1 = n1; m2 = n2;
              o1 = dppf<0x4E, 0xf>(m1); o2 = dppf<0x4E, 0xf>(m2); n1 = fmaxf(m1, o1); n2 = fmaxf(fminf(m1, o1), fmaxf(m2, o2)); m1 = n1; m2 = n2;
              o1 = dppf<0x141, 0xf>(m1); o2 = dppf<0x141, 0xf>(m2); n1 = fmaxf(m1, o1); n2 = fmaxf(fminf(m1, o1), fmaxf(m2, o2)); m1 = n1; m2 = n2; }
            const float gs = m1 + m2; const int myg = l >> 3; int higher = 0;
#pragma unroll
            for (int j = 0; j < 8; ++j) { const float og = __int_as_float(__builtin_amdgcn_readlane(__float_as_int(gs), 8 * j)); higher += (og > gs || (og == gs && j < myg)) ? 1 : 0; }
            if (higher >= 4) { v[0] = -1e30f; v[1] = -1e30f; v[2] = -1e30f; v[3] = -1e30f; }
            int my_e = 0; float my_s = 0.f, tot = 0.f;
#pragma unroll
            for (int k = 0; k < 8; ++k) {
                float bv = v[0]; int bi = 4 * l;
                if (v[1] > bv) { bv = v[1]; bi = 4 * l + 1; } if (v[2] > bv) { bv = v[2]; bi = 4 * l + 2; } if (v[3] > bv) { bv = v[3]; bi = 4 * l + 3; }
                { const float wm = wave_max_f(bv); bi = wave_min_i(bv == wm ? bi : 0x7fffffff); bv = wm; }
                const float mys = (bi == 4 * l) ? sc.x : (bi == 4 * l + 1) ? sc.y : (bi == 4 * l + 2) ? sc.z : sc.w;
                const float ssel = __int_as_float(__builtin_amdgcn_readlane(__float_as_int(mys), bi >> 2));
                if (bi == 4 * l) v[0] = -3e38f; if (bi == 4 * l + 1) v[1] = -3e38f; if (bi == 4 * l + 2) v[2] = -3e38f; if (bi == 4 * l + 3) v[3] = -3e38f;
                tot += ssel; if (l == k) { my_e = bi; my_s = ssel; }
            }
            if (l < 8) { le[tl * 8 + l] = my_e; lw[tl * 8 + l] = my_s / tot * 2.5f; lr[tl * 8 + l] = __hip_atomic_fetch_add(lcnt + my_e, 1u, __ATOMIC_RELAXED, __HIP_MEMORY_SCOPE_WORKGROUP); }
        }
        __syncthreads();
        if (tid < 256) { const unsigned c = lcnt[tid]; unsigned base = 0u; if (c) base = atomicAdd(cnt + tid * CNT_STRIDE, c); lcnt[tid] = base; }
        __syncthreads();
        { const int e = le[tid]; const size_t gi = (size_t)blk * 512 + tid; top_idx[gi] = e; top_w[gi] = lw[tid]; rank[gi] = (int)(lr[tid] + lcnt[e]); }
    }
    __syncthreads();
}
DI int build_tiles(Frame& F) {
    const unsigned* cnt = (const unsigned*)(F.ws + WS_CTL) + CW_CNT;
    LAS unsigned* sa = (LAS unsigned*)(F.lds + SCAN_OFF); LAS unsigned* sb = sa + 256; LAS unsigned short* tile_e = (LAS unsigned short*)(F.lds + TILEE_OFF);
    LAS unsigned* misc = (LAS unsigned*)(F.lds + MISC_OFF);
    const int tid = FTID; unsigned nt = 0, cn = 0;
    __syncthreads();
    if (tid < 256) { cn = __hip_atomic_load(cnt + tid * CNT_STRIDE, __ATOMIC_RELAXED, __HIP_MEMORY_SCOPE_AGENT); nt = (cn + 255u) >> 8; sa[tid] = nt; }
    __syncthreads();
    LAS unsigned* src = sa; LAS unsigned* dst = sb;
    for (int o = 1; o < 256; o <<= 1) { if (tid < 256) { unsigned v = src[tid]; if (tid >= o) v += src[tid - o]; dst[tid] = v; } __syncthreads(); LAS unsigned* tmp = src; src = dst; dst = tmp; }
    if (tid < 256) { const unsigned incl = src[tid], first = incl - nt; for (unsigned k = 0; k < nt; ++k) if (first + k < MAXTILES) { tile_e[first + k] = (unsigned short)tid; const unsigned rem = cn - 256u * k; tile_e[MAXTILES + first + k] = (unsigned short)(rem > 256u ? 256u : rem); } dst[tid] = first; if (tid == 255) misc[16] = incl; }
    __syncthreads();
    if (tid < 256) sa[tid] = dst[tid];
    __syncthreads();
    int ntl = (int)misc[16]; if (ntl > MAXTILES) ntl = MAXTILES; return ntl;
}
DI void route_scatter(Frame& F) {
    const int* top_idx = (const int*)(F.ws + WS_ROUTE); const float* top_w = (const float*)(F.ws + WS_ROUTE + 512 * 1024); const int* rank = (const int*)(F.ws + WS_ROUTE + 1024 * 1024);
    int* rowoff = (int*)(F.ws + WS_ROUTE + 2 * MiB); float* roww = (float*)(F.ws + WS_ROUTE + 3 * MiB); int* dest = (int*)(F.ws + WS_ROUTE + 4 * MiB);
    (void)build_tiles(F);
    LAS unsigned* first = (LAS unsigned*)(F.lds + SCAN_OFF);
    const int gt = F.vcu * 512 + FTID, NT = F.G * 512;
    for (int i = gt; i < M * 8; i += NT) { const int e = top_idx[i]; const int pos = (int)first[e] * 256 + rank[i];
        if (pos < MAXROWS) { rowoff[pos] = (i >> 3) * (DM * 2); roww[pos] = top_w[i]; dest[pos] = i; } }
}
DI void route_clear(Frame& F) {
    int* rowoff = (int*)(F.ws + WS_ROUTE + 2 * MiB); float* roww = (float*)(F.ws + WS_ROUTE + 3 * MiB); int* dest = (int*)(F.ws + WS_ROUTE + 4 * MiB);
    const int gt = F.vcu * 512 + FTID, NT = F.G * 512;
    for (int i = gt; i < MAXROWS; i += NT) { rowoff[i] = 0; roww[i] = 0.f; dest[i] = -1; }
}
DI void combine(Frame& F) {
    const float* mod = (const float*)(F.ws + WS_SMALL); const bf16_t* ysh = (const bf16_t*)(F.ws + WS_YSH); const bf16_t* Y = (const bf16_t*)(F.ws + WS_Y);
    const int gw = F.vcu * 8 + F.wave, NGW = F.G * 8;
    for (int t = gw; t < M; t += NGW) { const int b = t / SEQ;
#pragma unroll
        for (int hf = 0; hf < 2; ++hf) { const int col = hf * 512 + FLANE * 8;
            const u32x4 s = *(const u32x4*)(ysh + (size_t)t * 1024 + col);
            float a[8] = {bflo(s.x), bfhi(s.x), bflo(s.y), bfhi(s.y), bflo(s.z), bfhi(s.z), bflo(s.w), bfhi(s.w)};
            u32x4 yv[8];
#pragma unroll
            for (int k = 0; k < 8; ++k) yv[k] = *(const u32x4*)(Y + ((size_t)t * 8 + k) * 1024 + col);
#pragma unroll
            for (int k = 0; k < 8; ++k) { a[0] += bflo(yv[k].x); a[1] += bfhi(yv[k].x); a[2] += bflo(yv[k].y); a[3] += bfhi(yv[k].y); a[4] += bflo(yv[k].z); a[5] += bfhi(yv[k].z); a[6] += bflo(yv[k].w); a[7] += bfhi(yv[k].w); }
            float* o = F.out + (size_t)t * 1024 + col; const float* g2 = mod + b * 6144 + 5120 + col;
            const f32x4 x0 = *(const f32x4*)o, x1 = *(const f32x4*)(o + 4), g0 = *(const f32x4*)g2, g1 = *(const f32x4*)(g2 + 4);
            *(f32x4*)o = x0 + g0 * (f32x4){a[0], a[1], a[2], a[3]}; *(f32x4*)(o + 4) = x1 + g1 * (f32x4){a[4], a[5], a[6], a[7]}; }
    }
}

constexpr int NPHASE = 17;
__global__ void __launch_bounds__(512, 2) mk_fwd(Args args) {
    extern __shared__ __attribute__((aligned(16))) unsigned char lds_raw[];
    Frame F;
    F.lds = (LAS unsigned char*)lds_raw; F.wave = __builtin_amdgcn_readfirstlane((int)threadIdx.x >> 6);
    F.G = gridDim.x; { const int bx = blockIdx.x; F.vcu = (F.G % 8 == 0) ? (bx % 8) * (F.G / 8) + bx / 8 : bx; }
    F.in.dummy = 0; F.out = args.out; F.ws = args.ws;
    unsigned char* ws = args.ws;
    volatile LAS unsigned* MISC = (volatile LAS unsigned*)(F.lds + MISC_OFF);
    LAS unsigned* gtab = (LAS unsigned*)(F.lds + GTAB_OFF);
    for (int u = FTID; u < 64; u += 512) MISC[u] = 0u;
    __syncthreads();
    unsigned* ctl = (unsigned*)(ws + WS_CTL);
    XcdBarrier bar; bar.bar = ctl + CW_BAR; bar.x = 0; bar.st = nullptr; bar.wave = F.wave;
    if (!MK_PER_PHASE) bar = xcd_barrier_post(ctl + CW_BAR, MISC + 8, F.wave);
    const int lo = args.ph_lo, hi = args.ph_hi;
#ifndef ONLY_PHASE
#define ONLY_PHASE -1
#endif
#define IN(k) ((ONLY_PHASE < 0 || ONLY_PHASE == (k)) && lo <= (k) && (k) < hi)
#ifndef PROBE_PHASE
#define PROBE_PHASE -1
#endif
#ifndef PROBE_AMP
#define PROBE_AMP 4
#endif
    unsigned long long pr_t0 = 0, pr_dt = 0;
#define SEAM(k) do { if (IN(k) && IN((k) + 1)) xcd_barrier(bar); \
    if (PROBE_PHASE >= 0) { if ((k) + 1 == PROBE_PHASE) pr_t0 = __builtin_amdgcn_s_memrealtime(); if ((k) == PROBE_PHASE) pr_dt = __builtin_amdgcn_s_memrealtime() - pr_t0; } } while (0)
    const int G = F.G, bx = (int)blockIdx.x;
    float* mod = (float*)(ws + WS_SMALL);

    if (PROBE_PHASE == 0) pr_t0 = __builtin_amdgcn_s_memrealtime();
    if (IN(0)) {
        if (bx < 96) p0_adaln(F, bx); else if (bx < 224) p0_ssm(F, (bx - 96) >> 2, (bx - 96) & 3);
        conv_items(F, 0, I_SMALL);
    }
    SEAM(0);
    if (IN(1)) norm_mod_rows(F, in_ptr<IN_X>(), in_ptr<IN_LN1G>(), 0, 1024, (bf16_t*)(ws + WS_H));
    SEAM(1);
    if (IN(2)) {
        pg8::Gemm g{DM, DM, DM}; DenseSched S; S.init(M, INW, G, bx, ws + WS_H, DM, ws + WS_WIN, DM);
        EpiInProj E{(bf16_t*)(ws + WS_Q), (bf16_t*)(ws + WS_K), (bf16_t*)(ws + WS_V), (bf16_t*)(ws + WS_ASSM), (bf16_t*)(ws + WS_SGA), (bf16_t*)(ws + WS_SGS), (float*)(ctl + CW_KMEAN), in_ptr<IN_QG>(), in_ptr<IN_KG>()};
        pg8::gemm_phase<EpiInProj, DenseSched, true, false>(F.lds, gtab, F.wave, g, S, E);
    }
    SEAM(2);
    if (IN(3)) {
#pragma unroll 1
        for (int ui = F.vcu * 2; ui < 512; ui += 2 * G) {
#pragma unroll 1
            for (int k2 = 0; k2 < 2; ++k2) { const int pi = ui >> 1, bh = pi >> 3, s = pi & 7, qb = k2 ? s : 15 - s;
                att::attn_unit<8>(F.wave, bh >> 3, bh & 7, qb, (const bf16_t*)(ws + WS_Q), (const bf16_t*)(ws + WS_K), (const bf16_t*)(ws + WS_V), (bf16_t*)(ws + WS_Q), (char*)lds_raw, (const float*)(ctl + CW_KMEAN), in_ptr<IN_RELB>()); } }
        __syncthreads();
        pg8::Gemm g{384, 256, 256}; SsmSched S{G, F.vcu, (const char*)(ws + WS_ASSM), (const char*)(ws + WS_ET), (size_t)256 * 256 * 2};
        EpiS1 E{(float*)(ws + WS_HLOC)};
        pg8::gemm_phase<EpiS1, SsmSched, true, false>(F.lds, gtab, F.wave, g, S, E);
    }
    SEAM(3);
    if (IN(4)) ssm_scan(F);
    SEAM(4);
    if (IN(5)) {
        pg8::Gemm g{384, 384, 384}; SsmSched S{G, F.vcu, (const char*)(ws + WS_ASSM), (const char*)(ws + WS_TF), (size_t)256 * 384 * 2};
        EpiS2 E{(const bf16_t*)(ws + WS_ASSM), in_ptr<IN_SSMD>(), (bf16_t*)(ws + WS_GBUF)};
        pg8::gemm_phase<EpiS2, SsmSched, true, false>(F.lds, gtab, F.wave, g, S, E);
    }
    SEAM(5);
    if (IN(6)) {
        pg8::Gemm g{512, 512, 512}; GluUpSched S{G, F.vcu, (const char*)(ws + WS_GBUF), (const char*)(ws + WS_WGLU), (const char*)(ws + WS_Q), (const char*)(ws + WS_WUPA)};
        EpiGluUp E{(const bf16_t*)(ws + WS_GBUF), in_ptr<IN_BGLU>(), (bf16_t*)(ws + WS_SOUT), (const bf16_t*)(ws + WS_SGA), (bf16_t*)(ws + WS_P1)};
        pg8::gemm_phase<EpiGluUp, GluUpSched, true, false>(F.lds, gtab, F.wave, g, S, E);
    }
    SEAM(6);
    if (IN(7)) {
        pg8::Gemm g{512, 512, 512}; DenseSched S; S.init(M, DM, G, bx, ws + WS_SOUT, 512, ws + WS_WUPS, 512);
        EpiUp2 E{(const bf16_t*)(ws + WS_P1), (const bf16_t*)(ws + WS_SGS), (bf16_t*)(ws + WS_MIX)};
        pg8::gemm_phase<EpiUp2, DenseSched, true, false>(F.lds, gtab, F.wave, g, S, E);
    }
    SEAM(7);
    if (IN(8)) {
        pg8::Gemm g{DM, DM, DM}; DenseSched S; S.init(M, DM, G, bx, ws + WS_MIX, DM, ws + WS_WOUT, DM);
        EpiOut E{in_ptr<IN_X>(), mod, F.out};
        pg8::gemm_phase<EpiOut, DenseSched, true, false>(F.lds, gtab, F.wave, g, S, E);
    }
    SEAM(8);
    if (IN(9)) norm_mod_rows(F, F.out, in_ptr<IN_LN2G>(), 3072, 4096, (bf16_t*)(ws + WS_H));
    SEAM(9);
    if (IN(10)) {
        pg8::Gemm g{DM, DM, DM}; DenseSched S; S.init(M, 768, G, bx, ws + WS_H, DM, ws + WS_WRSH, DM);
        EpiRsh E{(float*)(ws + WS_SCORES), (bf16_t*)(ws + WS_HS)};
        pg8::gemm_phase<EpiRsh, DenseSched, true, false>(F.lds, gtab, F.wave, g, S, E);
    }
    SEAM(10);
    if (IN(11)) {
        route_clear(F);
        topk_tokens(F);
        __syncthreads();
        pg8::Gemm g{ED, ED, ED}; DenseSched S; S.init(M, DM, G, bx, ws + WS_HS, ED, ws + WS_WSHD, ED);
        EpiBf16 E{(bf16_t*)(ws + WS_YSH), 1024};
        pg8::gemm_phase<EpiBf16, DenseSched, true, false>(F.lds, gtab, F.wave, g, S, E);
    }
    SEAM(11);
    if (IN(12)) { route_scatter(F); conv_items(F, I_SMALL, I_SMALL + I_EG + I_EU); }
    SEAM(12);
    if (IN(13)) {
        const int ntl = build_tiles(F);
        pg8::Gemm g{DM, DM, DM};
        MoeSched S{G, F.vcu, 2, ntl, (const LAS unsigned short*)(F.lds + TILEE_OFF), (const char*)(ws + WS_H), (const char*)(ws + WS_WEGU), 0, (size_t)512 * DM * 2, (size_t)256 * DM * 2, (const int*)(ws + WS_ROUTE + 2 * MiB)};
        EpiMoe1 E{(bf16_t*)(ws + WS_HSORT)};
        pg8::gemm_phase<EpiMoe1, MoeSched, true, true>(F.lds, gtab, F.wave, g, S, E);
        conv_items(F, I_SMALL + I_EG + I_EU, NITEMS);
    }
    SEAM(13);
    if (IN(14)) {
        const int ntl = build_tiles(F);
        pg8::Gemm g{ED, ED, ED};
        MoeSched S{G, F.vcu, 4, ntl, (const LAS unsigned short*)(F.lds + TILEE_OFF), (const char*)(ws + WS_HSORT), (const char*)(ws + WS_WED), (size_t)256 * ED * 2, (size_t)DM * ED * 2, (size_t)256 * ED * 2, nullptr};
        EpiMoe2 E{(const int*)(ws + WS_ROUTE + 4 * MiB), (const float*)(ws + WS_ROUTE + 3 * MiB), (bf16_t*)(ws + WS_Y)};
        pg8::gemm_phase<EpiMoe2, MoeSched, true, false>(F.lds, gtab, F.wave, g, S, E);
    }
    SEAM(14);
    if (IN(15)) combine(F);
    if (PROBE_PHASE >= 0) { if (PROBE_PHASE == 15) { asm volatile("s_waitcnt vmcnt(0)" ::: "memory"); pr_dt = __builtin_amdgcn_s_memrealtime() - pr_t0; }
        if (blockIdx.x == 0) { const unsigned long long te = __builtin_amdgcn_s_memrealtime(); while (__builtin_amdgcn_s_memrealtime() - te < (unsigned long long)PROBE_AMP * pr_dt) __builtin_amdgcn_s_sleep(8); } }
#undef IN
#undef SEAM
}

extern "C" void kernel_launch(void* const* d_in, const int* in_sizes, int n_in, void* d_out, int out_size, void* d_ws, size_t ws_size, hipStream_t stream) {
    static int grid = 0;
    if (grid == 0) {
        if (n_in != 31 || out_size != M * DM || ws_size < WS_END) { fprintf(stderr, "kernel_launch: unexpected shapes (n_in %d out %d ws %zu)\n", n_in, out_size, ws_size); grid = -1; return; }
        int dev = 0, cus = 0;
        if (hipGetDevice(&dev) != hipSuccess || hipDeviceGetAttribute(&cus, hipDeviceAttributeMultiprocessorCount, dev) != hipSuccess) { grid = -1; return; }
        if (hipFuncSetAttribute((const void*)mk_fwd, hipFuncAttributeMaxDynamicSharedMemorySize, LDS_BYTES) != hipSuccess) { fprintf(stderr, "kernel_launch: hipFuncSetAttribute failed\n"); grid = -1; return; }
        int per_cu = 0;
        if (hipOccupancyMaxActiveBlocksPerMultiprocessor(&per_cu, (const void*)mk_fwd, 512, LDS_BYTES) != hipSuccess || per_cu < 1) fprintf(stderr, "kernel_launch: occupancy query says %d\n", per_cu);
        (void)hipGetLastError();
        grid = cus;
    }
    if (grid < 0) return;
    (void)hipMemsetAsync((char*)d_ws + WS_CTL, 0, CTL_ZERO_BYTES, stream);
    Args a{};
    for (int i = 0; i < 31; ++i) a.in[i] = (const float*)d_in[i];
    a.out = (float*)d_out; a.ws = (unsigned char*)d_ws;
#if MK_PER_PHASE
    for (int p = 0; p < NPHASE; ++p) { a.ph_lo = p; a.ph_hi = p + 1; hipLaunchKernelGGL(mk_fwd, dim3(grid), dim3(512), LDS_BYTES, stream, a); }
#else
    a.ph_lo = 0; a.ph_hi = NPHASE;
    hipLaunchKernelGGL(mk_fwd, dim3(grid), dim3(512), LDS_BYTES, stream, a);
#endif
}
```
